# Optimizing an MI355X kernel written in HIP

```python
import jax, jax.numpy as jnp
from jax import lax
import numpy as np

D_MODEL = 1024
BATCH = 2
SEQ = 16384
DEPTH = 1

D_MIX = D_MODEL
D_HG = D_MIX // 2
HG_HEAD_DIM = 128
HG_HEADS = D_HG // HG_HEAD_DIM
D_RG = D_MIX - D_HG
RG_BLOCKS = 8
RG_BLOCK_DIM = D_RG // RG_BLOCKS
RG_CONV_W = 4
RG_CONV_LEFT = RG_CONV_W // 2
RG_C = 8.0
D_FF = 2816
CHUNK = 64
EPS = 1e-6
N_MOD = 9
IN_COLS = 5 * D_HG + 2 * D_RG

kernel_name = "hymba_hgrn2_rglru_macaron_adaln"


def rms_norm(x, gain):
    xf = x.astype(jnp.float32)
    y = xf * lax.rsqrt(jnp.mean(xf * xf, axis=-1, keepdims=True) + EPS)
    return (y * gain.astype(jnp.float32)).astype(x.dtype)


def modulate(h, shift, scale):
    return h * (1 + scale[:, None, :]) + shift[:, None, :]


def swiglu(h, w1, w3, w2):
    return (jax.nn.silu(h @ w1) * (h @ w3)) @ w2


def gla_chunk_scan(q, k, v, log_g):
    B, T, H, dk = q.shape
    dv = v.shape[-1]
    n = T // CHUNK

    def to_chunks(a):
        return a.astype(jnp.float32).reshape(B, n, CHUNK, H, a.shape[-1]).transpose(1, 0, 3, 2, 4)

    qc, kc, vc, gc = to_chunks(q), to_chunks(k), to_chunks(v), to_chunks(log_g)
    mask = jnp.tril(jnp.ones((CHUNK, CHUNK), dtype=bool))[:, :, None]

    def step(S, inp):
        qb, kb, vb, gb = inp
        b = jnp.cumsum(gb, axis=-2)
        b_last = b[..., -1:, :]
        o_inter = jnp.einsum('bhck,bhkv->bhcv', qb * jnp.exp(b), S)
        diff = b[..., :, None, :] - b[..., None, :, :]
        decay = jnp.exp(jnp.where(mask, diff, -jnp.inf))
        scores = jnp.einsum('bhtk,bhsk,bhtsk->bhts', qb, kb, decay)
        o = o_inter + jnp.einsum('bhts,bhsv->bhtv', scores, vb)
        S = (jnp.exp(b_last[..., 0, :])[..., None] * S
             + jnp.einsum('bhck,bhcv->bhkv', kb * jnp.exp(b_last - b), vb))
        return S, o

    S0 = jnp.zeros((B, H, dk, dv), jnp.float32)
    _, o = lax.scan(step, S0, (qc, kc, vc, gc))
    return o.transpose(1, 0, 3, 2, 4).reshape(B, T, H, dv).astype(q.dtype)


def layer_lower_bound(lb_param, layer):
    s = jax.nn.softmax(lb_param.astype(jnp.float32), axis=0)
    return (jnp.cumsum(s, axis=0) - s[0])[layer + 1]


def hgrn2_mixer(q_raw, f_fwd_raw, f_bwd_raw, i_raw, g_raw, lb_fwd, lb_bwd, norm_gain):
    B, T, _ = q_raw.shape
    split = lambda a: a.reshape(B, T, HG_HEADS, HG_HEAD_DIM)
    q = split(jax.nn.silu(q_raw))
    v = split(i_raw)

    def direction(f_raw, lb, reverse):
        f = lb + (1 - lb) * jax.nn.sigmoid(f_raw.astype(jnp.float32))
        k = split((1 - f).astype(q_raw.dtype))
        lg = split(jnp.log(f))
        if reverse:
            return gla_chunk_scan(q[:, ::-1], k[:, ::-1], v[:, ::-1], lg[:, ::-1])[:, ::-1]
        return gla_chunk_scan(q, k, v, lg)

    o = direction(f_fwd_raw, lb_fwd, False) + direction(f_bwd_raw, lb_bwd, True)
    o = rms_norm(o, norm_gain).reshape(B, T, D_HG)
    return o * jax.nn.silu(g_raw)


def centred_dwconv(x, w, b):
    y = lax.conv_general_dilated(
        x, w[:, None, :].astype(x.dtype), window_strides=(1,),
        padding=[(RG_CONV_LEFT, RG_CONV_W - 1 - RG_CONV_LEFT)],
        dimension_numbers=('NWC', 'WIO', 'NWC'), feature_group_count=x.shape[-1])
    return y + b


def rglru_direction(xc, w_a, b_a, w_x, b_x, lam, reverse):
    B, T, _ = xc.shape
    xf = xc.astype(jnp.float32)
    xb = xf.reshape(B, T, RG_BLOCKS, RG_BLOCK_DIM)
    r = jax.nn.sigmoid(jnp.einsum('btnd,nde->btne', xb, w_a.astype(jnp.float32)).reshape(B, T, D_RG)
                       + b_a.astype(jnp.float32))
    i = jax.nn.sigmoid(jnp.einsum('btnd,nde->btne', xb, w_x.astype(jnp.float32)).reshape(B, T, D_RG)
                       + b_x.astype(jnp.float32))
    log_a = -RG_C * r * jax.nn.softplus(-lam.astype(jnp.float32))
    a = jnp.exp(log_a)
    u = jnp.sqrt(-jnp.expm1(2 * log_a)) * (i * xf)

    def combine(e1, e2):
        a1, b1 = e1
        a2, b2 = e2
        return a1 * a2, a2 * b1 + b2

    _, h = lax.associative_scan(combine, (a, u), axis=1, reverse=reverse)
    return h


def rglru_mixer(rx, rgate, conv_w, conv_b,
                wa_f, ba_f, wx_f, bx_f, lam_f, wa_b, ba_b, wx_b, bx_b, lam_b):
    xc = centred_dwconv(rx, conv_w, conv_b)
    h = (rglru_direction(xc, wa_f, ba_f, wx_f, bx_f, lam_f, False)
         + rglru_direction(xc, wa_b, ba_b, wx_b, bx_b, lam_b, True))
    return h.astype(rx.dtype) * jax.nn.gelu(rgate)


def setup_inputs(seed: int = 0) -> dict:
    key = jax.random.key(seed)
    ks = jax.random.split(key, 40)
    f32 = jnp.float32
    nrm = lambda k, shape, fan_in: jax.random.normal(k, shape, f32) * (fan_in ** -0.5)
    gain = lambda k, shape: 1.0 + 0.05 * jax.random.normal(k, shape, f32)
    small = lambda k, shape: 0.01 * jax.random.normal(k, shape, f32)

    def lam_init(k):
        a_c = jax.random.uniform(k, (DEPTH, D_RG), f32, 0.9, 0.999)
        a0 = a_c ** (1.0 / RG_C)
        return jnp.log(a0) - jnp.log1p(-a0)

    return {
        "x": jax.random.normal(ks[0], (BATCH, SEQ, D_MODEL), f32),
        "c": jax.random.normal(ks[1], (BATCH, D_MODEL), f32),
        "w_ada": nrm(ks[2], (DEPTH, D_MODEL, N_MOD * D_MODEL), D_MODEL),
        "b_ada": small(ks[3], (DEPTH, N_MOD * D_MODEL)),
        "ffn1_norm": gain(ks[4], (DEPTH, D_MODEL)),
        "ffn1_w1": nrm(ks[5], (DEPTH, D_MODEL, D_FF), D_MODEL),
        "ffn1_w3": nrm(ks[6], (DEPTH, D_MODEL, D_FF), D_MODEL),
        "ffn1_w2": nrm(ks[7], (DEPTH, D_FF, D_MODEL), D_FF),
        "mix_norm": gain(ks[8], (DEPTH, D_MODEL)),
        "w_in": nrm(ks[9], (DEPTH, D_MODEL, IN_COLS), D_MODEL),
        "hg_lb_fwd": jax.random.normal(ks[10], (DEPTH + 1, D_HG), f32),
        "hg_lb_bwd": jax.random.normal(ks[11], (DEPTH + 1, D_HG), f32),
        "hg_out_norm": gain(ks[12], (DEPTH, HG_HEAD_DIM)),
        "rg_conv_w": nrm(ks[13], (DEPTH, RG_CONV_W, D_RG), RG_CONV_W),
        "rg_conv_b": small(ks[14], (DEPTH, D_RG)),
        "rg_wa_fwd": nrm(ks[15], (DEPTH, RG_BLOCKS, RG_BLOCK_DIM, RG_BLOCK_DIM), RG_BLOCK_DIM),
        "rg_ba_fwd": small(ks[16], (DEPTH, D_RG)),
        "rg_wx_fwd": nrm(ks[17], (DEPTH, RG_BLOCKS, RG_BLOCK_DIM, RG_BLOCK_DIM), RG_BLOCK_DIM),
        "rg_bx_fwd": small(ks[18], (DEPTH, D_RG)),
        "rg_lam_fwd": lam_init(ks[19]),
        "rg_wa_bwd": nrm(ks[20], (DEPTH, RG_BLOCKS, RG_BLOCK_DIM, RG_BLOCK_DIM), RG_BLOCK_DIM),
        "rg_ba_bwd": small(ks[21], (DEPTH, D_RG)),
        "rg_wx_bwd": nrm(ks[22], (DEPTH, RG_BLOCKS, RG_BLOCK_DIM, RG_BLOCK_DIM), RG_BLOCK_DIM),
        "rg_bx_bwd": small(ks[23], (DEPTH, D_RG)),
        "rg_lam_bwd": lam_init(ks[24]),
        "w_out": nrm(ks[25], (DEPTH, D_MIX, D_MODEL), D_MIX),
        "ffn2_norm": gain(ks[26], (DEPTH, D_MODEL)),
        "ffn2_w1": nrm(ks[27], (DEPTH, D_MODEL, D_FF), D_MODEL),
        "ffn2_w3": nrm(ks[28], (DEPTH, D_MODEL, D_FF), D_MODEL),
        "ffn2_w2": nrm(ks[29], (DEPTH, D_FF, D_MODEL), D_FF),
        "final_norm": gain(ks[30], (D_MODEL,)),
    }


def reference(x, c, w_ada, b_ada, ffn1_norm, ffn1_w1, ffn1_w3, ffn1_w2, mix_norm, w_in,
              hg_lb_fwd, hg_lb_bwd, hg_out_norm, rg_conv_w, rg_conv_b,
              rg_wa_fwd, rg_ba_fwd, rg_wx_fwd, rg_bx_fwd, rg_lam_fwd,
              rg_wa_bwd, rg_ba_bwd, rg_wx_bwd, rg_bx_bwd, rg_lam_bwd,
              w_out, ffn2_norm, ffn2_w1, ffn2_w3, ffn2_w2, final_norm):
    split_idx = [D_HG, 2 * D_HG, 3 * D_HG, 4 * D_HG, 5 * D_HG, 5 * D_HG + D_RG]
    for l in range(DEPTH):
        mod = jax.nn.silu(c) @ w_ada[l] + b_ada[l]
        sh1, sc1, g1, sh2, sc2, g2, sh3, sc3, g3 = jnp.split(mod, N_MOD, axis=-1)

        h = modulate(rms_norm(x, ffn1_norm[l]), sh1, sc1)
        x = x + 0.5 * g1[:, None, :] * swiglu(h, ffn1_w1[l], ffn1_w3[l], ffn1_w2[l])

        h = modulate(rms_norm(x, mix_norm[l]), sh2, sc2)
        z = h @ w_in[l]
        q_raw, f_fwd_raw, f_bwd_raw, i_raw, g_raw, rx, rgate = jnp.split(z, split_idx, axis=-1)
        o_hg = hgrn2_mixer(q_raw, f_fwd_raw, f_bwd_raw, i_raw, g_raw,
                           layer_lower_bound(hg_lb_fwd, l), layer_lower_bound(hg_lb_bwd, l),
                           hg_out_norm[l])
        o_rg = rglru_mixer(rx, rgate, rg_conv_w[l], rg_conv_b[l],
                           rg_wa_fwd[l], rg_ba_fwd[l], rg_wx_fwd[l], rg_bx_fwd[l], rg_lam_fwd[l],
                           rg_wa_bwd[l], rg_ba_bwd[l], rg_wx_bwd[l], rg_bx_bwd[l], rg_lam_bwd[l])
        y = jnp.concatenate([o_hg, o_rg], axis=-1) @ w_out[l]
        x = x + g2[:, None, :] * y

        h = modulate(rms_norm(x, ffn2_norm[l]), sh3, sc3)
        x = x + 0.5 * g3[:, None, :] * swiglu(h, ffn2_w1[l], ffn2_w3[l], ffn2_w2[l])
    return rms_norm(x, final_norm)
```

```cpp
#include <hip/hip_runtime.h>
#include <cstdio>
#include <cstdint>
namespace pg8 {
#define PG8_LAS __attribute__((address_space(3)))
typedef unsigned short bf16_t;
typedef short bf16x8 __attribute__((ext_vector_type(8)));
typedef float f32x4 __attribute__((ext_vector_type(4)));
typedef unsigned u32x4 __attribute__((ext_vector_type(4)));
constexpr int BM = 256, BK = 64, HALF = 128, HTB = HALF * BK * 2  , STAGE_BYTES = 8 * HTB, NXCD = 8, WGM = 8;

__host__ __device__ __forceinline__ int lds_byte(int r, int c) { const int st = (r >> 4) * 2 + (c >> 5), rr = r & 15, cc = c & 31, ob = rr * 64 + cc * 2; return st * 1024 + (ob ^ (((ob >> 9) & 1) << 5)); }
__host__ __device__ __forceinline__ void stage_rc(int b, int& R, int& C) { const int st = b / 1024, sb = b % 1024, swz = sb ^ (((sb >> 9) & 1) << 5); R = (st >> 1) * 16 + swz / 64; C = (st & 1) * 32 + (swz % 64) / 2; }
__host__ __device__ __forceinline__ int perm32(int rho) { const int n = rho >> 4, i = rho & 15; return 8 * (i >> 2) + 4 * n + (i & 3); }

struct Unit { int pm, pn; };
struct Gemm { const bf16_t* A; const bf16_t* Bt; int M, N, K; };

struct StaticOrder {
    int nM, nN, nwg, G, c;
    __host__ __device__ void init(int M, int N, int G_, int c_) { nM = M / BM; nN = N / BM; nwg = nM * nN; G = G_; c = c_; }
    __host__ __device__ bool next(int i, Unit& u) const {
        const long L = (long)i * G + c; if (L >= nwg) return false;
        int wgid = (int)L; { const int q = nwg / NXCD, r = nwg % NXCD, xcd = wgid % NXCD, off = wgid / NXCD; wgid = (xcd < r ? xcd * (q + 1) : r * (q + 1) + (xcd - r) * q) + off; }
        const int nig = WGM * nN, gid = wgid / nig, fm = gid * WGM, gsz = (nM - fm) < WGM ? (nM - fm) : WGM;
        u.pm = fm + ((wgid % nig) % gsz); u.pn = (wgid % nig) / gsz; return true;
    }
    __device__ __forceinline__ void a_ready(const Unit&) const {}
    __device__ __forceinline__ void done(const Unit&) const {}
};
__device__ __forceinline__ unsigned cvt_pk_bf16(float lo, float hi) { unsigned r; asm volatile("v_cvt_pk_bf16_f32 %0, %1, %2" : "=v"(r) : "v"(lo), "v"(hi)); return r; }
typedef float f32x2 __attribute__((ext_vector_type(2)));
__device__ __forceinline__ float sigmoid_f(float x) { return __builtin_amdgcn_rcpf(1.0f + __builtin_amdgcn_exp2f(-1.44269504f * x)); }
__device__ __forceinline__ float silu_f(float x) { return x * sigmoid_f(x); }
__device__ __forceinline__ float gelu_tanh_f(float x) { return x * sigmoid_f(1.5957691216f * (x + 0.044715f * x * x * x)); }

struct EpiSwiGLU {
    static constexpr bool PERM = true, AFTER_DRAIN = false;
    bf16_t* O; int ldc;
    __device__ __forceinline__ void operator()(const f32x4 (&acc)[2][2][4][2], const Unit& u, int wr, int wc, int fr, int fq) const {
        const int row0 = u.pm * BM + wr * 64 + fr, col0 = u.pn * 128 + wc * 32 + 8 * fq;
#pragma unroll
        for (int ai = 0; ai < 2; ++ai)
#pragma unroll
            for (int m = 0; m < 4; ++m) { bf16_t* rowp = O + (size_t)(row0 + ai * HALF + m * 16) * ldc + col0;
                const f32x4 g0 = acc[ai][0][m][0], g1 = acc[ai][0][m][1], u0 = acc[ai][1][m][0], u1 = acc[ai][1][m][1];
                f32x4 v0, v1;
#pragma unroll
                for (int j = 0; j < 4; ++j) { v0[j] = silu_f(g0[j]) * u0[j]; v1[j] = silu_f(g1[j]) * u1[j]; }
                u32x4 w; w.x = cvt_pk_bf16(v0[0], v0[1]); w.y = cvt_pk_bf16(v0[2], v0[3]); w.z = cvt_pk_bf16(v1[0], v1[1]); w.w = cvt_pk_bf16(v1[2], v1[3]);
                *(u32x4*)rowp = w; }
    }
};
struct EpiResid {
    static constexpr bool PERM = false, AFTER_DRAIN = false;
    const float* base; float* out; const float* gate; int gstride; int rows_per_batch; float scale;
    __device__ __forceinline__ void operator()(const f32x4 (&acc)[2][2][4][2], const Unit& u, int wr, int wc, int fr, int fq) const {
        const int row0 = u.pm * BM + wr * 64 + fr, col0 = u.pn * BM + wc * 32 + 4 * fq;
        const float* gp = gate + (size_t)((u.pm * BM) / rows_per_batch) * gstride + col0;
        f32x4 gv[2][2];
#pragma unroll
        for (int bj = 0; bj < 2; ++bj)
#pragma unroll
            for (int n = 0; n < 2; ++n) gv[bj][n] = *(const f32x4*)(gp + bj * HALF + n * 16) * scale;
#pragma unroll
        for (int ai = 0; ai < 2; ++ai)
#pragma unroll
            for (int m = 0; m < 4; ++m) { const size_t off = (size_t)(row0 + ai * HALF + m * 16) * 1024 + col0;
#pragma unroll
                for (int bj = 0; bj < 2; ++bj)
#pragma unroll
                    for (int n = 0; n < 2; ++n) { const f32x4 bs = *(const f32x4*)(base + off + bj * HALF + n * 16); *(f32x4*)(out + off + bj * HALF + n * 16) = bs + gv[bj][n] * acc[ai][bj][m][n]; }
                asm volatile("" ::: "memory"); }
    }
};
struct EpiInProj {
    static constexpr bool PERM = true, AFTER_DRAIN = false;
    bf16_t *ZQ, *ZV, *ZG, *ZRX, *ZRG; float *ZLF, *ZLB; const float *LBF, *LBB;
    __device__ __forceinline__ void operator()(const f32x4 (&acc)[2][2][4][2], const Unit& u, int wr, int wc, int fr, int fq) const {
        const int row0 = u.pm * BM + wr * 64 + fr, seg = u.pn >> 1, cs0 = (u.pn & 1) * 256 + wc * 32 + 8 * fq;
        if (seg == 1 || seg == 2) {
            float* Z = seg == 1 ? ZLF : ZLB; const float* LB = seg == 1 ? LBF : LBB;
#pragma unroll
            for (int bj = 0; bj < 2; ++bj) { const f32x4 l0 = *(const f32x4*)(LB + cs0 + bj * HALF), l1 = *(const f32x4*)(LB + cs0 + bj * HALF + 4);
#pragma unroll
                for (int ai = 0; ai < 2; ++ai)
#pragma unroll
                    for (int m = 0; m < 4; ++m) { float* rowp = Z + (size_t)(row0 + ai * HALF + m * 16) * 512 + cs0 + bj * HALF;
                        const f32x4 a0 = acc[ai][bj][m][0], a1 = acc[ai][bj][m][1]; f32x4 v0, v1;
#pragma unroll
                        for (int j = 0; j < 4; ++j) { v0[j] = __builtin_amdgcn_logf(l0[j] + (1.0f - l0[j]) * sigmoid_f(a0[j])); v1[j] = __builtin_amdgcn_logf(l1[j] + (1.0f - l1[j]) * sigmoid_f(a1[j])); }
                        *(f32x4*)rowp = v0; *(f32x4*)(rowp + 4) = v1; } }
        } else {
            bf16_t* Z = seg == 0 ? ZQ : seg == 3 ? ZV : seg == 4 ? ZG : seg == 5 ? ZRX : ZRG;
            const int act = (seg == 0 || seg == 4) ? 1 : (seg == 6 ? 2 : 0);
#pragma unroll
            for (int ai = 0; ai < 2; ++ai)
#pragma unroll
                for (int m = 0; m < 4; ++m) { bf16_t* rowp = Z + (size_t)(row0 + ai * HALF + m * 16) * 512 + cs0;
#pragma unroll
                    for (int bj = 0; bj < 2; ++bj) { f32x4 v0 = acc[ai][bj][m][0], v1 = acc[ai][bj][m][1];
                        if (act == 1) {
#pragma unroll
                            for (int j = 0; j < 4; ++j) { v0[j] = silu_f(v0[j]); v1[j] = silu_f(v1[j]); } }
                        else if (act == 2) {
#pragma unroll
                            for (int j = 0; j < 4; ++j) { v0[j] = gelu_tanh_f(v0[j]); v1[j] = gelu_tanh_f(v1[j]); } }
                        u32x4 w; w.x = cvt_pk_bf16(v0[0], v0[1]); w.y = cvt_pk_bf16(v0[2], v0[3]); w.z = cvt_pk_bf16(v1[0], v1[1]); w.w = cvt_pk_bf16(v1[2], v1[3]);
                        *(u32x4*)(rowp + bj * HALF) = w; } }
        }
    }
};
template <class Epi, class Sched, bool ALIGN_EPI = false, bool SP2 = false>
__device__ __forceinline__ void gemm_phase(PG8_LAS unsigned char* lds, const Gemm g, const Sched& S, const Epi& E) {
    const int tid = threadIdx.x, wid = __builtin_amdgcn_readfirstlane(tid >> 6), lane = tid & 63, wr = wid >> 2, wc = wid & 3, fr = lane & 15, fq = lane >> 4;
    const int K = g.K, nt = K / BK;
    unsigned voffA[2], voffB[2];
#pragma unroll
    for (int i = 0; i < 2; ++i) { int R, C; stage_rc(tid * 16 + i * 8192, R, C); const int Rb = Epi::PERM ? ((R & ~31) + perm32(R & 31)) : R;
        voffA[i] = (unsigned)(R * K + C) * 2u; voffB[i] = (unsigned)(Rb * K + C) * 2u; }
    const size_t kstep = (size_t)(BK * 2);
    const size_t hstep = (size_t)HALF * K * 2;
    const size_t tstep = 2 * hstep;
    const unsigned ldsw = (unsigned)wid * 1024u;
    const int aoff = lds_byte(wr * 64 + fr, fq * 8), boff = lds_byte(wc * 32 + fr, fq * 8);
#define PG8_SA(b, h) (((b) * 2 + (h)) * HTB)
#define PG8_SB(b, h) ((4 + (b) * 2 + (h)) * HTB)
#define PG8_STAGE(bufoff, gbase, voff) do { _Pragma("unroll") for (int _i = 0; _i < 2; ++_i) \
        __builtin_amdgcn_global_load_lds((const unsigned*)((const char*)(gbase) + (voff)[_i]), (PG8_LAS unsigned*)(lds + (bufoff) + ldsw + _i * 8192), 16, 0, 0); } while (0)
#define PG8_LDA(dst, b, h) do { _Pragma("unroll") for (int m = 0; m < 4; ++m) _Pragma("unroll") for (int k = 0; k < 2; ++k) dst[m][k] = *(const PG8_LAS bf16x8*)(lds + PG8_SA(b, h) + aoff + m * 2048 + k * 1024); } while (0)
#define PG8_LDB(dst, b, h) do { _Pragma("unroll") for (int n = 0; n < 2; ++n) _Pragma("unroll") for (int k = 0; k < 2; ++k) dst[n][k] = *(const PG8_LAS bf16x8*)(lds + PG8_SB(b, h) + boff + n * 2048 + k * 1024); } while (0)
#define PG8_MMA(ai, bj, At, Bt) do { __builtin_amdgcn_s_setprio(1); _Pragma("unroll") for (int m = 0; m < 4; ++m) _Pragma("unroll") for (int n = 0; n < 2; ++n) _Pragma("unroll") for (int k = 0; k < 2; ++k) \
        acc[ai][bj][m][n] = __builtin_amdgcn_mfma_f32_16x16x32_bf16(Bt[n][k], At[m][k], acc[ai][bj][m][n], 0, 0, 0); __builtin_amdgcn_s_setprio(0); } while (0)
#define PG8_WAIT_V(n) asm volatile("s_waitcnt vmcnt(" #n ")" ::: "memory")
#define PG8_WAIT_L(n) asm volatile("s_waitcnt lgkmcnt(" #n ")" ::: "memory")
#define PG8_BAR __builtin_amdgcn_s_barrier()
#define PG8_SCHED __builtin_amdgcn_sched_barrier(0)
    Unit cur, nxt; int ui = 0;
    if (!S.next(0, cur)) return;
    f32x4 acc[2][2][4][2];
#pragma unroll
    for (int a = 0; a < 2; ++a)
#pragma unroll
        for (int b = 0; b < 2; ++b)
#pragma unroll
            for (int m = 0; m < 4; ++m)
#pragma unroll
                for (int n = 0; n < 2; ++n) acc[a][b][m][n] = (f32x4){0.f, 0.f, 0.f, 0.f};
    bf16x8 At[4][2], B0[2][2], B1[2][2];
    const char* cA = (const char*)g.A + (size_t)cur.pm * tstep; const char* cB = (const char*)g.Bt + (size_t)cur.pn * tstep;
    S.a_ready(cur);
    if constexpr (SP2) {
        PG8_STAGE(PG8_SB(0, 0), cB, voffB); PG8_STAGE(PG8_SB(0, 1), cB + hstep, voffB); PG8_STAGE(PG8_SA(0, 0), cA, voffA); PG8_STAGE(PG8_SA(0, 1), cA + hstep, voffA);
        if (wr == 1) PG8_BAR;
        PG8_WAIT_V(2); PG8_BAR;
        PG8_STAGE(PG8_SB(1, 0), cB + kstep, voffB); PG8_STAGE(PG8_SA(1, 0), cA + kstep, voffA); PG8_STAGE(PG8_SB(1, 1), cB + hstep + kstep, voffB);
        PG8_WAIT_V(6); PG8_BAR;
    } else {
        PG8_STAGE(PG8_SB(0, 0), cB, voffB); PG8_STAGE(PG8_SA(0, 0), cA, voffA); PG8_STAGE(PG8_SB(0, 1), cB + hstep, voffB); PG8_STAGE(PG8_SA(0, 1), cA + hstep, voffA);
        if (wr == 1) PG8_BAR;
        PG8_WAIT_V(4); PG8_BAR;
        PG8_STAGE(PG8_SB(1, 0), cB + kstep, voffB); PG8_STAGE(PG8_SA(1, 0), cA + kstep, voffA); PG8_STAGE(PG8_SB(1, 1), cB + hstep + kstep, voffB);
        PG8_WAIT_V(6); PG8_BAR;
    }
    for (;;) {
        const bool has_next = S.next(ui + 1, nxt);
        const char* nA = has_next ? (const char*)g.A + (size_t)nxt.pm * tstep : cA; const char* nB = has_next ? (const char*)g.Bt + (size_t)nxt.pn * tstep : cB;
        for (int t = 0; t < nt; t += 2) {
            const bool last = (t == nt - 2);
            const char* a1 = cA + (size_t)(t + 1) * kstep;
            const char* a2 = last ? nA : cA + (size_t)(t + 2) * kstep; const char* b2 = last ? nB : cB + (size_t)(t + 2) * kstep;
            const char* a3 = a2 + kstep; const char* b3 = b2 + kstep;
            if (last && has_next) S.a_ready(nxt);
            if constexpr (SP2) {
            PG8_LDB(B0, 0, 0); PG8_LDB(B1, 0, 1); PG8_SCHED; PG8_LDA(At, 0, 0); PG8_STAGE(PG8_SA(1, 1), a1 + hstep, voffA);
            PG8_WAIT_V(8); PG8_WAIT_L(0); PG8_BAR; PG8_MMA(0, 0, At, B0); PG8_MMA(0, 1, At, B1); PG8_BAR; PG8_SCHED;
            PG8_LDA(At, 0, 1); PG8_STAGE(PG8_SB(0, 0), b2, voffB); PG8_STAGE(PG8_SB(0, 1), b2 + hstep, voffB); PG8_STAGE(PG8_SA(0, 0), a2, voffA);
            PG8_WAIT_V(8); PG8_WAIT_L(0); PG8_BAR; PG8_MMA(1, 0, At, B0); PG8_MMA(1, 1, At, B1); PG8_BAR; PG8_SCHED;
            PG8_LDB(B0, 1, 0); PG8_LDB(B1, 1, 1); PG8_SCHED; PG8_LDA(At, 1, 0); PG8_STAGE(PG8_SA(0, 1), a2 + hstep, voffA);
            PG8_WAIT_V(8); PG8_WAIT_L(0); PG8_BAR; PG8_MMA(0, 0, At, B0); PG8_MMA(0, 1, At, B1); PG8_BAR; PG8_SCHED;
            PG8_LDA(At, 1, 1); PG8_STAGE(PG8_SB(1, 0), b3, voffB); PG8_STAGE(PG8_SB(1, 1), b3 + hstep, voffB); PG8_STAGE(PG8_SA(1, 0), a3, voffA);
            PG8_WAIT_V(8); PG8_WAIT_L(0); PG8_BAR; PG8_MMA(1, 0, At, B0); PG8_MMA(1, 1, At, B1); PG8_BAR; PG8_SCHED;
            } else {
            PG8_LDB(B0, 0, 0); PG8_SCHED; PG8_LDA(At, 0, 0); PG8_STAGE(PG8_SA(1, 1), a1 + hstep, voffA);
            PG8_WAIT_L(8); PG8_BAR; PG8_WAIT_L(0); PG8_MMA(0, 0, At, B0); PG8_BAR; PG8_SCHED;
            PG8_LDB(B1, 0, 1); PG8_STAGE(PG8_SB(0, 0), b2, voffB);
            PG8_BAR; PG8_WAIT_L(0); PG8_MMA(0, 1, At, B1); PG8_BAR;
            PG8_LDA(At, 0, 1); PG8_STAGE(PG8_SA(0, 0), a2, voffA);
            PG8_BAR; PG8_WAIT_L(0); PG8_MMA(1, 0, At, B0); PG8_BAR; PG8_SCHED;
            PG8_STAGE(PG8_SB(0, 1), b2 + hstep, voffB);
            PG8_WAIT_V(6); PG8_BAR; PG8_MMA(1, 1, At, B1); PG8_BAR;
            PG8_LDB(B0, 1, 0); PG8_SCHED; PG8_LDA(At, 1, 0); PG8_STAGE(PG8_SA(0, 1), a2 + hstep, voffA);
            PG8_WAIT_L(8); PG8_BAR; PG8_WAIT_L(0); PG8_MMA(0, 0, At, B0); PG8_BAR; PG8_SCHED;
            PG8_LDB(B1, 1, 1); PG8_STAGE(PG8_SB(1, 0), b3, voffB);
            PG8_BAR; PG8_WAIT_L(0); PG8_MMA(0, 1, At, B1); PG8_BAR;
            PG8_LDA(At, 1, 1); PG8_STAGE(PG8_SA(1, 0), a3, voffA);
            PG8_BAR; PG8_WAIT_L(0); PG8_MMA(1, 0, At, B0); PG8_BAR; PG8_SCHED;
            PG8_STAGE(PG8_SB(1, 1), b3 + hstep, voffB);
            PG8_WAIT_V(6); PG8_BAR; PG8_MMA(1, 1, At, B1); PG8_BAR;
            }
        }
        if constexpr (ALIGN_EPI) { if (wr == 0) PG8_BAR; }
        if constexpr (!Epi::AFTER_DRAIN) { E(acc, cur, wr, wc, fr, fq); S.done(cur); }
        if (!has_next) break;
#pragma unroll
        for (int a = 0; a < 2; ++a)
#pragma unroll
            for (int b = 0; b < 2; ++b)
#pragma unroll
                for (int m = 0; m < 4; ++m)
#pragma unroll
                    for (int n = 0; n < 2; ++n) acc[a][b][m][n] = (f32x4){0.f, 0.f, 0.f, 0.f};
        cur = nxt; cA = nA; cB = nB; ++ui;
        if constexpr (ALIGN_EPI) { if (wr == 1) PG8_BAR; }
    }
    PG8_WAIT_V(0);
    if constexpr (!ALIGN_EPI) { if (wr == 0) PG8_BAR; }
    PG8_BAR;
    if constexpr (Epi::AFTER_DRAIN) { E.fused(acc, cur, wr, wc, fr, fq, lds, wid, lane); S.done(cur); }
#undef PG8_SA
#undef PG8_SB
#undef PG8_STAGE
#undef PG8_LDA
#undef PG8_LDB
#undef PG8_MMA
#undef PG8_WAIT_V
#undef PG8_WAIT_L
#undef PG8_BAR
#undef PG8_SCHED
}
}
#define GAS __attribute__((address_space(1)))
#define LAS __attribute__((address_space(3)))
typedef unsigned short bf16;
typedef unsigned v4u __attribute__((ext_vector_type(4)));
typedef float f32x4 __attribute__((ext_vector_type(4)));
typedef short bf16x8 __attribute__((ext_vector_type(8)));
typedef GAS unsigned gu32;
typedef GAS unsigned long long gu64;
#define RLX_AGENT __ATOMIC_RELAXED, __HIP_MEMORY_SCOPE_AGENT
#define LDS_WAIT() asm volatile("s_waitcnt lgkmcnt(0)" ::: "memory")
#define VM_WAIT() asm volatile("s_waitcnt vmcnt(0)" ::: "memory")
__device__ __forceinline__ unsigned long long rt() { return __builtin_amdgcn_s_memrealtime(); }
__device__ __forceinline__ unsigned f2bf(float f) { unsigned u = __builtin_bit_cast(unsigned, f); return (u + 0x7fffu + ((u >> 16) & 1u)) >> 16; }
__device__ __forceinline__ unsigned pk2(float lo, float hi) { return f2bf(lo) | (f2bf(hi) << 16); }

#define XB_TMO      128
#define XB_XCNT(j)  (256  + 64 * (j))
#define XB_XSUB(j)  (1280 + 64 * (j))
#define XB_XGEN(j)  (2304 + 64 * (j))
#define XB_TOP      3328
#define XB_TOPGEN   3392
#define XCD_BAR_WORDS 3456
#define XB_SPIN_CAP (1u << 23)

__device__ __forceinline__ unsigned xb_ld(unsigned* p)              { return __hip_atomic_load(p, __ATOMIC_RELAXED, __HIP_MEMORY_SCOPE_AGENT); }
__device__ __forceinline__ unsigned xb_add(unsigned* p, unsigned v) { return __hip_atomic_fetch_add(p, v, __ATOMIC_RELAXED, __HIP_MEMORY_SCOPE_AGENT); }
__device__ __forceinline__ unsigned xb_xcc_id() { return (unsigned)__builtin_amdgcn_s_getreg((3 << 11) | 20) & 0xFu; }
#define XB_SPIN(cond, bar) do { unsigned _sp = 0; while (cond) { __builtin_amdgcn_s_sleep(1); \
    if ((++_sp & 255u) == 0u) { if (xb_ld(&(bar)[XB_TMO])) break; if (_sp > XB_SPIN_CAP) { atomicAdd(&(bar)[XB_TMO], 1u); break; } } } } while (0)

struct XcdBarrier {
    unsigned* bar; unsigned x;
    volatile LAS unsigned* st;
};

__device__ __forceinline__ XcdBarrier xcd_barrier_post(unsigned* bar, volatile LAS unsigned* st) {
    XcdBarrier b; b.bar = bar; b.x = xb_xcc_id(); b.st = st;
    if (threadIdx.x == 0) (void)xb_add(&bar[XB_XCNT(b.x)], 1u);
    return b;
}
__device__ __forceinline__ void xcd_barrier_complete(unsigned* bar, unsigned x, unsigned& nloc, unsigned& nx) {
    const unsigned G = gridDim.x * gridDim.y * gridDim.z;
    unsigned sum, cnt, mine, sp = 0u;
    for (;;) {
        sum = 0u; cnt = 0u; mine = 0u;
#pragma unroll
        for (unsigned j = 0; j < 16; ++j) { const unsigned c = xb_ld(&bar[XB_XCNT(j)]); sum += c; cnt += (c > 0u) ? 1u : 0u; mine = (j == x) ? c : mine; }
        if (sum == G) break;
        __builtin_amdgcn_s_sleep(1);
        if ((++sp & 255u) == 0u) { if (xb_ld(&bar[XB_TMO])) break; if (sp > XB_SPIN_CAP) { atomicAdd(&bar[XB_TMO], 1u); break; } }
    }
    nloc = mine > 0u ? mine : 1u; nx = cnt > 0u ? cnt : 1u;
}

__device__ __forceinline__ void xcd_barrier(const XcdBarrier& b) {
    asm volatile("s_waitcnt vmcnt(0)" ::: "memory");
    __syncthreads();
    if (threadIdx.x == 0) {
        unsigned* bar = b.bar;
        __builtin_amdgcn_s_waitcnt(0);
        unsigned nloc = b.st[0], nx = b.st[1];
        if (nloc == 0u) { xcd_barrier_complete(bar, b.x, nloc, nx); b.st[0] = nloc; b.st[1] = nx; }
        const unsigned old = xb_add(&bar[XB_XSUB(b.x)], 1u);
        const unsigned gen = old / nloc;
        if (old + 1u == (gen + 1u) * nloc) {
            __builtin_amdgcn_fence(__ATOMIC_RELEASE, "agent");
            asm volatile("s_waitcnt vmcnt(0)" ::: "memory");
            const unsigned og = xb_add(&bar[XB_TOP], 1u);
            const unsigned tg = og / nx;
            if (og + 1u == (tg + 1u) * nx) xb_add(&bar[XB_TOPGEN], 1u);
            else XB_SPIN(xb_ld(&bar[XB_TOPGEN]) == tg, bar);
            __builtin_amdgcn_fence(__ATOMIC_ACQUIRE, "agent");
            xb_add(&bar[XB_XGEN(b.x)], 1u);
            asm volatile("s_waitcnt vmcnt(0)" ::: "memory");
        } else {
            XB_SPIN(xb_ld(&bar[XB_XGEN(b.x)]) == gen, bar);
            __builtin_amdgcn_fence(__ATOMIC_ACQUIRE, "agent");
            asm volatile("s_waitcnt vmcnt(0)" ::: "memory");
        }
    }
    __syncthreads();
}
constexpr int NWAVES = 8;
constexpr int BATCH = 2, T = 16384, D = 1024, FF = 2816, NIN = 3584, DH = 512, NMOD = 9 * D;
constexpr int M = BATCH * T;
constexpr float EPS = 1e-6f;
constexpr size_t MiB = 1u << 20;
constexpr size_t WS_CTL = 0, CTL_ZERO_BYTES = 1 * MiB;
constexpr size_t WS_MOD = 1 * MiB;
constexpr size_t WS_LBF = WS_MOD + 128 * 1024, WS_LBB = WS_LBF + 4096, WS_RGCL = WS_LBB + 4096;
constexpr size_t WS_RGTOT = 2 * MiB;
constexpr size_t WS_DG = 3 * MiB;
constexpr size_t WS_W13A = 4 * MiB, WS_W13B = 15 * MiB, WS_W2A = 26 * MiB, WS_W2B = 32 * MiB, WS_WIN = 38 * MiB, WS_WOUT = 45 * MiB, WS_RGW = 47 * MiB;
constexpr size_t WS_XN = 48 * MiB;
constexpr size_t WS_HB = 112 * MiB;
constexpr size_t WS_ZQ = 112 * MiB, WS_ZV = 144 * MiB, WS_ZG = 176 * MiB, WS_ZRX = 208 * MiB, WS_ZRG = 240 * MiB, WS_ZLF = 272 * MiB, WS_ZLB = 336 * MiB;
constexpr size_t WS_SG = 400 * MiB;
constexpr size_t WS_OB = 464 * MiB;
constexpr size_t WS_END = 496 * MiB;
static_assert(WS_HB + (size_t)M * FF * 2 <= WS_SG && WS_ZLB + (size_t)M * DH * 4 <= WS_SG && WS_W13A + (size_t)2 * FF * D * 2 <= WS_W13B && WS_W2A + (size_t)D * FF * 2 <= WS_W2B && WS_WIN + (size_t)NIN * D * 2 <= WS_WOUT, "ws map");
constexpr int CW_BAR = 4096;
constexpr int RING_OFF = 0, RING_BYTES = 131072;
constexpr int LDSCTL_OFF = RING_BYTES, MISC_OFF = LDSCTL_OFF + 320;
constexpr int LDS_BYTES = 147456;

struct Frame {
    LAS unsigned char* lds;
    volatile LAS unsigned* MISC;
    gu32* ctl;
    int tid, lane, wave, G, bid;
    const float* in[31]; float* out; unsigned char* ws;
};
__device__ __forceinline__ float wave_sum(float v) {
#pragma unroll
    for (int o = 1; o < 64; o <<= 1) v += __shfl_xor(v, o);
    return v;
}
__device__ __forceinline__ float bf2f(unsigned short b) { return __builtin_bit_cast(float, ((unsigned)b) << 16); }
__device__ __forceinline__ float bflo(unsigned w) { return __builtin_bit_cast(float, w << 16); }
__device__ __forceinline__ float bfhi(unsigned w) { return __builtin_bit_cast(float, w & 0xffff0000u); }
__device__ __forceinline__ float sigmoidf_(float x) { return __builtin_amdgcn_rcpf(1.0f + __builtin_amdgcn_exp2f(-1.44269504f * x)); }

__device__ __forceinline__ void p0_transpose_item(const float* W, int K, int N, bf16* WT, int k0, int n0, int drow0, LAS float* scr, int lane) {
#pragma unroll 8
    for (int i = 0; i < 32; ++i) { const int kk = 2 * i + (lane >> 5); scr[kk * 33 + (lane & 31)] = W[(size_t)(k0 + kk) * N + n0 + (lane & 31)]; }
    LDS_WAIT(); asm volatile("" ::: "memory");
    const int c = lane & 7;
#pragma unroll
    for (int j = 0; j < 4; ++j) { const int n = (lane >> 3) + 8 * j; const LAS float* s = scr + (8 * c) * 33 + n;
        v4u o; o.x = pk2(s[0 * 33], s[1 * 33]); o.y = pk2(s[2 * 33], s[3 * 33]); o.z = pk2(s[4 * 33], s[5 * 33]); o.w = pk2(s[6 * 33], s[7 * 33]);
        *(GAS v4u*)(WT + (size_t)(drow0 + n) * K + k0 + 8 * c) = o; }
    LDS_WAIT(); asm volatile("" ::: "memory");
}
__device__ __forceinline__ void p0_item_w13(const float* W, int mat, bf16* WT, int item, LAS float* scr, int lane) {
    const int nblk = FF / 32, kb = item / nblk, nb = item % nblk, n0 = 32 * nb;
    p0_transpose_item(W, D, FF, WT, 64 * kb, n0, 256 * (n0 / 128) + 128 * mat + (n0 % 128), scr, lane);
}
__device__ __forceinline__ void p0_item_plain(const float* W, int K, int N, bf16* WT, int item, LAS float* scr, int lane) {
    const int nblk = N / 32, kb = item / nblk, nb = item % nblk;
    p0_transpose_item(W, K, N, WT, 64 * kb, 32 * nb, 32 * nb, scr, lane);
}

__device__ __forceinline__ void p0a(Frame& F) {
    LAS float* L = (LAS float*)(F.lds + RING_OFF);
    const float* c = F.in[1]; const float* w_ada = F.in[2]; const float* b_ada = F.in[3];
    float* MOD = (float*)(F.ws + WS_MOD);
    for (int gi = F.bid; gi < NMOD / 64; gi += F.G) {
        for (int i = F.tid; i < 2 * D; i += NWAVES * 64) { const float v = c[i]; L[i] = v * sigmoidf_(v); }
        __syncthreads();
        const int n = 64 * gi + F.lane; float a0 = 0.f, a1 = 0.f; const float* wp = w_ada + (size_t)(128 * F.wave) * NMOD + n;
#pragma unroll 16
        for (int k = 0; k < 128; ++k) { const float wv = wp[(size_t)k * NMOD]; a0 += wv * L[128 * F.wave + k]; a1 += wv * L[D + 128 * F.wave + k]; }
        L[2 * D + (F.wave * 2 + 0) * 64 + F.lane] = a0; L[2 * D + (F.wave * 2 + 1) * 64 + F.lane] = a1;
        __syncthreads();
        if (F.wave < 2) { float s = b_ada[n];
#pragma unroll
            for (int w = 0; w < 8; ++w) s += L[2 * D + (w * 2 + F.wave) * 64 + F.lane];
            MOD[F.wave * NMOD + n] = s; }
        __syncthreads();
    }
    if (F.bid == F.G - 1) {
        const float* lbf = F.in[10]; const float* lbb = F.in[11]; float* LBF = (float*)(F.ws + WS_LBF); float* LBB = (float*)(F.ws + WS_LBB); float* CL = (float*)(F.ws + WS_RGCL);
        for (int i = F.tid; i < DH; i += NWAVES * 64) {
            LBF[i] = sigmoidf_(lbf[DH + i] - lbf[i]); LBB[i] = sigmoidf_(lbb[DH + i] - lbb[i]);
            const float lf = F.in[19][i], lb = F.in[24][i];
            CL[i] = -8.0f * 1.44269504f * log1pf(expf(-lf)); CL[DH + i] = -8.0f * 1.44269504f * log1pf(expf(-lb));
        }
    }
    LAS float* scr = (LAS float*)(F.lds + RING_OFF + 16384 + F.wave * 12288);
    const int gw = F.bid * NWAVES + F.wave, NGW = F.G * NWAVES;
    constexpr int I_13 = (D / 64) * (FF / 32), I_2 = (FF / 64) * (D / 32), I_IN = (D / 64) * (NIN / 32), I_OUT = (D / 64) * (D / 32), I_RG = 2;
    constexpr int NITEMS = 4 * I_13 + 2 * I_2 + I_IN + I_OUT + 32 * I_RG;
    for (int it = gw; it < NITEMS; it += NGW) {
        int r = it;
        if (r < I_13) { p0_item_w13(F.in[5], 0, (bf16*)(F.ws + WS_W13A), r, scr, F.lane); continue; } r -= I_13;
        if (r < I_13) { p0_item_w13(F.in[6], 1, (bf16*)(F.ws + WS_W13A), r, scr, F.lane); continue; } r -= I_13;
        if (r < I_13) { p0_item_w13(F.in[27], 0, (bf16*)(F.ws + WS_W13B), r, scr, F.lane); continue; } r -= I_13;
        if (r < I_13) { p0_item_w13(F.in[28], 1, (bf16*)(F.ws + WS_W13B), r, scr, F.lane); continue; } r -= I_13;
        if (r < I_2) { p0_item_plain(F.in[7], FF, D, (bf16*)(F.ws + WS_W2A), r, scr, F.lane); continue; } r -= I_2;
        if (r < I_2) { p0_item_plain(F.in[29], FF, D, (bf16*)(F.ws + WS_W2B), r, scr, F.lane); continue; } r -= I_2;
        if (r < I_IN) { p0_item_plain(F.in[9], D, NIN, (bf16*)(F.ws + WS_WIN), r, scr, F.lane); continue; } r -= I_IN;
        if (r < I_OUT) { p0_item_plain(F.in[25], D, D, (bf16*)(F.ws + WS_WOUT), r, scr, F.lane); continue; } r -= I_OUT;
        { const int mb = r / I_RG, half = r % I_RG, mat = mb >> 3, blk = mb & 7;
          const float* src = (mat == 0 ? F.in[15] : mat == 1 ? F.in[17] : mat == 2 ? F.in[20] : F.in[22]) + (size_t)blk * 4096;
          p0_transpose_item(src, 64, 64, (bf16*)(F.ws + WS_RGW) + (size_t)mb * 4096, 0, 32 * half, 32 * half, scr, F.lane); }
    }
}

__device__ __forceinline__ void norm_rows(Frame& F, const float* xin, const float* gain, const float* sh, const float* sc, bf16* XN) {
    const int gw = F.bid * NWAVES + F.wave, NGW = F.G * NWAVES;
    for (int m = gw; m < M; m += NGW) {
        const int b = m >= T ? 1 : 0;
        const GAS f32x4* xr = (const GAS f32x4*)(xin + (size_t)m * D) + F.lane;
        f32x4 v[4]; float s = 0.f;
#pragma unroll
        for (int j = 0; j < 4; ++j) { v[j] = xr[64 * j]; s += (v[j].x * v[j].x + v[j].y * v[j].y) + (v[j].z * v[j].z + v[j].w * v[j].w); }
        const float rstd = rsqrtf(wave_sum(s) * (1.f / D) + EPS);
        GAS unsigned long long* o8 = (GAS unsigned long long*)(XN + (size_t)m * D) + F.lane;
#pragma unroll
        for (int j = 0; j < 4; ++j) {
            const f32x4 g = *((const f32x4*)gain + 64 * j + F.lane), s1 = *((const f32x4*)(sc + (size_t)b * NMOD) + 64 * j + F.lane), s0 = *((const f32x4*)(sh + (size_t)b * NMOD) + 64 * j + F.lane);
            const f32x4 h = v[j] * rstd * g * (s1 + 1.0f) + s0;
            o8[64 * j] = (unsigned long long)pk2(h.x, h.y) | ((unsigned long long)pk2(h.z, h.w) << 32);
        }
    }
}
__device__ __forceinline__ void final_norm_rows(Frame& F, float* x, const float* gain) {
    const int gw = F.bid * NWAVES + F.wave, NGW = F.G * NWAVES;
    for (int m = gw; m < M; m += NGW) {
        GAS f32x4* xr = (GAS f32x4*)(x + (size_t)m * D) + F.lane;
        f32x4 v[4]; float s = 0.f;
#pragma unroll
        for (int j = 0; j < 4; ++j) { v[j] = xr[64 * j]; s += (v[j].x * v[j].x + v[j].y * v[j].y) + (v[j].z * v[j].z + v[j].w * v[j].w); }
        const float rstd = rsqrtf(wave_sum(s) * (1.f / D) + EPS);
#pragma unroll
        for (int j = 0; j < 4; ++j) { const f32x4 g = *((const f32x4*)gain + 64 * j + F.lane); xr[64 * j] = v[j] * rstd * g; }
    }
}
__device__ __forceinline__ void hgrn2_naive(Frame& F, int ci) {
    const int dir = ci & 1, h = (ci >> 1) & 3, b = ci >> 3;
    LAS float* QS = (LAS float*)(F.lds + RING_OFF); LAS float* FS = QS + 2048; LAS float* KS = FS + 2048; LAS float* VS = KS + 2048; LAS float* PART = VS + 2048;
    const bf16* ZQ = (const bf16*)(F.ws + WS_ZQ); const bf16* ZV = (const bf16*)(F.ws + WS_ZV); const float* ZL = (const float*)(F.ws + (dir ? WS_ZLB : WS_ZLF));
    float* OF = (float*)(F.ws + WS_SG); bf16* OB = (bf16*)(F.ws + WS_OB);
    const int v = F.tid & 127, kq = F.tid >> 7;
    float S[32];
#pragma unroll
    for (int i = 0; i < 32; ++i) S[i] = 0.f;
    for (int tl = 0; tl < T / 16; ++tl) {
        { const int tt = F.tid >> 5, k4 = (F.tid & 31) * 4; const int p = 16 * tl + tt, t = dir ? (T - 1 - p) : p; const size_t off = (size_t)(b * T + t) * DH + h * 128 + k4;
          const uint2 qw = *(const uint2*)(ZQ + off); const uint2 vw = *(const uint2*)(ZV + off); const f32x4 lg = *(const f32x4*)(ZL + off);
          LAS float* q = QS + tt * 128 + k4; q[0] = bflo(qw.x); q[1] = bfhi(qw.x); q[2] = bflo(qw.y); q[3] = bfhi(qw.y);
          LAS float* vv = VS + tt * 128 + k4; vv[0] = bflo(vw.x); vv[1] = bfhi(vw.x); vv[2] = bflo(vw.y); vv[3] = bfhi(vw.y);
#pragma unroll
          for (int j = 0; j < 4; ++j) { const float f = __builtin_amdgcn_exp2f(lg[j]); FS[tt * 128 + k4 + j] = f; KS[tt * 128 + k4 + j] = 1.0f - f; } }
        __syncthreads();
        for (int tt = 0; tt < 16; ++tt) { const float vv = VS[tt * 128 + v]; float a = 0.f; const LAS float* fp = FS + tt * 128 + 32 * kq; const LAS float* kp = KS + tt * 128 + 32 * kq; const LAS float* qp = QS + tt * 128 + 32 * kq;
#pragma unroll
            for (int kk = 0; kk < 32; ++kk) { S[kk] = fp[kk] * S[kk] + kp[kk] * vv; a += S[kk] * qp[kk]; }
            PART[(kq * 16 + tt) * 128 + v] = a; }
        __syncthreads();
        { const int tt = F.tid >> 5, v4 = (F.tid & 31) * 4; const int p = 16 * tl + tt, t = dir ? (T - 1 - p) : p; const size_t off = (size_t)(b * T + t) * DH + h * 128 + v4;
          f32x4 o = {0.f, 0.f, 0.f, 0.f};
#pragma unroll
          for (int q = 0; q < 4; ++q) o += *(const LAS f32x4*)(PART + (q * 16 + tt) * 128 + v4);
          if (dir == 0) *(f32x4*)(OF + off) = o; else { uint2 w; w.x = pk2(o[0], o[1]); w.y = pk2(o[2], o[3]); *(uint2*)(OB + off) = w; } }
    }
}
__device__ __forceinline__ void rglru_seg(Frame& F, int pass) {
    const int b = F.bid >> 7, blk = (F.bid >> 4) & 7, sg = F.bid & 15;
    LAS float* L = (LAS float*)(F.lds + RING_OFF);
    for (int i = F.tid; i < 4 * 4096; i += NWAVES * 64) { const int mat = i >> 12; const float* src = mat == 0 ? F.in[15] : mat == 1 ? F.in[17] : mat == 2 ? F.in[20] : F.in[22]; L[i] = src[(size_t)blk * 4096 + (i & 4095)]; }
    __syncthreads();
    if (F.wave < 4) {
        const int seg = sg * 4 + F.wave, e = F.lane, ch = 64 * blk + e, t0 = seg * 256;
        const bf16* ZRX = (const bf16*)(F.ws + WS_ZRX); const bf16* ZRG = (const bf16*)(F.ws + WS_ZRG); bf16* YM = (bf16*)(F.ws + WS_XN);
        const float* CL = (const float*)(F.ws + WS_RGCL); float2* TOT = (float2*)(F.ws + WS_RGTOT);
        const float* cw = F.in[13]; const float c0 = cw[ch], c1 = cw[DH + ch], c2 = cw[2 * DH + ch], c3 = cw[3 * DH + ch], cb = F.in[14][ch];
        for (int dir = 0; dir < 2; ++dir) {
            const LAS float* wa = L + (2 * dir) * 4096 + e; const LAS float* wx = L + (2 * dir + 1) * 4096 + e;
            const float ba = (dir ? F.in[21] : F.in[16])[ch], bx = (dir ? F.in[23] : F.in[18])[ch], cl = CL[dir * DH + ch];
            float hs = 0.f, A = 1.f;
            if (pass == 1) {
                if (dir == 0) { for (int s = 0; s < seg; ++s) { const float2 tt = TOT[(size_t)((b * 64 + s) * 2 + 0) * DH + ch]; hs = tt.x * hs + tt.y; } }
                else { for (int s = 63; s > seg; --s) { const float2 tt = TOT[(size_t)((b * 64 + s) * 2 + 1) * DH + ch]; hs = tt.x * hs + tt.y; } }
            }
            for (int p = 0; p < 256; ++p) {
                const int t = dir ? (t0 + 255 - p) : (t0 + p); const size_t m = (size_t)b * T + t;
                const float x0 = t >= 2 ? bf2f(ZRX[(m - 2) * DH + ch]) : 0.f, x1 = t >= 1 ? bf2f(ZRX[(m - 1) * DH + ch]) : 0.f, x2 = bf2f(ZRX[m * DH + ch]), x3 = t + 1 < T ? bf2f(ZRX[(m + 1) * DH + ch]) : 0.f;
                const float xc = cb + c0 * x0 + c1 * x1 + c2 * x2 + c3 * x3;
                float rp = ba, ip = bx;
#pragma unroll 8
                for (int d = 0; d < 64; ++d) { const float xd = __shfl(xc, d); rp += xd * wa[d * 64]; ip += xd * wx[d * 64]; }
                const float r = sigmoidf_(rp), ii = sigmoidf_(ip), l2a = cl * r, a = __builtin_amdgcn_exp2f(l2a);
                const float u = sqrtf(fmaxf(1.0f - __builtin_amdgcn_exp2f(2.0f * l2a), 0.f)) * ii * xc;
                hs = a * hs + u; A *= a;
                if (pass == 1) { bf16* yp = YM + m * D + DH + ch;
                    if (dir == 0) *yp = (bf16)f2bf(hs); else *yp = (bf16)f2bf((bf2f(*yp) + hs) * bf2f(ZRG[m * DH + ch])); }
            }
            if (pass == 0) TOT[(size_t)((b * 64 + seg) * 2 + dir) * DH + ch] = make_float2(A, hs);
            asm volatile("s_waitcnt vmcnt(0)" ::: "memory");
        }
    }
    __syncthreads();
}
__device__ __forceinline__ void hgrn2_combine_rows(Frame& F) {
    const float* OF = (const float*)(F.ws + WS_SG); const bf16* OB = (const bf16*)(F.ws + WS_OB); const bf16* ZG = (const bf16*)(F.ws + WS_ZG); bf16* YM = (bf16*)(F.ws + WS_XN);
    const float* gn = F.in[12];
    const int gw = F.bid * NWAVES + F.wave, NGW = F.G * NWAVES;
    for (int m = gw; m < M; m += NGW) {
        const size_t off = (size_t)m * DH + 8 * F.lane;
        const f32x4 a0 = *(const f32x4*)(OF + off), a1 = *(const f32x4*)(OF + off + 4); const v4u bw = *(const v4u*)(OB + off), gwd = *(const v4u*)(ZG + off);
        float o[8] = {a0[0] + bflo(bw.x), a0[1] + bfhi(bw.x), a0[2] + bflo(bw.y), a0[3] + bfhi(bw.y), a1[0] + bflo(bw.z), a1[1] + bfhi(bw.z), a1[2] + bflo(bw.w), a1[3] + bfhi(bw.w)};
        float s = 0.f;
#pragma unroll
        for (int j = 0; j < 8; ++j) s += o[j] * o[j];
        s += __shfl_xor(s, 1); s += __shfl_xor(s, 2); s += __shfl_xor(s, 4); s += __shfl_xor(s, 8);
        const float rstd = rsqrtf(s * (1.f / 128.f) + EPS);
        const f32x4 g0 = *(const f32x4*)(gn + (8 * F.lane & 127)), g1 = *(const f32x4*)(gn + (8 * F.lane & 127) + 4);
        const float gg[8] = {bflo(gwd.x), bfhi(gwd.x), bflo(gwd.y), bfhi(gwd.y), bflo(gwd.z), bfhi(gwd.z), bflo(gwd.w), bfhi(gwd.w)};
        v4u w; w.x = pk2(o[0] * rstd * g0[0] * gg[0], o[1] * rstd * g0[1] * gg[1]); w.y = pk2(o[2] * rstd * g0[2] * gg[2], o[3] * rstd * g0[3] * gg[3]);
        w.z = pk2(o[4] * rstd * g1[0] * gg[4], o[5] * rstd * g1[1] * gg[5]); w.w = pk2(o[6] * rstd * g1[2] * gg[6], o[7] * rstd * g1[3] * gg[7]);
        *(v4u*)(YM + (size_t)m * D + 8 * F.lane) = w;
    }
}
struct Args { const float* in[31]; float* out; unsigned char* ws; };
__global__ void __launch_bounds__(NWAVES * 64, 2) hymba_fwd(Args args) {
    extern __shared__ __attribute__((aligned(16))) unsigned char lds[];
    Frame F;
    F.lds = (LAS unsigned char*)lds;
    F.MISC = (volatile LAS unsigned*)(F.lds + MISC_OFF);
    F.tid = threadIdx.x; F.lane = F.tid & 63; F.wave = __builtin_amdgcn_readfirstlane(F.tid >> 6);
    F.G = gridDim.x; F.bid = blockIdx.x;
#pragma unroll
    for (int i = 0; i < 31; ++i) F.in[i] = args.in[i];
    F.out = args.out; F.ws = args.ws;
    F.ctl = (gu32*)(F.ws + WS_CTL);
    for (int u = F.tid; u < (LDS_BYTES - LDSCTL_OFF) / 4; u += NWAVES * 64) ((LAS unsigned*)(F.lds + LDSCTL_OFF))[u] = 0u;
    __syncthreads();
    XcdBarrier bar = xcd_barrier_post((unsigned*)(F.ctl + CW_BAR), F.MISC + 8);
#define GRID_BAR() xcd_barrier(bar)
    unsigned char* ws = F.ws;
    const float* MOD = (const float*)(ws + WS_MOD);
    bf16* XN = (bf16*)(ws + WS_XN); bf16* HB = (bf16*)(ws + WS_HB);

    p0a(F); GRID_BAR();
    norm_rows(F, F.in[0], F.in[4], MOD + 0 * D, MOD + 1 * D, XN); GRID_BAR();
    { pg8::Gemm g{XN, (const bf16*)(ws + WS_W13A), M, 2 * FF, D}; pg8::StaticOrder S; S.init(M, 2 * FF, F.G, F.bid);
      pg8::EpiSwiGLU E{HB, FF};
      pg8::gemm_phase<pg8::EpiSwiGLU, pg8::StaticOrder, true, true>(F.lds + RING_OFF, g, S, E); GRID_BAR(); }
    { pg8::Gemm g{HB, (const bf16*)(ws + WS_W2A), M, D, FF}; pg8::StaticOrder S; S.init(M, D, F.G, F.bid);
      pg8::EpiResid E{F.in[0], F.out, MOD + 2 * D, NMOD, T, 0.5f};
      pg8::gemm_phase<pg8::EpiResid, pg8::StaticOrder, true, true>(F.lds + RING_OFF, g, S, E); GRID_BAR(); }
    norm_rows(F, F.out, F.in[8], MOD + 3 * D, MOD + 4 * D, XN); GRID_BAR();
    { pg8::Gemm g{XN, (const bf16*)(ws + WS_WIN), M, NIN, D}; pg8::StaticOrder S; S.init(M, NIN, F.G, F.bid);
      pg8::EpiInProj E{(bf16*)(ws + WS_ZQ), (bf16*)(ws + WS_ZV), (bf16*)(ws + WS_ZG), (bf16*)(ws + WS_ZRX), (bf16*)(ws + WS_ZRG), (float*)(ws + WS_ZLF), (float*)(ws + WS_ZLB), (const float*)(ws + WS_LBF), (const float*)(ws + WS_LBB)};
      pg8::gemm_phase<pg8::EpiInProj, pg8::StaticOrder, true, true>(F.lds + RING_OFF, g, S, E); GRID_BAR(); }
    rglru_seg(F, 0);
    if (F.bid < 16) hgrn2_naive(F, F.bid);
    GRID_BAR();
    rglru_seg(F, 1);
    hgrn2_combine_rows(F); GRID_BAR();
    { pg8::Gemm g{XN, (const bf16*)(ws + WS_WOUT), M, D, D}; pg8::StaticOrder S; S.init(M, D, F.G, F.bid);
      pg8::EpiResid E{F.out, F.out, MOD + 5 * D, NMOD, T, 1.0f};
      pg8::gemm_phase<pg8::EpiResid, pg8::StaticOrder, true, true>(F.lds + RING_OFF, g, S, E); GRID_BAR(); }
    norm_rows(F, F.out, F.in[26], MOD + 6 * D, MOD + 7 * D, XN); GRID_BAR();
    { pg8::Gemm g{XN, (const bf16*)(ws + WS_W13B), M, 2 * FF, D}; pg8::StaticOrder S; S.init(M, 2 * FF, F.G, F.bid);
      pg8::EpiSwiGLU E{HB, FF};
      pg8::gemm_phase<pg8::EpiSwiGLU, pg8::StaticOrder, true, true>(F.lds + RING_OFF, g, S, E); GRID_BAR(); }
    { pg8::Gemm g{HB, (const bf16*)(ws + WS_W2B), M, D, FF}; pg8::StaticOrder S; S.init(M, D, F.G, F.bid);
      pg8::EpiResid E{F.out, F.out, MOD + 8 * D, NMOD, T, 0.5f};
      pg8::gemm_phase<pg8::EpiResid, pg8::StaticOrder, true, true>(F.lds + RING_OFF, g, S, E); GRID_BAR(); }
    final_norm_rows(F, F.out, F.in[30]);
}

extern "C" void kernel_launch(void* const* d_in, const int* in_sizes, int n_in, void* d_out, int out_size, void* d_ws, size_t ws_size, hipStream_t stream) {
    static int grid = 0;
    if (grid == 0) {
        if (n_in != 31 || in_sizes[0] != M * D || out_size != M * D || ws_size < WS_END) { fprintf(stderr, "kernel_launch: unexpected shapes (n_in %d, in0 %d, out %d, ws %zu)\n", n_in, n_in > 0 ? in_sizes[0] : -1, out_size, ws_size); grid = -1; return; }
        int dev = 0, cus = 0;
        if (hipGetDevice(&dev) != hipSuccess || hipDeviceGetAttribute(&cus, hipDeviceAttributeMultiprocessorCount, dev) != hipSuccess) { grid = -1; return; }
        if (hipFuncSetAttribute((const void*)hymba_fwd, hipFuncAttributeMaxDynamicSharedMemorySize, LDS_BYTES) != hipSuccess) { fprintf(stderr, "kernel_launch: hipFuncSetAttribute failed\n"); grid = -1; return; }
        (void)hipGetLastError();
        grid = cus;
    }
    if (grid < 0) return;
    if (hipMemsetAsync((char*)d_ws + WS_CTL, 0, CTL_ZERO_BYTES, stream) != hipSuccess) return;
    Args a{};
    for (int i = 0; i < 31; ++i) a.in[i] = (const float*)d_in[i];
    a.out = (float*)d_out; a.ws = (unsigned char*)d_ws;
    hipLaunchKernelGGL(hymba_fwd, dim3(grid), dim3(NWAVES * 64), LDS_BYTES, stream, a);
}
```

```cpp
#include <hip/hip_runtime.h>
#include <cstdio>
#include <cstdint>
namespace pg8 {
#define PG8_LAS __attribute__((address_space(3)))
typedef unsigned short bf16_t;
typedef short bf16x8 __attribute__((ext_vector_type(8)));
typedef float f32x4 __attribute__((ext_vector_type(4)));
typedef unsigned u32x4 __attribute__((ext_vector_type(4)));
constexpr int BM = 256, BK = 64, HALF = 128, HTB = HALF * BK * 2  , STAGE_BYTES = 8 * HTB, NXCD = 8, WGM = 8;

__host__ __device__ __forceinline__ int lds_byte(int r, int c) { const int st = (r >> 4) * 2 + (c >> 5), rr = r & 15, cc = c & 31, ob = rr * 64 + cc * 2; return st * 1024 + (ob ^ (((ob >> 9) & 1) << 5)); }
__host__ __device__ __forceinline__ void stage_rc(int b, int& R, int& C) { const int st = b / 1024, sb = b % 1024, swz = sb ^ (((sb >> 9) & 1) << 5); R = (st >> 1) * 16 + swz / 64; C = (st & 1) * 32 + (swz % 64) / 2; }
__host__ __device__ __forceinline__ int perm32(int rho) { const int n = rho >> 4, i = rho & 15; return 8 * (i >> 2) + 4 * n + (i & 3); }

struct Unit { int pm, pn; };
struct Gemm { const bf16_t* A; const bf16_t* Bt; int M, N, K; size_t bt_batch_bytes; };

struct StaticOrder {
    int nM, nN, nwg, G, c;
    __host__ __device__ void init(int M, int N, int G_, int c_) { nM = M / BM; nN = N / BM; nwg = nM * nN; G = G_; c = c_; }
    __host__ __device__ bool next(int i, Unit& u) const {
        const long L = (long)i * G + c; if (L >= nwg) return false;
        int wgid = (int)L; { const int q = nwg / NXCD, r = nwg % NXCD, xcd = wgid % NXCD, off = wgid / NXCD; wgid = (xcd < r ? xcd * (q + 1) : r * (q + 1) + (xcd - r) * q) + off; }
        const int nig = WGM * nN, gid = wgid / nig, fm = gid * WGM, gsz = (nM - fm) < WGM ? (nM - fm) : WGM;
        u.pm = fm + ((wgid % nig) % gsz); u.pn = (wgid % nig) / gsz; return true;
    }
    __device__ __forceinline__ void a_ready(const Unit&) const {}
    __device__ __forceinline__ void done(const Unit&) const {}
};
typedef __bf16 bf16v2_t __attribute__((ext_vector_type(2)));
__device__ __forceinline__ unsigned cvt_pk_bf16(float lo, float hi) { bf16v2_t v; v.x = (__bf16)lo; v.y = (__bf16)hi; return __builtin_bit_cast(unsigned, v); }
typedef float f32x2 __attribute__((ext_vector_type(2)));
__device__ __forceinline__ float sigmoid_f(float x) { return __builtin_amdgcn_rcpf(1.0f + __builtin_amdgcn_exp2f(-1.44269504f * x)); }
__device__ __forceinline__ float silu_f(float x) { return x * sigmoid_f(x); }
__device__ __forceinline__ float gelu_tanh_f(float x) { return x * sigmoid_f(1.5957691216f * (x + 0.044715f * x * x * x)); }

struct EpiSwiGLU {
    static constexpr bool PERM = true, AFTER_DRAIN = false, PRE = true;
    bf16_t* O; int ldc; const float* ssq; const float* bias; int bstride; int rows_per_batch;
    __device__ __forceinline__ float pre_load(const Unit& u, int tid) const { const float* p = tid < 256 ? ssq + u.pm * BM + tid : bias + (size_t)((u.pm * BM) / rows_per_batch) * bstride + u.pn * BM + tid - 256;
        float v; asm volatile("global_load_dword %0, %1, off" : "=v"(v) : "v"(p) : "memory"); return v; }
    __device__ __forceinline__ void pre_store(PG8_LAS float* p, float v, int tid) const { p[tid] = tid < 256 ? __builtin_amdgcn_rsqf(v * (1.0f / 1024.0f) + 1e-6f) : v; }
    __device__ __forceinline__ void operator()(const f32x4 (&acc)[2][2][4][2], const Unit& u, int wr, int wc, int fr, int fq, const PG8_LAS float* pre) const {
        const int row0 = u.pm * BM + wr * 64 + fr, col0 = u.pn * 128 + wc * 32 + 8 * fq;
        const PG8_LAS float* bp = pre + 256 + wc * 32 + 8 * fq;
        const f32x4 bg0 = *(const PG8_LAS f32x4*)bp, bg1 = *(const PG8_LAS f32x4*)(bp + 4), bu0 = *(const PG8_LAS f32x4*)(bp + HALF), bu1 = *(const PG8_LAS f32x4*)(bp + HALF + 4);
#pragma unroll
        for (int ai = 0; ai < 2; ++ai)
#pragma unroll
            for (int m = 0; m < 4; ++m) { bf16_t* rowp = O + (size_t)(row0 + ai * HALF + m * 16) * ldc + col0;
                const float rs = pre[wr * 64 + fr + ai * HALF + m * 16];
                const f32x4 g0 = acc[ai][0][m][0] * rs + bg0, g1 = acc[ai][0][m][1] * rs + bg1, u0 = acc[ai][1][m][0] * rs + bu0, u1 = acc[ai][1][m][1] * rs + bu1;
                f32x4 v0, v1;
#pragma unroll
                for (int j = 0; j < 4; ++j) { v0[j] = silu_f(g0[j]) * u0[j]; v1[j] = silu_f(g1[j]) * u1[j]; }
                u32x4 w; w.x = cvt_pk_bf16(v0[0], v0[1]); w.y = cvt_pk_bf16(v0[2], v0[3]); w.z = cvt_pk_bf16(v1[0], v1[1]); w.w = cvt_pk_bf16(v1[2], v1[3]);
                *(u32x4*)rowp = w; }
    }
};
template <bool HAS_XG, int SCALE2  , bool BASE_F32, bool OUT_F32> struct EpiResid {
    static constexpr bool PERM = true, AFTER_DRAIN = false, PRE = false;
    const void* base; void* out; const float* gate; bf16_t* xg; const float* gvn; float* ssq;
    static constexpr int gstride = 9216, rows_per_batch = 16384; static constexpr float scale = 0.5f * SCALE2;
    __device__ __forceinline__ void operator()(const f32x4 (&acc)[2][2][4][2], const Unit& u, int wr, int wc, int fr, int fq, const PG8_LAS float*) const {
        const int row0 = u.pm * BM + wr * 64 + fr, col0 = u.pn * BM + wc * 32 + 8 * fq, bidx = (u.pm * BM) / rows_per_batch;
        const float* gp = gate + (size_t)bidx * gstride + col0;
        f32x4 gv[2][2], gn[2][2];
#pragma unroll
        for (int bj = 0; bj < 2; ++bj)
#pragma unroll
            for (int n = 0; n < 2; ++n) { gv[bj][n] = *(const f32x4*)(gp + bj * HALF + n * 4) * scale; gn[bj][n] = HAS_XG ? *(const f32x4*)(gvn + (size_t)bidx * 1024 + col0 + bj * HALF + n * 4) : (f32x4){0.f, 0.f, 0.f, 0.f}; }
#pragma unroll
        for (int ai = 0; ai < 2; ++ai)
#pragma unroll
            for (int mp = 0; mp < 2; ++mp) {
            f32x4 bs[2][2][2];
#pragma unroll
            for (int mm = 0; mm < 2; ++mm)
#pragma unroll
                for (int bj = 0; bj < 2; ++bj) { const size_t off = (size_t)(row0 + ai * HALF + (2 * mp + mm) * 16) * 1024 + col0 + bj * HALF;
                    if (BASE_F32) { bs[mm][bj][0] = *(const f32x4*)((const float*)base + off); bs[mm][bj][1] = *(const f32x4*)((const float*)base + off + 4); }
                    else { const u32x4 w = *(const u32x4*)((const bf16_t*)base + off);
                        bs[mm][bj][0] = (f32x4){__builtin_bit_cast(float, w.x << 16), __builtin_bit_cast(float, w.x & 0xffff0000u), __builtin_bit_cast(float, w.y << 16), __builtin_bit_cast(float, w.y & 0xffff0000u)};
                        bs[mm][bj][1] = (f32x4){__builtin_bit_cast(float, w.z << 16), __builtin_bit_cast(float, w.z & 0xffff0000u), __builtin_bit_cast(float, w.w << 16), __builtin_bit_cast(float, w.w & 0xffff0000u)}; } }
#pragma unroll
            for (int mm = 0; mm < 2; ++mm) { const int m = 2 * mp + mm; float sq = 0.f;
#pragma unroll
                for (int bj = 0; bj < 2; ++bj) { const size_t off = (size_t)(row0 + ai * HALF + m * 16) * 1024 + col0 + bj * HALF;
                    const f32x4 o0 = bs[mm][bj][0] + gv[bj][0] * acc[ai][bj][m][0], o1 = bs[mm][bj][1] + gv[bj][1] * acc[ai][bj][m][1];
                    if (OUT_F32) { *(f32x4*)((float*)out + off) = o0; *(f32x4*)((float*)out + off + 4) = o1; }
                    else { u32x4 w; w.x = cvt_pk_bf16(o0[0], o0[1]); w.y = cvt_pk_bf16(o0[2], o0[3]); w.z = cvt_pk_bf16(o1[0], o1[1]); w.w = cvt_pk_bf16(o1[2], o1[3]); *(u32x4*)((bf16_t*)out + off) = w; }
                    sq += ((o0[0] * o0[0] + o0[1] * o0[1]) + (o0[2] * o0[2] + o0[3] * o0[3])) + ((o1[0] * o1[0] + o1[1] * o1[1]) + (o1[2] * o1[2] + o1[3] * o1[3]));
                    if (HAS_XG) { const f32x4 q0 = o0 * gn[bj][0], q1 = o1 * gn[bj][1]; u32x4 w; w.x = cvt_pk_bf16(q0[0], q0[1]); w.y = cvt_pk_bf16(q0[2], q0[3]); w.z = cvt_pk_bf16(q1[0], q1[1]); w.w = cvt_pk_bf16(q1[2], q1[3]); *(u32x4*)(xg + off) = w; } }
                sq += __shfl_xor(sq, 16); sq += __shfl_xor(sq, 32);
                if (fq == 0) atomicAdd(ssq + row0 + ai * HALF + m * 16, sq); }
            asm volatile("" ::: "memory"); }
    }
};
typedef __attribute__((address_space(1))) unsigned epi_gu32;
typedef __attribute__((address_space(1))) float epi_gf32;
struct EpiFinal {
    static constexpr bool PERM = true, AFTER_DRAIN = false, PRE = false;
    const bf16_t* base; float* out; const float* gate; const float* gain; float* ssq; unsigned* cnt;
    static constexpr int gstride = 9216, rows_per_batch = 16384;
    __device__ __forceinline__ void operator()(const f32x4 (&acc)[2][2][4][2], const Unit& u, int wr, int wc, int fr, int fq, const PG8_LAS float*) const {
        const int row0 = u.pm * BM + wr * 64 + fr, col0 = u.pn * BM + wc * 32 + 8 * fq, bidx = (u.pm * BM) / rows_per_batch;
        const float* gp = gate + (size_t)bidx * gstride + col0;
        f32x4 gv[2][2];
#pragma unroll
        for (int bj = 0; bj < 2; ++bj)
#pragma unroll
            for (int n = 0; n < 2; ++n) gv[bj][n] = *(const f32x4*)(gp + bj * HALF + n * 4) * 0.5f;
        f32x4 o[2][2][4][2]; float sq[2][4];
#pragma unroll
        for (int ai = 0; ai < 2; ++ai)
#pragma unroll
            for (int mp = 0; mp < 2; ++mp) {
            u32x4 bw[2][2];
#pragma unroll
            for (int mm = 0; mm < 2; ++mm)
#pragma unroll
                for (int bj = 0; bj < 2; ++bj) bw[mm][bj] = *(const u32x4*)(base + (size_t)(row0 + ai * HALF + (2 * mp + mm) * 16) * 1024 + col0 + bj * HALF);
#pragma unroll
            for (int mm = 0; mm < 2; ++mm) { const int m = 2 * mp + mm; float sqv = 0.f;
#pragma unroll
                for (int bj = 0; bj < 2; ++bj) { const u32x4 w = bw[mm][bj];
                    const f32x4 b0 = (f32x4){__builtin_bit_cast(float, w.x << 16), __builtin_bit_cast(float, w.x & 0xffff0000u), __builtin_bit_cast(float, w.y << 16), __builtin_bit_cast(float, w.y & 0xffff0000u)};
                    const f32x4 b1 = (f32x4){__builtin_bit_cast(float, w.z << 16), __builtin_bit_cast(float, w.z & 0xffff0000u), __builtin_bit_cast(float, w.w << 16), __builtin_bit_cast(float, w.w & 0xffff0000u)};
                    const f32x4 o0 = b0 + gv[bj][0] * acc[ai][bj][m][0], o1 = b1 + gv[bj][1] * acc[ai][bj][m][1];
                    o[ai][bj][m][0] = o0; o[ai][bj][m][1] = o1;
                    sqv += ((o0[0] * o0[0] + o0[1] * o0[1]) + (o0[2] * o0[2] + o0[3] * o0[3])) + ((o1[0] * o1[0] + o1[1] * o1[1]) + (o1[2] * o1[2] + o1[3] * o1[3])); }
                sq[ai][m] = sqv; }
            asm volatile("" ::: "memory"); }
#pragma unroll
        for (int ai = 0; ai < 2; ++ai)
#pragma unroll
            for (int m = 0; m < 4; ++m) sq[ai][m] += __shfl_xor(sq[ai][m], 16);
#pragma unroll
        for (int ai = 0; ai < 2; ++ai)
#pragma unroll
            for (int m = 0; m < 4; ++m) sq[ai][m] += __shfl_xor(sq[ai][m], 32);
        if (fq == 0) {
#pragma unroll
            for (int ai = 0; ai < 2; ++ai)
#pragma unroll
                for (int m = 0; m < 4; ++m) atomicAdd(ssq + row0 + ai * HALF + m * 16, sq[ai][m]); }
        asm volatile("s_waitcnt vmcnt(0)" ::: "memory");
        epi_gu32* c = (epi_gu32*)(cnt + u.pm * 16);
        if (fr == 0 && fq == 0) __hip_atomic_fetch_add(c, 1u, __ATOMIC_RELAXED, __HIP_MEMORY_SCOPE_AGENT);
        f32x4 gn[2][2];
#pragma unroll
        for (int bj = 0; bj < 2; ++bj)
#pragma unroll
            for (int n = 0; n < 2; ++n) gn[bj][n] = *(const f32x4*)(gain + col0 + bj * HALF + n * 4);
        for (unsigned spins = 0; (unsigned)__builtin_amdgcn_readfirstlane((int)__hip_atomic_load(c, __ATOMIC_RELAXED, __HIP_MEMORY_SCOPE_AGENT)) < 32u; ) { __builtin_amdgcn_s_sleep(1); if (++spins > (1u << 20)) break; }
        float rs[2][4];
#pragma unroll
        for (int ai = 0; ai < 2; ++ai)
#pragma unroll
            for (int m = 0; m < 4; ++m) rs[ai][m] = __hip_atomic_load((epi_gf32*)(ssq + row0 + ai * HALF + m * 16), __ATOMIC_RELAXED, __HIP_MEMORY_SCOPE_AGENT);
#pragma unroll
        for (int ai = 0; ai < 2; ++ai)
#pragma unroll
            for (int m = 0; m < 4; ++m) { const float r = __builtin_amdgcn_rsqf(rs[ai][m] * (1.0f / 1024.0f) + 1e-6f);
#pragma unroll
                for (int bj = 0; bj < 2; ++bj) { float* p = out + (size_t)(row0 + ai * HALF + m * 16) * 1024 + col0 + bj * HALF;
                    *(f32x4*)p = o[ai][bj][m][0] * r * gn[bj][0]; *(f32x4*)(p + 4) = o[ai][bj][m][1] * r * gn[bj][1]; } }
    }
};
struct EpiInProj {
    static constexpr bool PERM = true, AFTER_DRAIN = false, PRE = true;
    bf16_t *ZQ, *ZV, *ZG, *ZRX, *ZRG, *ZLF, *ZLB; const float *LBF, *LBB; const float* ssq; const float* bias; int bstride; int rows_per_batch;
    __device__ __forceinline__ float pre_load(const Unit& u, int tid) const { const float* p = tid < 256 ? ssq + u.pm * BM + tid : bias + (size_t)((u.pm * BM) / rows_per_batch) * bstride + u.pn * BM + tid - 256;
        float v; asm volatile("global_load_dword %0, %1, off" : "=v"(v) : "v"(p) : "memory"); return v; }
    __device__ __forceinline__ void pre_store(PG8_LAS float* p, float v, int tid) const { p[tid] = tid < 256 ? __builtin_amdgcn_rsqf(v * (1.0f / 1024.0f) + 1e-6f) : v; }
    __device__ __forceinline__ void operator()(const f32x4 (&acc)[2][2][4][2], const Unit& u, int wr, int wc, int fr, int fq, const PG8_LAS float* pre) const {
        const int row0 = u.pm * BM + wr * 64 + fr, seg = u.pn >> 1, cs0 = (u.pn & 1) * 256 + wc * 32 + 8 * fq;
        const PG8_LAS float* bp = pre + 256 + wc * 32 + 8 * fq;
        f32x4 bb[2][2];
#pragma unroll
        for (int bj = 0; bj < 2; ++bj) { bb[bj][0] = *(const PG8_LAS f32x4*)(bp + bj * HALF); bb[bj][1] = *(const PG8_LAS f32x4*)(bp + bj * HALF + 4); }
        float rs[2][4];
#pragma unroll
        for (int ai = 0; ai < 2; ++ai)
#pragma unroll
            for (int m = 0; m < 4; ++m) rs[ai][m] = pre[wr * 64 + fr + ai * HALF + m * 16];
        if (seg == 1 || seg == 2) {
            bf16_t* Z = seg == 1 ? ZLF : ZLB; const float* LB = seg == 1 ? LBF : LBB;
#pragma unroll
            for (int bj = 0; bj < 2; ++bj) { const f32x4 l0 = *(const f32x4*)(LB + cs0 + bj * HALF), l1 = *(const f32x4*)(LB + cs0 + bj * HALF + 4);
#pragma unroll
                for (int ai = 0; ai < 2; ++ai)
#pragma unroll
                    for (int m = 0; m < 4; ++m) { bf16_t* rowp = Z + (size_t)(row0 + ai * HALF + m * 16) * 512 + cs0 + bj * HALF;
                        const f32x4 a0 = acc[ai][bj][m][0] * rs[ai][m] + bb[bj][0], a1 = acc[ai][bj][m][1] * rs[ai][m] + bb[bj][1]; f32x4 v0, v1;
#pragma unroll
                        for (int j = 0; j < 4; ++j) { v0[j] = __builtin_amdgcn_logf(l0[j] + (1.0f - l0[j]) * sigmoid_f(a0[j])); v1[j] = __builtin_amdgcn_logf(l1[j] + (1.0f - l1[j]) * sigmoid_f(a1[j])); }
                        u32x4 w; w.x = cvt_pk_bf16(v0[0], v0[1]); w.y = cvt_pk_bf16(v0[2], v0[3]); w.z = cvt_pk_bf16(v1[0], v1[1]); w.w = cvt_pk_bf16(v1[2], v1[3]); *(u32x4*)rowp = w; } }
        } else {
            bf16_t* Z = seg == 0 ? ZQ : seg == 3 ? ZV : seg == 4 ? ZG : seg == 5 ? ZRX : ZRG;
            const int act = (seg == 0 || seg == 4) ? 1 : (seg == 6 ? 2 : 0);
#pragma unroll
            for (int ai = 0; ai < 2; ++ai)
#pragma unroll
                for (int m = 0; m < 4; ++m) { bf16_t* rowp = Z + (size_t)(row0 + ai * HALF + m * 16) * 512 + cs0;
#pragma unroll
                    for (int bj = 0; bj < 2; ++bj) { f32x4 v0 = acc[ai][bj][m][0] * rs[ai][m] + bb[bj][0], v1 = acc[ai][bj][m][1] * rs[ai][m] + bb[bj][1];
                        if (act == 1) {
#pragma unroll
                            for (int j = 0; j < 4; ++j) { v0[j] = silu_f(v0[j]); v1[j] = silu_f(v1[j]); } }
                        else if (act == 2) {
#pragma unroll
                            for (int j = 0; j < 4; ++j) { v0[j] = gelu_tanh_f(v0[j]); v1[j] = gelu_tanh_f(v1[j]); } }
                        u32x4 w; w.x = cvt_pk_bf16(v0[0], v0[1]); w.y = cvt_pk_bf16(v0[2], v0[3]); w.z = cvt_pk_bf16(v1[0], v1[1]); w.w = cvt_pk_bf16(v1[2], v1[3]);
                        *(u32x4*)(rowp + bj * HALF) = w; } }
        }
    }
};
#ifdef GSTAMP_K
#define GSTAMP(k) do { if (g.K == GSTAMP_K && blockIdx.x == 0 && threadIdx.x == 0) ((unsigned long long*)((char*)g.A - GSTAMP_AOFF + 768 * 1024))[k] = __builtin_amdgcn_s_memrealtime(); } while (0)
#else
#define GSTAMP(k) do { } while (0)
#endif
template <class Epi, class Sched, bool ALIGN_EPI = false, bool SP2 = false>
__device__ __forceinline__ void gemm_phase(PG8_LAS unsigned char* lds, const Gemm g, const Sched& S, const Epi& E) {
    const int tid = threadIdx.x, wid = __builtin_amdgcn_readfirstlane(tid >> 6), lane = tid & 63, wr = wid >> 2, wc = wid & 3, fr = lane & 15, fq = lane >> 4;
    const int K = g.K, nt = K / BK;
    unsigned voffA[2], voffB[2];
#pragma unroll
    for (int i = 0; i < 2; ++i) { int R, C; stage_rc(tid * 16 + i * 8192, R, C); const int Rb = Epi::PERM ? ((R & ~31) + perm32(R & 31)) : R;
        voffA[i] = (unsigned)(R * K + C) * 2u; voffB[i] = (unsigned)(Rb * K + C) * 2u; }
    asm volatile("" : "+v"(voffA[0]), "+v"(voffA[1]), "+v"(voffB[0]), "+v"(voffB[1]));
    const size_t kstep = (size_t)(BK * 2);
    const size_t hstep = (size_t)HALF * K * 2;
    const size_t tstep = 2 * hstep;
    const unsigned ldsw = (unsigned)wid * 1024u;
    const int aoff = lds_byte(wr * 64 + fr, fq * 8), boff = lds_byte(wc * 32 + fr, fq * 8);
#define PG8_SA(b, h) (((b) * 2 + (h)) * HTB)
#define PG8_SB(b, h) ((4 + (b) * 2 + (h)) * HTB)
#define PG8_STAGE(bufoff, gbase, voff) do { _Pragma("unroll") for (int _i = 0; _i < 2; ++_i) \
        __builtin_amdgcn_global_load_lds((const unsigned*)((const char*)(gbase) + (voff)[_i]), (PG8_LAS unsigned*)(lds + (bufoff) + ldsw + _i * 8192), 16, 0, 0); } while (0)
#define PG8_LDA(dst, b, h) do { _Pragma("unroll") for (int m = 0; m < 4; ++m) _Pragma("unroll") for (int k = 0; k < 2; ++k) dst[m][k] = *(const PG8_LAS bf16x8*)(lds + PG8_SA(b, h) + aoff + m * 2048 + k * 1024); } while (0)
#define PG8_LDB(dst, b, h) do { _Pragma("unroll") for (int n = 0; n < 2; ++n) _Pragma("unroll") for (int k = 0; k < 2; ++k) dst[n][k] = *(const PG8_LAS bf16x8*)(lds + PG8_SB(b, h) + boff + n * 2048 + k * 1024); } while (0)
#define PG8_MMA(ai, bj, At, Bt) do { __builtin_amdgcn_s_setprio(1); _Pragma("unroll") for (int m = 0; m < 4; ++m) _Pragma("unroll") for (int n = 0; n < 2; ++n) _Pragma("unroll") for (int k = 0; k < 2; ++k) \
        acc[ai][bj][m][n] = __builtin_amdgcn_mfma_f32_16x16x32_bf16(Bt[n][k], At[m][k], acc[ai][bj][m][n], 0, 0, 0); __builtin_amdgcn_s_setprio(0); } while (0)
#define PG8_WAIT_V(n) asm volatile("s_waitcnt vmcnt(" #n ")" ::: "memory")
#define PG8_WAIT_L(n) asm volatile("s_waitcnt lgkmcnt(" #n ")" ::: "memory")
#define PG8_BAR __builtin_amdgcn_s_barrier()
#define PG8_SCHED __builtin_amdgcn_sched_barrier(0)
    Unit cur, nxt; int ui = 0; float pre_v = 0.f;
    if (!S.next(0, cur)) return;
    f32x4 acc[2][2][4][2];
#pragma unroll
    for (int a = 0; a < 2; ++a)
#pragma unroll
        for (int b = 0; b < 2; ++b)
#pragma unroll
            for (int m = 0; m < 4; ++m)
#pragma unroll
                for (int n = 0; n < 2; ++n) acc[a][b][m][n] = (f32x4){0.f, 0.f, 0.f, 0.f};
    bf16x8 At[4][2], B0[2][2], B1[2][2];
    const char* cA = (const char*)g.A + (size_t)cur.pm * tstep; const char* cB = (const char*)g.Bt + (size_t)cur.pn * tstep + (cur.pm >= 64 ? g.bt_batch_bytes : 0);
    S.a_ready(cur);
    if constexpr (SP2) {
        PG8_STAGE(PG8_SB(0, 0), cB, voffB); PG8_STAGE(PG8_SB(0, 1), cB + hstep, voffB); PG8_STAGE(PG8_SA(0, 0), cA, voffA); PG8_STAGE(PG8_SA(0, 1), cA + hstep, voffA);
        if (wr == 1) PG8_BAR;
        PG8_WAIT_V(2); PG8_BAR;
        PG8_STAGE(PG8_SB(1, 0), cB + kstep, voffB); PG8_STAGE(PG8_SA(1, 0), cA + kstep, voffA); PG8_STAGE(PG8_SB(1, 1), cB + hstep + kstep, voffB);
        PG8_WAIT_V(6); PG8_BAR;
    } else {
        PG8_STAGE(PG8_SB(0, 0), cB, voffB); PG8_STAGE(PG8_SA(0, 0), cA, voffA); PG8_STAGE(PG8_SB(0, 1), cB + hstep, voffB); PG8_STAGE(PG8_SA(0, 1), cA + hstep, voffA);
        if (wr == 1) PG8_BAR;
        PG8_WAIT_V(4); PG8_BAR;
        PG8_STAGE(PG8_SB(1, 0), cB + kstep, voffB); PG8_STAGE(PG8_SA(1, 0), cA + kstep, voffA); PG8_STAGE(PG8_SB(1, 1), cB + hstep + kstep, voffB);
        PG8_WAIT_V(6); PG8_BAR;
    }
    for (;;) {
        GSTAMP(22);
        const bool has_next = S.next(ui + 1, nxt);
        const char* nA = has_next ? (const char*)g.A + (size_t)nxt.pm * tstep : cA; const char* nB = has_next ? (const char*)g.Bt + (size_t)nxt.pn * tstep + (nxt.pm >= 64 ? g.bt_batch_bytes : 0) : cB;
        for (int t = 0; t < nt; t += 2) {
            const bool last = (t == nt - 2);
            const char* a1 = cA + (size_t)(t + 1) * kstep;
            const char* a2 = last ? nA : cA + (size_t)(t + 2) * kstep; const char* b2 = last ? nB : cB + (size_t)(t + 2) * kstep;
            const char* a3 = a2 + kstep; const char* b3 = b2 + kstep;
            if (last) { if constexpr (Epi::PRE) pre_v = E.pre_load(cur, tid); if (has_next) S.a_ready(nxt); }
            if constexpr (SP2) {
            PG8_LDB(B0, 0, 0); PG8_LDB(B1, 0, 1); PG8_SCHED; PG8_LDA(At, 0, 0); PG8_STAGE(PG8_SA(1, 1), a1 + hstep, voffA);
            PG8_WAIT_V(8); PG8_WAIT_L(0); PG8_BAR; PG8_MMA(0, 0, At, B0); PG8_MMA(0, 1, At, B1); PG8_BAR; PG8_SCHED;
            PG8_LDA(At, 0, 1); PG8_STAGE(PG8_SB(0, 0), b2, voffB); PG8_STAGE(PG8_SB(0, 1), b2 + hstep, voffB); PG8_STAGE(PG8_SA(0, 0), a2, voffA);
            PG8_WAIT_V(8); PG8_WAIT_L(0); PG8_BAR; PG8_MMA(1, 0, At, B0); PG8_MMA(1, 1, At, B1); PG8_BAR; PG8_SCHED;
            PG8_LDB(B0, 1, 0); PG8_LDB(B1, 1, 1); PG8_SCHED; PG8_LDA(At, 1, 0); PG8_STAGE(PG8_SA(0, 1), a2 + hstep, voffA);
            PG8_WAIT_V(8); PG8_WAIT_L(0); PG8_BAR; PG8_MMA(0, 0, At, B0); PG8_MMA(0, 1, At, B1); PG8_BAR; PG8_SCHED;
            PG8_LDA(At, 1, 1); PG8_STAGE(PG8_SB(1, 0), b3, voffB); PG8_STAGE(PG8_SB(1, 1), b3 + hstep, voffB); PG8_STAGE(PG8_SA(1, 0), a3, voffA);
            PG8_WAIT_V(8); PG8_WAIT_L(0); PG8_BAR; PG8_MMA(1, 0, At, B0); PG8_MMA(1, 1, At, B1); PG8_BAR; PG8_SCHED;
            } else {
            PG8_LDB(B0, 0, 0); PG8_SCHED; PG8_LDA(At, 0, 0); PG8_STAGE(PG8_SA(1, 1), a1 + hstep, voffA);
            PG8_WAIT_L(8); PG8_BAR; PG8_WAIT_L(0); PG8_MMA(0, 0, At, B0); PG8_BAR; PG8_SCHED;
            PG8_LDB(B1, 0, 1); PG8_STAGE(PG8_SB(0, 0), b2, voffB);
            PG8_BAR; PG8_WAIT_L(0); PG8_MMA(0, 1, At, B1); PG8_BAR;
            PG8_LDA(At, 0, 1); PG8_STAGE(PG8_SA(0, 0), a2, voffA);
            PG8_BAR; PG8_WAIT_L(0); PG8_MMA(1, 0, At, B0); PG8_BAR; PG8_SCHED;
            PG8_STAGE(PG8_SB(0, 1), b2 + hstep, voffB);
            PG8_WAIT_V(6); PG8_BAR; PG8_MMA(1, 1, At, B1); PG8_BAR;
            PG8_LDB(B0, 1, 0); PG8_SCHED; PG8_LDA(At, 1, 0); PG8_STAGE(PG8_SA(0, 1), a2 + hstep, voffA);
            PG8_WAIT_L(8); PG8_BAR; PG8_WAIT_L(0); PG8_MMA(0, 0, At, B0); PG8_BAR; PG8_SCHED;
            PG8_LDB(B1, 1, 1); PG8_STAGE(PG8_SB(1, 0), b3, voffB);
            PG8_BAR; PG8_WAIT_L(0); PG8_MMA(0, 1, At, B1); PG8_BAR;
            PG8_LDA(At, 1, 1); PG8_STAGE(PG8_SA(1, 0), a3, voffA);
            PG8_BAR; PG8_WAIT_L(0); PG8_MMA(1, 0, At, B0); PG8_BAR; PG8_SCHED;
            PG8_STAGE(PG8_SB(1, 1), b3 + hstep, voffB);
            PG8_WAIT_V(6); PG8_BAR; PG8_MMA(1, 1, At, B1); PG8_BAR;
            }
        }
        if constexpr (ALIGN_EPI) { if (wr == 0) PG8_BAR; }
        if constexpr (Epi::PRE) { asm volatile("s_waitcnt vmcnt(16)" : "+v"(pre_v) :: "memory"); E.pre_store((PG8_LAS float*)(lds + STAGE_BYTES), pre_v, tid); PG8_WAIT_L(0); PG8_BAR; }
        GSTAMP(20);
        if constexpr (!Epi::AFTER_DRAIN) { int t2 = threadIdx.x; asm volatile("" : "+v"(t2));
            E(acc, cur, wr, wc, t2 & 15, (t2 >> 4) & 3, (const PG8_LAS float*)(lds + STAGE_BYTES)); S.done(cur); }
        GSTAMP(21);
        if (!has_next) break;
#pragma unroll
        for (int a = 0; a < 2; ++a)
#pragma unroll
            for (int b = 0; b < 2; ++b)
#pragma unroll
                for (int m = 0; m < 4; ++m)
#pragma unroll
                    for (int n = 0; n < 2; ++n) acc[a][b][m][n] = (f32x4){0.f, 0.f, 0.f, 0.f};
        cur = nxt; cA = nA; cB = nB; ++ui;
        if constexpr (ALIGN_EPI) { if (wr == 1) PG8_BAR; }
    }
    PG8_WAIT_V(0);
    if constexpr (!ALIGN_EPI) { if (wr == 0) PG8_BAR; }
    PG8_BAR;
    if constexpr (Epi::AFTER_DRAIN) { E.fused(acc, cur, wr, wc, fr, fq, lds, wid, lane); S.done(cur); }
#undef PG8_SA
#undef PG8_SB
#undef PG8_STAGE
#undef PG8_LDA
#undef PG8_LDB
#undef PG8_MMA
#undef PG8_WAIT_V
#undef PG8_WAIT_L
#undef PG8_BAR
#undef PG8_SCHED
}
}
#define GAS __attribute__((address_space(1)))
#define LAS __attribute__((address_space(3)))
typedef unsigned short bf16;
typedef unsigned v4u __attribute__((ext_vector_type(4)));
typedef float f32x4 __attribute__((ext_vector_type(4)));
typedef short bf16x8 __attribute__((ext_vector_type(8)));
typedef GAS unsigned gu32;
typedef GAS unsigned long long gu64;
#define RLX_AGENT __ATOMIC_RELAXED, __HIP_MEMORY_SCOPE_AGENT
#define LDS_WAIT() asm volatile("s_waitcnt lgkmcnt(0)" ::: "memory")
#define VM_WAIT() asm volatile("s_waitcnt vmcnt(0)" ::: "memory")
__device__ __forceinline__ unsigned long long rt() { return __builtin_amdgcn_s_memrealtime(); }
__device__ __forceinline__ unsigned f2bf(float f) { unsigned u = __builtin_bit_cast(unsigned, f); return (u + 0x7fffu + ((u >> 16) & 1u)) >> 16; }
__device__ __forceinline__ unsigned pk2(float lo, float hi) { return pg8::cvt_pk_bf16(lo, hi); }

#define XB_TMO      128
#define XB_XCNT(j)  (256  + 64 * (j))
#define XB_XSUB(j)  (1280 + 64 * (j))
#define XB_XGEN(j)  (2304 + 64 * (j))
#define XB_TOP      3328
#define XB_TOPGEN   3392
#define XCD_BAR_WORDS 3456
#define XB_SPIN_CAP (1u << 23)

__device__ __forceinline__ unsigned xb_ld(unsigned* p)              { return __hip_atomic_load(p, __ATOMIC_RELAXED, __HIP_MEMORY_SCOPE_AGENT); }
__device__ __forceinline__ unsigned xb_add(unsigned* p, unsigned v) { return __hip_atomic_fetch_add(p, v, __ATOMIC_RELAXED, __HIP_MEMORY_SCOPE_AGENT); }
__device__ __forceinline__ unsigned xb_xcc_id() { return (unsigned)__builtin_amdgcn_s_getreg((3 << 11) | 20) & 0xFu; }
#define XB_SPIN(cond, bar) do { unsigned _sp = 0; while (cond) { __builtin_amdgcn_s_sleep(1); \
    if ((++_sp & 255u) == 0u) { if (xb_ld(&(bar)[XB_TMO])) break; if (_sp > XB_SPIN_CAP) { atomicAdd(&(bar)[XB_TMO], 1u); break; } } } } while (0)

struct XcdBarrier {
    unsigned* bar; unsigned x;
    volatile LAS unsigned* st;
};

__device__ __forceinline__ XcdBarrier xcd_barrier_post(unsigned* bar, volatile LAS unsigned* st) {
    XcdBarrier b; b.bar = bar; b.x = xb_xcc_id(); b.st = st;
    if (threadIdx.x == 0) (void)xb_add(&bar[XB_XCNT(b.x)], 1u);
    return b;
}
__device__ __forceinline__ void xcd_barrier_complete(unsigned* bar, unsigned x, unsigned& nloc, unsigned& nx) {
    const unsigned G = gridDim.x * gridDim.y * gridDim.z;
    unsigned sum, cnt, mine, sp = 0u;
    for (;;) {
        sum = 0u; cnt = 0u; mine = 0u;
#pragma unroll
        for (unsigned j = 0; j < 16; ++j) { const unsigned c = xb_ld(&bar[XB_XCNT(j)]); sum += c; cnt += (c > 0u) ? 1u : 0u; mine = (j == x) ? c : mine; }
        if (sum == G) break;
        __builtin_amdgcn_s_sleep(1);
        if ((++sp & 255u) == 0u) { if (xb_ld(&bar[XB_TMO])) break; if (sp > XB_SPIN_CAP) { atomicAdd(&bar[XB_TMO], 1u); break; } }
    }
    nloc = mine > 0u ? mine : 1u; nx = cnt > 0u ? cnt : 1u;
}

__device__ __forceinline__ void xcd_barrier(const XcdBarrier& b) {
    asm volatile("s_waitcnt vmcnt(0)" ::: "memory");
    __syncthreads();
    if (threadIdx.x == 0) {
        unsigned* bar = b.bar;
        __builtin_amdgcn_s_waitcnt(0);
        unsigned nloc = b.st[0], nx = b.st[1];
        if (nloc == 0u) { xcd_barrier_complete(bar, b.x, nloc, nx); b.st[0] = nloc; b.st[1] = nx; }
        const unsigned old = xb_add(&bar[XB_XSUB(b.x)], 1u);
        const unsigned gen = old / nloc;
        if (old + 1u == (gen + 1u) * nloc) {
            __builtin_amdgcn_fence(__ATOMIC_RELEASE, "agent");
            asm volatile("s_waitcnt vmcnt(0)" ::: "memory");
            const unsigned og = xb_add(&bar[XB_TOP], 1u);
            const unsigned tg = og / nx;
            if (og + 1u == (tg + 1u) * nx) xb_add(&bar[XB_TOPGEN], 1u);
            else XB_SPIN(xb_ld(&bar[XB_TOPGEN]) == tg, bar);
            __builtin_amdgcn_fence(__ATOMIC_ACQUIRE, "agent");
            xb_add(&bar[XB_XGEN(b.x)], 1u);
            asm volatile("s_waitcnt vmcnt(0)" ::: "memory");
        } else {
            XB_SPIN(xb_ld(&bar[XB_XGEN(b.x)]) == gen, bar);
            __builtin_amdgcn_fence(__ATOMIC_ACQUIRE, "agent");
            asm volatile("s_waitcnt vmcnt(0)" ::: "memory");
        }
    }
    __syncthreads();
}
constexpr int NWAVES = 8;
constexpr int BATCH = 2, T = 16384, D = 1024, FF = 2816, NIN = 3584, DH = 512, NMOD = 9 * D;
constexpr int M = BATCH * T;
constexpr float EPS = 1e-6f;
constexpr size_t MiB = 1u << 20;
constexpr size_t WS_CTL = 0, CTL_ZERO_BYTES = 128 * 1024;
constexpr size_t WS_MOD = 1 * MiB;
constexpr size_t WS_SSQ2 = 128 * 1024, WS_SSQ3 = 256 * 1024, WS_SSQ4 = 384 * 1024, WS_SSQ1 = 512 * 1024;
constexpr size_t WS_GV = WS_MOD + 80 * 1024;
constexpr size_t WS_BIAS1 = 640 * 1024, WS_BIAS2 = 688 * 1024, WS_BIAS3 = 720 * 1024;
constexpr size_t WS_LBF = WS_MOD + 128 * 1024, WS_LBB = WS_LBF + 4096, WS_RGCL = WS_LBB + 4096;
constexpr size_t WS_RGTOT = 2 * MiB;
constexpr size_t WS_DG = 3 * MiB;
constexpr size_t WS_W13B = 4 * MiB, WS_W2A = 26 * MiB, WS_W2B = 32 * MiB, WS_WOUT = 45 * MiB, WS_RGW = 47 * MiB;
constexpr size_t WS_W13A = 400 * MiB, WS_WIN = 464 * MiB;
constexpr size_t W13_COPY = (size_t)2 * 2816 * 1024 * 2, WIN_COPY = (size_t)3584 * 1024 * 2;
constexpr size_t WS_XN = 48 * MiB;
constexpr size_t WS_HB = 112 * MiB;
constexpr size_t WS_ZQ = 112 * MiB, WS_ZV = 144 * MiB, WS_ZG = 176 * MiB, WS_ZRX = 208 * MiB, WS_ZRG = 240 * MiB, WS_ZLF = 272 * MiB, WS_ZLB = 304 * MiB;
constexpr size_t WS_XB = 336 * MiB;
constexpr size_t WS_SG = 400 * MiB;
constexpr size_t WS_OB = 464 * MiB;
constexpr size_t WS_END = 500 * MiB;
static_assert(WS_HB + (size_t)M * FF * 2 <= WS_SG && WS_XB + (size_t)M * D * 2 <= WS_SG && WS_W13B + 2 * W13_COPY <= WS_W2A && WS_W13A + 2 * W13_COPY <= WS_SG + 32 * MiB && WS_WIN + 2 * WIN_COPY <= WS_OB + 32 * MiB && WS_W2A + (size_t)D * FF * 2 <= WS_W2B && WS_W2B + (size_t)D * FF * 2 <= WS_WOUT, "ws map");
constexpr int CW_BAR = 4096;
constexpr int CW_FIN = 20480;
constexpr int CW_QUEUE = 16384;
constexpr int RING_OFF = 0, RING_BYTES = 145408;
constexpr int LDSCTL_OFF = RING_BYTES, MISC_OFF = LDSCTL_OFF + 320;
constexpr int LDS_BYTES = 147456;
static_assert(MISC_OFF + 128 <= LDS_BYTES, "LDS map");

struct Frame {
    LAS unsigned char* lds;
    volatile LAS unsigned* MISC;
    gu32* ctl;
    int tid, lane, wave, G, bid;
    const __attribute__((address_space(4))) unsigned long long* ka;
    float* out; unsigned char* ws;
};
#ifdef STAMP_A
#define STAMPX(F, k) do { if (blockIdx.x == 0 && threadIdx.x == 0) ((unsigned long long*)((F).ws + WS_CTL + 768 * 1024))[k] = __builtin_amdgcn_s_memrealtime(); } while (0)
#else
#define STAMPX(F, k) do { } while (0)
#endif
#define FIN(k) ((const float*)(const __attribute__((address_space(1))) float*)F.ka[k])
__device__ __forceinline__ float wave_sum(float v) {
#pragma unroll
    for (int o = 1; o < 64; o <<= 1) v += __shfl_xor(v, o);
    return v;
}
__device__ __forceinline__ float bf2f(unsigned short b) { return __builtin_bit_cast(float, ((unsigned)b) << 16); }
__device__ __forceinline__ float bflo(unsigned w) { return __builtin_bit_cast(float, w << 16); }
__device__ __forceinline__ float bfhi(unsigned w) { return __builtin_bit_cast(float, w & 0xffff0000u); }
__device__ __forceinline__ float sigmoidf_(float x) { return __builtin_amdgcn_rcpf(1.0f + __builtin_amdgcn_exp2f(-1.44269504f * x)); }

__device__ __forceinline__ void p0_transpose_item(const float* W, int K, int N, bf16* WT, int k0, int n0, int drow0, LAS float* scr, int lane, float scale = 1.0f) {
    {
        const int r8 = lane >> 3, c4 = 4 * (lane & 7); f32x4 tv[8];
#pragma unroll
        for (int i = 0; i < 8; ++i) tv[i] = *(const f32x4*)(W + (size_t)(k0 + 8 * i + r8) * N + n0 + c4);
#pragma unroll
        for (int i = 0; i < 8; ++i) { LAS float* d = scr + (8 * i + r8) * 33 + c4; d[0] = tv[i][0] * scale; d[1] = tv[i][1] * scale; d[2] = tv[i][2] * scale; d[3] = tv[i][3] * scale; } }
    LDS_WAIT(); asm volatile("" ::: "memory");
    const int c = lane & 7;
#pragma unroll
    for (int j = 0; j < 4; ++j) { const int n = (lane >> 3) + 8 * j; const LAS float* s = scr + (8 * c) * 33 + n;
        v4u o; o.x = pk2(s[0 * 33], s[1 * 33]); o.y = pk2(s[2 * 33], s[3 * 33]); o.z = pk2(s[4 * 33], s[5 * 33]); o.w = pk2(s[6 * 33], s[7 * 33]);
        *(GAS v4u*)(WT + (size_t)(drow0 + n) * K + k0 + 8 * c) = o; }
    LDS_WAIT(); asm volatile("" ::: "memory");
}
__device__ __forceinline__ void p0_item_w13(const float* W, int mat, bf16* WT, int item, LAS float* scr, int lane) {
    const int nblk = FF / 32, kb = item / nblk, nb = item % nblk, n0 = 32 * nb;
    p0_transpose_item(W, D, FF, WT, 64 * kb, n0, 256 * (n0 / 128) + 128 * mat + (n0 % 128), scr, lane);
}
__device__ __forceinline__ void p0_item_plain(const float* W, int K, int N, bf16* WT, int item, LAS float* scr, int lane) {
    const int nblk = N / 32, kb = item / nblk, nb = item % nblk;
    p0_transpose_item(W, K, N, WT, 64 * kb, 32 * nb, 32 * nb, scr, lane);
}

__device__ __forceinline__ void p0a(Frame& F) {
    LAS float* L = (LAS float*)(F.lds + RING_OFF);
    const float* c = FIN(1); const float* w_ada = FIN(2); const float* b_ada = FIN(3);
    float* MOD = (float*)(F.ws + WS_MOD);
    for (int gi = F.bid; gi < NMOD / 64; gi += F.G) {
        for (int i = F.tid; i < 2 * D; i += NWAVES * 64) { const float v = c[i]; L[i] = v * sigmoidf_(v); }
        __syncthreads();
        const int n = 64 * gi + F.lane;
        {
            const int c4 = F.lane & 15, kq = F.lane >> 4; f32x4 a0 = {0.f, 0.f, 0.f, 0.f}, a1 = {0.f, 0.f, 0.f, 0.f};
            const float* wp = w_ada + (size_t)(128 * F.wave + kq) * NMOD + 64 * gi + 4 * c4;
#pragma unroll 16
            for (int i = 0; i < 32; ++i) { const f32x4 wv = *(const f32x4*)(wp + (size_t)(4 * i) * NMOD); a0 += wv * L[128 * F.wave + 4 * i + kq]; a1 += wv * L[D + 128 * F.wave + 4 * i + kq]; }
#pragma unroll
            for (int q = 0; q < 4; ++q) { a0[q] += __shfl_xor(a0[q], 16); a0[q] += __shfl_xor(a0[q], 32); a1[q] += __shfl_xor(a1[q], 16); a1[q] += __shfl_xor(a1[q], 32); }
            if (kq == 0) { *(LAS f32x4*)(L + 2 * D + (F.wave * 2 + 0) * 64 + 4 * c4) = a0; *(LAS f32x4*)(L + 2 * D + (F.wave * 2 + 1) * 64 + 4 * c4) = a1; } }
        __syncthreads();
        if (F.wave < 2) { float s = b_ada[n];
#pragma unroll
            for (int w = 0; w < 8; ++w) s += L[2 * D + (w * 2 + F.wave) * 64 + F.lane];
            MOD[F.wave * NMOD + n] = s; }
        __syncthreads();
    }
    {
        f32x4* z0 = (f32x4*)(F.ws + 128 * 1024); f32x4* z1 = (f32x4*)(F.ws + 640 * 1024); const f32x4 zz = {0.f, 0.f, 0.f, 0.f};
        for (int i = F.bid * NWAVES * 64 + F.tid; i < (384 * 1024) / 16; i += F.G * NWAVES * 64) z0[i] = zz;
        for (int i = F.bid * NWAVES * 64 + F.tid; i < (128 * 1024) / 16; i += F.G * NWAVES * 64) z1[i] = zz;
    }
    if (F.bid == F.G - 1) {
        const float* lbf = FIN(10); const float* lbb = FIN(11); float* LBF = (float*)(F.ws + WS_LBF); float* LBB = (float*)(F.ws + WS_LBB); float* CL = (float*)(F.ws + WS_RGCL);
        for (int i = F.tid; i < DH; i += NWAVES * 64) {
            LBF[i] = sigmoidf_(lbf[DH + i] - lbf[i]); LBB[i] = sigmoidf_(lbb[DH + i] - lbb[i]);
            const float lf = FIN(19)[i], lb = FIN(24)[i];
            CL[i] = -8.0f * 1.44269504f * log1pf(expf(-lf)); CL[DH + i] = -8.0f * 1.44269504f * log1pf(expf(-lb));
        }
    }
    LAS float* scr = (LAS float*)(F.lds + RING_OFF + 16384 + F.wave * 12288);
    const int gw = F.bid * NWAVES + F.wave, NGW = F.G * NWAVES;
    constexpr int I_2 = (FF / 64) * (D / 32), I_OUT = (D / 64) * (D / 32), I_RG = 2;
    constexpr int NITEMS = 2 * I_2 + I_OUT + 32 * I_RG;
    for (int it = gw; it < NITEMS; it += NGW) {
        int r = it;
        if (r < I_2) { p0_item_plain(FIN(7), FF, D, (bf16*)(F.ws + WS_W2A), r, scr, F.lane); continue; } r -= I_2;
        if (r < I_2) { p0_item_plain(FIN(29), FF, D, (bf16*)(F.ws + WS_W2B), r, scr, F.lane); continue; } r -= I_2;
        if (r < I_OUT) { p0_item_plain(FIN(25), D, D, (bf16*)(F.ws + WS_WOUT), r, scr, F.lane); continue; } r -= I_OUT;
        { const int mb = r / I_RG, half = r % I_RG, mat = mb >> 3, blk = mb & 7;
          const float* src = (mat == 0 ? FIN(15) : mat == 1 ? FIN(17) : mat == 2 ? FIN(20) : FIN(22)) + (size_t)blk * 4096;
          p0_transpose_item(src, 64, 64, (bf16*)(F.ws + WS_RGW) + (size_t)mb * 4096, 0, 32 * half, 32 * half, scr, F.lane, -1.44269504f); }
    }
    const float* xin = FIN(0); bf16* XB = (bf16*)(F.ws + WS_XB); float* SSQ = (float*)(F.ws + WS_SSQ1);
    for (;;) {
        __syncthreads();
        if (F.tid == 0) F.MISC[16] = __hip_atomic_fetch_add(F.ctl + CW_QUEUE + 128, 1u, __ATOMIC_RELAXED, __HIP_MEMORY_SCOPE_AGENT);
        __syncthreads(); const int bt = (int)F.MISC[16];
        if (bt >= M / 32) break;
        const int mb = 32 * bt + 4 * F.wave;
        f32x4 v[4][4];
#pragma unroll
        for (int r = 0; r < 4; ++r) { const GAS f32x4* xr = (const GAS f32x4*)(xin + (size_t)(mb + r) * D) + F.lane;
#pragma unroll
            for (int j = 0; j < 4; ++j) v[r][j] = xr[64 * j]; }
#pragma unroll
        for (int r = 0; r < 4; ++r) { const int m = mb + r; float s = 0.f;
#pragma unroll
            for (int j = 0; j < 4; ++j) s += (v[r][j].x * v[r][j].x + v[r][j].y * v[r][j].y) + (v[r][j].z * v[r][j].z + v[r][j].w * v[r][j].w);
            s = wave_sum(s);
            if (F.lane == 0) SSQ[m] = s;
            GAS unsigned long long* o8 = (GAS unsigned long long*)(XB + (size_t)m * D) + F.lane;
#pragma unroll
            for (int j = 0; j < 4; ++j) o8[64 * j] = (unsigned long long)pk2(v[r][j].x, v[r][j].y) | ((unsigned long long)pk2(v[r][j].z, v[r][j].w) << 32); }
    }
}

__device__ __forceinline__ void p0_fold_item(const float* W, int N, bf16* WT, size_t copy_elems, int k0, int n0, int drow0, const float* gain, const float* sc, const float* sh, float* bias, int bstride, LAS float* scr, int lane) {
    const int r8 = lane >> 3, c4 = 4 * (lane & 7), c = lane & 7; f32x4 tv[8];
#pragma unroll
    for (int i = 0; i < 8; ++i) tv[i] = *(const f32x4*)(W + (size_t)(k0 + 8 * i + r8) * N + n0 + c4);
    const f32x4 ga = *(const f32x4*)(gain + k0 + 8 * c), gb = *(const f32x4*)(gain + k0 + 8 * c + 4);
    f32x4 sa[2], sb[2];
#pragma unroll
    for (int bb = 0; bb < 2; ++bb) { sa[bb] = *(const f32x4*)(sc + (size_t)bb * NMOD + k0 + 8 * c); sb[bb] = *(const f32x4*)(sc + (size_t)bb * NMOD + k0 + 8 * c + 4); }
    const float sh0 = sh[k0 + lane], sh1 = sh[(size_t)NMOD + k0 + lane];
    LAS float* shl = scr + 64 * 33;
#pragma unroll
    for (int i = 0; i < 8; ++i) { LAS float* d = scr + (8 * i + r8) * 33 + c4; d[0] = tv[i][0]; d[1] = tv[i][1]; d[2] = tv[i][2]; d[3] = tv[i][3]; }
    shl[lane] = sh0; shl[64 + lane] = sh1;
    LDS_WAIT(); asm volatile("" ::: "memory");
#pragma unroll
    for (int b = 0; b < 2; ++b) {
        const f32x4 va = ga * (1.0f + sa[b]), vb = gb * (1.0f + sb[b]);
        const float gv[8] = {va[0], va[1], va[2], va[3], vb[0], vb[1], vb[2], vb[3]};
#pragma unroll
        for (int j = 0; j < 4; ++j) { const int n = (lane >> 3) + 8 * j; const LAS float* s = scr + (8 * c) * 33 + n;
            v4u o; o.x = pk2(s[0 * 33] * gv[0], s[1 * 33] * gv[1]); o.y = pk2(s[2 * 33] * gv[2], s[3 * 33] * gv[3]); o.z = pk2(s[4 * 33] * gv[4], s[5 * 33] * gv[5]); o.w = pk2(s[6 * 33] * gv[6], s[7 * 33] * gv[7]);
            *(GAS v4u*)(WT + (size_t)b * copy_elems + (size_t)(drow0 + n) * D + k0 + 8 * c) = o; }
    }
    { const int n = lane & 31, b = lane >> 5; float a = 0.f;
#pragma unroll 16
      for (int kk = 0; kk < 64; ++kk) a += scr[kk * 33 + n] * shl[b * 64 + kk];
      atomicAdd(bias + (size_t)b * bstride + drow0 + n, a); }
    LDS_WAIT(); asm volatile("" ::: "memory");
}
__device__ __forceinline__ void p0b(Frame& F) {
    const float* MOD = (const float*)(F.ws + WS_MOD);
    const int gw = F.bid * NWAVES + F.wave, NGW = F.G * NWAVES;
    {
        LAS float* scr = (LAS float*)(F.lds + RING_OFF + F.wave * 12288);
        constexpr int I_13 = (D / 64) * (FF / 32), I_IN = (D / 64) * (NIN / 32);
        constexpr int NITEMS = 4 * I_13 + I_IN;
        auto tile = [&](int it, int& N) -> const float* {
            int r = it;
            if (r < 2 * I_13) { const int mat = r >= I_13; r -= mat * I_13; const int nblk = FF / 32, kb = r / nblk, nb = r % nblk; N = FF; return (mat ? FIN(6) : FIN(5)) + (size_t)(64 * kb) * FF + 32 * nb; }
            r -= 2 * I_13;
            if (r < 2 * I_13) { const int mat = r >= I_13; r -= mat * I_13; const int nblk = FF / 32, kb = r / nblk, nb = r % nblk; N = FF; return (mat ? FIN(28) : FIN(27)) + (size_t)(64 * kb) * FF + 32 * nb; }
            r -= 2 * I_13;
            { const int nblk = NIN / 32, kb = r / nblk, nb = r % nblk; N = NIN; return FIN(9) + (size_t)(64 * kb) * NIN + 32 * nb; } };
        for (int it = gw; it < NITEMS; it += NGW) {
            float pf = 0.f;
            { const int itn = it + NGW < NITEMS ? it + NGW : it; int Nn; const float* tn = tile(itn, Nn); const float* pn = tn + (size_t)F.lane * Nn;
              asm volatile("global_load_dword %0, %1, off" : "=v"(pf) : "v"(pn) : "memory"); }
            int r = it;
            if (r < 2 * I_13) { const int mat = r >= I_13; r -= mat * I_13; const int nblk = FF / 32, kb = r / nblk, nb = r % nblk, n0 = 32 * nb;
                p0_fold_item(mat ? FIN(6) : FIN(5), FF, (bf16*)(F.ws + WS_W13A), W13_COPY / 2, 64 * kb, n0, 256 * (n0 / 128) + 128 * mat + (n0 % 128), FIN(4), MOD + 1 * D, MOD + 0 * D, (float*)(F.ws + WS_BIAS1), 2 * FF, scr, F.lane); }
            else if (r < 4 * I_13) { r -= 2 * I_13; const int mat = r >= I_13; r -= mat * I_13; const int nblk = FF / 32, kb = r / nblk, nb = r % nblk, n0 = 32 * nb;
                p0_fold_item(mat ? FIN(28) : FIN(27), FF, (bf16*)(F.ws + WS_W13B), W13_COPY / 2, 64 * kb, n0, 256 * (n0 / 128) + 128 * mat + (n0 % 128), FIN(26), MOD + 7 * D, MOD + 6 * D, (float*)(F.ws + WS_BIAS3), 2 * FF, scr, F.lane); }
            else { r -= 4 * I_13; const int nblk = NIN / 32, kb = r / nblk, nb = r % nblk;
              p0_fold_item(FIN(9), NIN, (bf16*)(F.ws + WS_WIN), WIN_COPY / 2, 64 * kb, 32 * nb, 32 * nb, FIN(8), MOD + 4 * D, MOD + 3 * D, (float*)(F.ws + WS_BIAS2), NIN, scr, F.lane); }
            asm volatile("" :: "v"(pf));
        }
    }
}
__device__ __forceinline__ void final_norm_rows(Frame& F, const bf16* xb, float* out, const float* gain, const float* ssq) {
    const int gw = F.bid * NWAVES + F.wave, NGW = F.G * NWAVES;
    f32x4 g[4];
#pragma unroll
    for (int j = 0; j < 2; ++j) { g[2 * j] = *(const f32x4*)(gain + 512 * j + 8 * F.lane); g[2 * j + 1] = *(const f32x4*)(gain + 512 * j + 8 * F.lane + 4); }
    for (int m0 = gw; m0 < M; m0 += 4 * NGW) {
        v4u v[4][2]; float sq[4];
#pragma unroll
        for (int r = 0; r < 4; ++r) { const bf16* xr = xb + (size_t)(m0 + r * NGW) * D + 8 * F.lane; sq[r] = ssq[m0 + r * NGW]; v[r][0] = *(const v4u*)xr; v[r][1] = *(const v4u*)(xr + 512); }
#pragma unroll
        for (int r = 0; r < 4; ++r) { float* orow = out + (size_t)(m0 + r * NGW) * D + 8 * F.lane; const float rs = __builtin_amdgcn_rsqf(sq[r] * (1.f / D) + EPS);
#pragma unroll
            for (int j = 0; j < 2; ++j) { const v4u w = v[r][j];
                *(f32x4*)(orow + 512 * j) = (f32x4){bflo(w.x), bfhi(w.x), bflo(w.y), bfhi(w.y)} * rs * g[2 * j];
                *(f32x4*)(orow + 512 * j + 4) = (f32x4){bflo(w.z), bfhi(w.z), bflo(w.w), bfhi(w.w)} * rs * g[2 * j + 1]; } }
    }
}
__device__ __forceinline__ void hgrn2_naive(Frame& F, int ci) {
    const int dir = ci & 1, h = (ci >> 1) & 3, b = ci >> 3;
    LAS float* QS = (LAS float*)(F.lds + RING_OFF); LAS float* FS = QS + 2048; LAS float* KS = FS + 2048; LAS float* VS = KS + 2048; LAS float* PART = VS + 2048;
    const bf16* ZQ = (const bf16*)(F.ws + WS_ZQ); const bf16* ZV = (const bf16*)(F.ws + WS_ZV); const bf16* ZL = (const bf16*)(F.ws + (dir ? WS_ZLB : WS_ZLF));
    float* OF = (float*)(F.ws + WS_SG); bf16* OB = (bf16*)(F.ws + WS_OB);
    const int v = F.tid & 127, kq = F.tid >> 7;
    float S[32];
#pragma unroll
    for (int i = 0; i < 32; ++i) S[i] = 0.f;
    for (int tl = 0; tl < T / 16; ++tl) {
        { const int tt = F.tid >> 5, k4 = (F.tid & 31) * 4; const int p = 16 * tl + tt, t = dir ? (T - 1 - p) : p; const size_t off = (size_t)(b * T + t) * DH + h * 128 + k4;
          const uint2 qw = *(const uint2*)(ZQ + off); const uint2 vw = *(const uint2*)(ZV + off); const uint2 lw = *(const uint2*)(ZL + off); const f32x4 lg = {bflo(lw.x), bfhi(lw.x), bflo(lw.y), bfhi(lw.y)};
          LAS float* q = QS + tt * 128 + k4; q[0] = bflo(qw.x); q[1] = bfhi(qw.x); q[2] = bflo(qw.y); q[3] = bfhi(qw.y);
          LAS float* vv = VS + tt * 128 + k4; vv[0] = bflo(vw.x); vv[1] = bfhi(vw.x); vv[2] = bflo(vw.y); vv[3] = bfhi(vw.y);
#pragma unroll
          for (int j = 0; j < 4; ++j) { const float f = __builtin_amdgcn_exp2f(lg[j]); FS[tt * 128 + k4 + j] = f; KS[tt * 128 + k4 + j] = 1.0f - f; } }
        __syncthreads();
        for (int tt = 0; tt < 16; ++tt) { const float vv = VS[tt * 128 + v]; float a = 0.f; const LAS float* fp = FS + tt * 128 + 32 * kq; const LAS float* kp = KS + tt * 128 + 32 * kq; const LAS float* qp = QS + tt * 128 + 32 * kq;
#pragma unroll
            for (int kk = 0; kk < 32; ++kk) { S[kk] = fp[kk] * S[kk] + kp[kk] * vv; a += S[kk] * qp[kk]; }
            PART[(kq * 16 + tt) * 128 + v] = a; }
        __syncthreads();
        { const int tt = F.tid >> 5, v4 = (F.tid & 31) * 4; const int p = 16 * tl + tt, t = dir ? (T - 1 - p) : p; const size_t off = (size_t)(b * T + t) * DH + h * 128 + v4;
          f32x4 o = {0.f, 0.f, 0.f, 0.f};
#pragma unroll
          for (int q = 0; q < 4; ++q) o += *(const LAS f32x4*)(PART + (q * 16 + tt) * 128 + v4);
          if (dir == 0) *(f32x4*)(OF + off) = o; else { uint2 w; w.x = pk2(o[0], o[1]); w.y = pk2(o[2], o[3]); *(uint2*)(OB + off) = w; } }
    }
}
__device__ __forceinline__ void rglru_seg(Frame& F, int pass) {
    const int b = F.bid >> 7, blk = (F.bid >> 4) & 7, sg = F.bid & 15;
    LAS float* L = (LAS float*)(F.lds + RING_OFF);
    for (int i = F.tid; i < 4 * 4096; i += NWAVES * 64) { const int mat = i >> 12; const float* src = mat == 0 ? FIN(15) : mat == 1 ? FIN(17) : mat == 2 ? FIN(20) : FIN(22); L[i] = src[(size_t)blk * 4096 + (i & 4095)]; }
    __syncthreads();
    if (F.wave < 4) {
        const int seg = sg * 4 + F.wave, e = F.lane, ch = 64 * blk + e, t0 = seg * 256;
        const bf16* ZRX = (const bf16*)(F.ws + WS_ZRX); const bf16* ZRG = (const bf16*)(F.ws + WS_ZRG); bf16* YM = (bf16*)(F.ws + WS_XN);
        const float* CL = (const float*)(F.ws + WS_RGCL); float2* TOT = (float2*)(F.ws + WS_RGTOT);
        const float* cw = FIN(13); const float c0 = cw[ch], c1 = cw[DH + ch], c2 = cw[2 * DH + ch], c3 = cw[3 * DH + ch], cb = FIN(14)[ch];
        for (int dir = 0; dir < 2; ++dir) {
            const LAS float* wa = L + (2 * dir) * 4096 + e; const LAS float* wx = L + (2 * dir + 1) * 4096 + e;
            const float ba = (dir ? FIN(21) : FIN(16))[ch], bx = (dir ? FIN(23) : FIN(18))[ch], cl = CL[dir * DH + ch];
            float hs = 0.f, A = 1.f;
            if (pass == 1) {
                if (dir == 0) { for (int s = 0; s < seg; ++s) { const float2 tt = TOT[(size_t)((b * 64 + s) * 2 + 0) * DH + ch]; hs = tt.x * hs + tt.y; } }
                else { for (int s = 63; s > seg; --s) { const float2 tt = TOT[(size_t)((b * 64 + s) * 2 + 1) * DH + ch]; hs = tt.x * hs + tt.y; } }
            }
            for (int p = 0; p < 256; ++p) {
                const int t = dir ? (t0 + 255 - p) : (t0 + p); const size_t m = (size_t)b * T + t;
                const float x0 = t >= 2 ? bf2f(ZRX[(m - 2) * DH + ch]) : 0.f, x1 = t >= 1 ? bf2f(ZRX[(m - 1) * DH + ch]) : 0.f, x2 = bf2f(ZRX[m * DH + ch]), x3 = t + 1 < T ? bf2f(ZRX[(m + 1) * DH + ch]) : 0.f;
                const float xc = cb + c0 * x0 + c1 * x1 + c2 * x2 + c3 * x3;
                float rp = ba, ip = bx;
#pragma unroll 8
                for (int d = 0; d < 64; ++d) { const float xd = __shfl(xc, d); rp += xd * wa[d * 64]; ip += xd * wx[d * 64]; }
                const float r = sigmoidf_(rp), ii = sigmoidf_(ip), l2a = cl * r, a = __builtin_amdgcn_exp2f(l2a);
                const float u = sqrtf(fmaxf(1.0f - __builtin_amdgcn_exp2f(2.0f * l2a), 0.f)) * ii * xc;
                hs = a * hs + u; A *= a;
                if (pass == 1) { bf16* yp = YM + m * D + DH + ch;
                    if (dir == 0) *yp = (bf16)f2bf(hs); else *yp = (bf16)f2bf((bf2f(*yp) + hs) * bf2f(ZRG[m * DH + ch])); }
            }
            if (pass == 0) TOT[(size_t)((b * 64 + seg) * 2 + dir) * DH + ch] = make_float2(A, hs);
            asm volatile("s_waitcnt vmcnt(0)" ::: "memory");
        }
    }
    __syncthreads();
}
__device__ __forceinline__ void hgrn2_combine_rows(Frame& F) {
    const float* OF = (const float*)(F.ws + WS_SG); const bf16* OB = (const bf16*)(F.ws + WS_OB); const bf16* ZG = (const bf16*)(F.ws + WS_ZG); bf16* YM = (bf16*)(F.ws + WS_XN);
    const float* gn = FIN(12);
    const int gw = F.bid * NWAVES + F.wave, NGW = F.G * NWAVES;
    for (int m = gw; m < M; m += NGW) {
        const size_t off = (size_t)m * DH + 8 * F.lane;
        const f32x4 a0 = *(const f32x4*)(OF + off), a1 = *(const f32x4*)(OF + off + 4); const v4u bw = *(const v4u*)(OB + off), gwd = *(const v4u*)(ZG + off);
        float o[8] = {a0[0] + bflo(bw.x), a0[1] + bfhi(bw.x), a0[2] + bflo(bw.y), a0[3] + bfhi(bw.y), a1[0] + bflo(bw.z), a1[1] + bfhi(bw.z), a1[2] + bflo(bw.w), a1[3] + bfhi(bw.w)};
        float s = 0.f;
#pragma unroll
        for (int j = 0; j < 8; ++j) s += o[j] * o[j];
        s += __shfl_xor(s, 1); s += __shfl_xor(s, 2); s += __shfl_xor(s, 4); s += __shfl_xor(s, 8);
        const float rstd = rsqrtf(s * (1.f / 128.f) + EPS);
        const f32x4 g0 = *(const f32x4*)(gn + (8 * F.lane & 127)), g1 = *(const f32x4*)(gn + (8 * F.lane & 127) + 4);
        const float gg[8] = {bflo(gwd.x), bfhi(gwd.x), bflo(gwd.y), bfhi(gwd.y), bflo(gwd.z), bfhi(gwd.z), bflo(gwd.w), bfhi(gwd.w)};
        v4u w; w.x = pk2(o[0] * rstd * g0[0] * gg[0], o[1] * rstd * g0[1] * gg[1]); w.y = pk2(o[2] * rstd * g0[2] * gg[2], o[3] * rstd * g0[3] * gg[3]);
        w.z = pk2(o[4] * rstd * g1[0] * gg[4], o[5] * rstd * g1[1] * gg[5]); w.w = pk2(o[6] * rstd * g1[2] * gg[6], o[7] * rstd * g1[3] * gg[7]);
        *(v4u*)(YM + (size_t)m * D + 8 * F.lane) = w;
    }
}
namespace hg {
constexpr int QT = 0, KH = 8704, KT = 17408, VT = 27648, PB = 37888, ST = 40448, DEC = 75264, SEG = 75776, OT = 79872;
constexpr int RS = 272, TS = 80, OTS = 132;
typedef short bf16x8 __attribute__((ext_vector_type(8)));
typedef unsigned u32x2 __attribute__((ext_vector_type(2)));
typedef float f32x2 __attribute__((ext_vector_type(2)));
constexpr int NSC = 32, SCT = 512, NCH = 16;
constexpr size_t CARRY_OFF = 32 * MiB;
__device__ __forceinline__ int slot_of(int b, int h, int j, int dir) { return (((b * 4 + h) * NSC + j) * 2 + dir); }

template <int MODE>
__device__ __forceinline__ void pass(Frame& F, int b, int h, int j, int dir) {
    LAS unsigned char* L = F.lds + RING_OFF;
    const int tid = F.tid, lane = F.lane, w = F.wave, fr = lane & 15, fq = lane >> 4, cp = lane, ts = w;
    const bf16* ZQ = (const bf16*)(F.ws + WS_ZQ); const bf16* ZV = (const bf16*)(F.ws + WS_ZV); const bf16* ZL = (const bf16*)(F.ws + (dir ? WS_ZLB : WS_ZLF));
    float* SGp = (float*)(F.ws + WS_SG + (MODE != 0 ? CARRY_OFF : 0)) + (size_t)slot_of(b, h, j, dir) * 16384;
    const int colq = h * 128 + 2 * cp;
    auto mrow = [&](int c, int r) -> size_t { const int pos = 32 * c + r; return (size_t)b * T + (dir ? (SCT * j + SCT - 1 - pos) : (SCT * j + pos)); };
    STAMPX(F, 40);
    f32x4 s[8];
#pragma unroll
    for (int i = 0; i < 8; ++i) s[i] = (f32x4){0.f, 0.f, 0.f, 0.f};
    if (MODE != 0) {
#pragma unroll
        for (int i = 0; i < 8; ++i) { s[i] = *(const f32x4*)(SGp + (16 * w + fr) * 128 + 16 * i + 4 * fq);
            u32x2 pk; pk.x = pg8::cvt_pk_bf16(s[i][0], s[i][1]); pk.y = pg8::cvt_pk_bf16(s[i][2], s[i][3]);
            *(LAS u32x2*)(L + ST + (16 * w + fr) * RS + (16 * i + 4 * fq) * 2) = pk; }
    }
    float dsum0 = 0.f, dsum1 = 0.f;
    f32x4 g0 = {0.f, 0.f, 0.f, 0.f}, g1 = {0.f, 0.f, 0.f, 0.f};
    if (MODE == 2) { g0 = *(const f32x4*)(FIN(12) + 8 * (tid & 15)); g1 = *(const f32x4*)(FIN(12) + 8 * (tid & 15) + 4); }
    unsigned qA[4], vA[4], lA[4], qB[4], vB[4], lB[4];
    v4u obA = {0u, 0u, 0u, 0u}, gwA = {0u, 0u, 0u, 0u}, obB = {0u, 0u, 0u, 0u}, gwB = {0u, 0u, 0u, 0u};
    auto issue = [&](int c, unsigned (&q)[4], unsigned (&v)[4], unsigned (&l)[4]) {
#pragma unroll
        for (int r = 0; r < 4; ++r) { const size_t m = mrow(c, 4 * ts + r); q[r] = *(const unsigned*)(ZQ + m * DH + colq); v[r] = *(const unsigned*)(ZV + m * DH + colq); l[r] = *(const unsigned*)(ZL + m * DH + colq); } };
    auto issue_comb = [&](int c, v4u& ob, v4u& gw) { const size_t m = mrow(c, tid >> 4); ob = *(const v4u*)((const bf16*)(F.ws + WS_OB) + m * DH + h * 128 + 8 * (tid & 15)); gw = *(const v4u*)((const bf16*)(F.ws + WS_ZG) + m * DH + h * 128 + 8 * (tid & 15)); };
    issue(0, qA, vA, lA); issue(1, qB, vB, lB);
    if (MODE == 2) { issue_comb(0, obA, gwA); issue_comb(1, obB, gwB); }
    auto body = [&](int c, unsigned (&qX)[4], unsigned (&vX)[4], unsigned (&lX)[4], v4u& obX, v4u& gwX) {
        unsigned qc[4], vc[4]; float2 lc[4];
#pragma unroll
        for (int r = 0; r < 4; ++r) { qc[r] = qX[r]; vc[r] = vX[r]; lc[r] = make_float2(bflo(lX[r]), bfhi(lX[r])); }
        if (c < NCH - 2) issue(c + 2, qX, vX, lX);
        float cs0[4], cs1[4];
        cs0[0] = lc[0].x; cs1[0] = lc[0].y;
#pragma unroll
        for (int r = 1; r < 4; ++r) { cs0[r] = cs0[r - 1] + lc[r].x; cs1[r] = cs1[r - 1] + lc[r].y; }
        *(LAS f32x2*)(L + SEG + (ts * 128 + 2 * cp) * 4) = (f32x2){cs0[3], cs1[3]};
        __syncthreads();
        float pre0 = 0.f, pre1 = 0.f, tot0 = 0.f, tot1 = 0.f;
#pragma unroll
        for (int t2 = 0; t2 < 8; ++t2) { const f32x2 sv = *(const LAS f32x2*)(L + SEG + (t2 * 128 + 2 * cp) * 4); tot0 += sv.x; tot1 += sv.y; if (t2 < ts) { pre0 += sv.x; pre1 += sv.y; } }
        dsum0 += tot0; dsum1 += tot1;
        if (ts == 0) *(LAS f32x2*)(L + DEC + 2 * cp * 4) = (f32x2){__builtin_amdgcn_exp2f(tot0), __builtin_amdgcn_exp2f(tot1)};
        unsigned kt0[2], kt1[2];
        float kta[4], ktb[4];
#pragma unroll
        for (int r = 0; r < 4; ++r) {
            const float b0 = pre0 + cs0[r], b1 = pre1 + cs1[r];
            const float q0 = bflo(qc[r]), q1 = bfhi(qc[r]);
            const float k0 = 1.0f - __builtin_amdgcn_exp2f(lc[r].x), k1 = 1.0f - __builtin_amdgcn_exp2f(lc[r].y);
            const int row = 4 * ts + r;
            if (MODE != 0) {
                *(LAS unsigned*)(L + QT + row * RS + 4 * cp) = pg8::cvt_pk_bf16(q0 * __builtin_amdgcn_exp2f(b0), q1 * __builtin_amdgcn_exp2f(b1));
                *(LAS unsigned*)(L + KH + row * RS + 4 * cp) = pg8::cvt_pk_bf16(k0 * __builtin_amdgcn_exp2f(fminf(-b0, 126.f)), k1 * __builtin_amdgcn_exp2f(fminf(-b1, 126.f)));
            }
            kta[r] = k0 * __builtin_amdgcn_exp2f(tot0 - b0); ktb[r] = k1 * __builtin_amdgcn_exp2f(tot1 - b1);
        }
        kt0[0] = pg8::cvt_pk_bf16(kta[0], kta[1]); kt0[1] = pg8::cvt_pk_bf16(kta[2], kta[3]); kt1[0] = pg8::cvt_pk_bf16(ktb[0], ktb[1]); kt1[1] = pg8::cvt_pk_bf16(ktb[2], ktb[3]);
        *(LAS u32x2*)(L + KT + (2 * cp) * TS + 8 * ts) = (u32x2){kt0[0], kt0[1]};
        *(LAS u32x2*)(L + KT + (2 * cp + 1) * TS + 8 * ts) = (u32x2){kt1[0], kt1[1]};
        {
            const unsigned a0 = (vc[0] & 0xffffu) | (vc[1] << 16), a1 = (vc[2] & 0xffffu) | (vc[3] << 16);
            const unsigned c0 = (vc[0] >> 16) | (vc[1] & 0xffff0000u), c1 = (vc[2] >> 16) | (vc[3] & 0xffff0000u);
            *(LAS u32x2*)(L + VT + (2 * cp) * TS + 8 * ts) = (u32x2){a0, a1};
            *(LAS u32x2*)(L + VT + (2 * cp + 1) * TS + 8 * ts) = (u32x2){c0, c1};
        }
        __syncthreads();
        f32x4 o[2] = {(f32x4){0.f, 0.f, 0.f, 0.f}, (f32x4){0.f, 0.f, 0.f, 0.f}};
        if (MODE != 0) {
            f32x4 p = (f32x4){0.f, 0.f, 0.f, 0.f}; const int pmt = (w >> 1) & 1, pnt = w & 1;
#pragma unroll
            for (int ks = 0; ks < 4; ++ks) {
                const bf16x8 a0 = *(const LAS bf16x8*)(L + QT + (fr) * RS + (32 * ks + 8 * fq) * 2), a1 = *(const LAS bf16x8*)(L + QT + (16 + fr) * RS + (32 * ks + 8 * fq) * 2);
                const bf16x8 bs = *(const LAS bf16x8*)(L + ST + (16 * w + fr) * RS + (32 * ks + 8 * fq) * 2);
                o[0] = __builtin_amdgcn_mfma_f32_16x16x32_bf16(a0, bs, o[0], 0, 0, 0);
                o[1] = __builtin_amdgcn_mfma_f32_16x16x32_bf16(a1, bs, o[1], 0, 0, 0);
                if (w < 4) { const bf16x8 bk = *(const LAS bf16x8*)(L + KH + (16 * pnt + fr) * RS + (32 * ks + 8 * fq) * 2);
                    p = __builtin_amdgcn_mfma_f32_16x16x32_bf16(pmt ? a1 : a0, bk, p, 0, 0, 0); }
            }
            if (w < 4) {
#pragma unroll
                for (int rg = 0; rg < 4; ++rg) { const int t = 16 * pmt + 4 * fq + rg, sc = 16 * pnt + fr; const float pv = (sc <= t) ? p[rg] : 0.f;
                    *(LAS unsigned short*)(L + PB + t * TS + sc * 2) = (unsigned short)(pg8::cvt_pk_bf16(pv, 0.f) & 0xffffu); }
            }
            __syncthreads();
        }
        const bf16x8 bv = *(const LAS bf16x8*)(L + VT + (16 * w + fr) * TS + 16 * fq);
        if (MODE != 0) {
#pragma unroll
            for (int mt = 0; mt < 2; ++mt) { const bf16x8 ap = *(const LAS bf16x8*)(L + PB + (16 * mt + fr) * TS + 16 * fq);
                o[mt] = __builtin_amdgcn_mfma_f32_16x16x32_bf16(ap, bv, o[mt], 0, 0, 0);
#pragma unroll
                for (int rg = 0; rg < 4; ++rg) *(LAS float*)(L + OT + ((16 * mt + 4 * fq + rg) * OTS + 16 * w + fr) * 4) = o[mt][rg]; }
        }
#pragma unroll
        for (int i = 0; i < 8; ++i) {
            const f32x4 d4 = *(const LAS f32x4*)(L + DEC + (16 * i + 4 * fq) * 4);
            const bf16x8 ak = *(const LAS bf16x8*)(L + KT + (16 * i + fr) * TS + 16 * fq);
            s[i] = s[i] * d4;
            s[i] = __builtin_amdgcn_mfma_f32_16x16x32_bf16(ak, bv, s[i], 0, 0, 0);
            if (MODE != 0) { u32x2 pk; pk.x = pg8::cvt_pk_bf16(s[i][0], s[i][1]); pk.y = pg8::cvt_pk_bf16(s[i][2], s[i][3]);
                *(LAS u32x2*)(L + ST + (16 * w + fr) * RS + (16 * i + 4 * fq) * 2) = pk; }
        }
        __syncthreads();
        if (MODE != 0) {
            const int t = tid >> 4, vg = tid & 15; const size_t m = mrow(c, t);
            const f32x4 o0 = *(const LAS f32x4*)(L + OT + (t * OTS + 8 * vg) * 4), o1 = *(const LAS f32x4*)(L + OT + (t * OTS + 8 * vg + 4) * 4);
            if (MODE == 1) {
                v4u wv; wv.x = pg8::cvt_pk_bf16(o0[0], o0[1]); wv.y = pg8::cvt_pk_bf16(o0[2], o0[3]); wv.z = pg8::cvt_pk_bf16(o1[0], o1[1]); wv.w = pg8::cvt_pk_bf16(o1[2], o1[3]);
                *(v4u*)((bf16*)(F.ws + WS_OB) + m * DH + h * 128 + 8 * vg) = wv;
            } else {
                const v4u bw = obX, gwd = gwX;
                float ov[8] = {o0[0] + bflo(bw.x), o0[1] + bfhi(bw.x), o0[2] + bflo(bw.y), o0[3] + bfhi(bw.y), o1[0] + bflo(bw.z), o1[1] + bfhi(bw.z), o1[2] + bflo(bw.w), o1[3] + bfhi(bw.w)};
                float ss = 0.f;
#pragma unroll
                for (int q = 0; q < 8; ++q) ss += ov[q] * ov[q];
                ss += __builtin_bit_cast(float, __builtin_amdgcn_update_dpp(0, __builtin_bit_cast(int, ss), 0xB1, 0xF, 0xF, true));
                ss += __builtin_bit_cast(float, __builtin_amdgcn_update_dpp(0, __builtin_bit_cast(int, ss), 0x4E, 0xF, 0xF, true));
                ss += __builtin_bit_cast(float, __builtin_amdgcn_update_dpp(0, __builtin_bit_cast(int, ss), 0x141, 0xF, 0xF, true));
                ss += __builtin_bit_cast(float, __builtin_amdgcn_update_dpp(0, __builtin_bit_cast(int, ss), 0x140, 0xF, 0xF, true));
                const float rstd = __builtin_amdgcn_rsqf(ss * (1.f / 128.f) + EPS);
                const float gg[8] = {bflo(gwd.x), bfhi(gwd.x), bflo(gwd.y), bfhi(gwd.y), bflo(gwd.z), bfhi(gwd.z), bflo(gwd.w), bfhi(gwd.w)};
                v4u wv; wv.x = pg8::cvt_pk_bf16(ov[0] * rstd * g0[0] * gg[0], ov[1] * rstd * g0[1] * gg[1]); wv.y = pg8::cvt_pk_bf16(ov[2] * rstd * g0[2] * gg[2], ov[3] * rstd * g0[3] * gg[3]);
                wv.z = pg8::cvt_pk_bf16(ov[4] * rstd * g1[0] * gg[4], ov[5] * rstd * g1[1] * gg[5]); wv.w = pg8::cvt_pk_bf16(ov[6] * rstd * g1[2] * gg[6], ov[7] * rstd * g1[3] * gg[7]);
                *(v4u*)((bf16*)(F.ws + WS_XN) + m * D + h * 128 + 8 * vg) = wv;
            }
            if (MODE == 2 && c < NCH - 2) issue_comb(c + 2, obX, gwX);
        }
    };
    STAMPX(F, 41);
    for (int c = 0; c < NCH; c += 2) { body(c, qA, vA, lA, obA, gwA); if (c == 6) STAMPX(F, 43); body(c + 1, qB, vB, lB, obB, gwB); if (c == 6) STAMPX(F, 44); }
    STAMPX(F, 42);
    if (MODE == 0) {
#pragma unroll
        for (int i = 0; i < 8; ++i) *(f32x4*)(SGp + (16 * w + fr) * 128 + 16 * i + 4 * fq) = s[i];
        if (ts == 0) *(float2*)((float*)(F.ws + WS_DG) + (size_t)slot_of(b, h, j, dir) * 128 + 2 * cp) = make_float2(__builtin_amdgcn_exp2f(dsum0), __builtin_amdgcn_exp2f(dsum1));
    }
    asm volatile("s_waitcnt vmcnt(0)" ::: "memory");
    __syncthreads();
}

template <int MODE>
__device__ __forceinline__ void pass_pipe(Frame& F, int b, int h, int j, int dir) {
    constexpr int SETB = 38400, oQT = 0, oKH = 8704, oKT = 17408, oVT = 27648, oDEC = 37888;
    constexpr int pPB = 76800, pST = 79360, pSEG = 114176, pOT = 122368;
    LAS unsigned char* L = F.lds + RING_OFF;
    int t_ = threadIdx.x; asm volatile("" : "+v"(t_));
    const int tid = t_, lane = t_ & 63, w = F.wave, fr = lane & 15, fq = lane >> 4, cp = lane, ts = w;
    const bf16* ZQ = (const bf16*)(F.ws + WS_ZQ); const bf16* ZV = (const bf16*)(F.ws + WS_ZV); const bf16* ZL = (const bf16*)(F.ws + (dir ? WS_ZLB : WS_ZLF));
    const bf16* SGp = (const bf16*)(F.ws + WS_SG + CARRY_OFF) + (size_t)slot_of(b, h, j, dir) * 16384;
    const int colq = h * 128 + 2 * cp;
    auto mrow = [&](int c, int r) -> size_t { const int pos = 32 * c + r; return (size_t)b * T + (dir ? (SCT * j + SCT - 1 - pos) : (SCT * j + pos)); };
    f32x4 s[8];
#pragma unroll
    for (int i = 0; i < 8; ++i) { const u32x2 pk = *(const u32x2*)(SGp + (16 * w + fr) * 128 + 16 * i + 4 * fq);
        s[i] = (f32x4){bflo(pk.x), bfhi(pk.x), bflo(pk.y), bfhi(pk.y)};
        *(LAS u32x2*)(L + pST + (16 * w + fr) * RS + (16 * i + 4 * fq) * 2) = pk; }
    f32x4 g0 = {0.f, 0.f, 0.f, 0.f}, g1 = {0.f, 0.f, 0.f, 0.f};
    if (MODE == 2) { g0 = *(const f32x4*)(FIN(12) + 8 * (tid & 15)); g1 = *(const f32x4*)(FIN(12) + 8 * (tid & 15) + 4); }
    unsigned qA[4], vA[4], lA[4], qB[4], vB[4], lB[4];
    v4u obA = {0u, 0u, 0u, 0u}, gwA = {0u, 0u, 0u, 0u}, obB = {0u, 0u, 0u, 0u}, gwB = {0u, 0u, 0u, 0u};
    auto issue = [&](int c, unsigned (&q)[4], unsigned (&v)[4], unsigned (&l)[4]) {
#pragma unroll
        for (int r = 0; r < 4; ++r) { const size_t m = mrow(c, 4 * ts + r); q[r] = *(const unsigned*)(ZQ + m * DH + colq); v[r] = *(const unsigned*)(ZV + m * DH + colq); l[r] = *(const unsigned*)(ZL + m * DH + colq); } };
    auto issue_comb = [&](int c, v4u& ob, v4u& gw) { const size_t m = mrow(c, tid >> 4); ob = *(const v4u*)((const bf16*)(F.ws + WS_OB) + m * DH + h * 128 + 8 * (tid & 15)); gw = *(const v4u*)((const bf16*)(F.ws + WS_ZG) + m * DH + h * 128 + 8 * (tid & 15)); };
    auto seg_write = [&](const unsigned (&l)[4], int sb) { float t0 = 0.f, t1 = 0.f;
#pragma unroll
        for (int r = 0; r < 4; ++r) { t0 += bflo(l[r]); t1 += bfhi(l[r]); }
        *(LAS f32x2*)(L + pSEG + sb * 4096 + (ts * 128 + 2 * cp) * 4) = (f32x2){t0, t1}; };
    auto prep = [&](const unsigned (&q)[4], const unsigned (&v)[4], const unsigned (&l)[4], int so, int sb) {
        float2 lc[4]; float cs0[4], cs1[4];
#pragma unroll
        for (int r = 0; r < 4; ++r) lc[r] = make_float2(bflo(l[r]), bfhi(l[r]));
        cs0[0] = lc[0].x; cs1[0] = lc[0].y;
#pragma unroll
        for (int r = 1; r < 4; ++r) { cs0[r] = cs0[r - 1] + lc[r].x; cs1[r] = cs1[r - 1] + lc[r].y; }
        float pre0 = 0.f, pre1 = 0.f, tot0 = 0.f, tot1 = 0.f;
#pragma unroll
        for (int t2 = 0; t2 < 8; ++t2) { const f32x2 sv = *(const LAS f32x2*)(L + pSEG + sb * 4096 + (t2 * 128 + 2 * cp) * 4); tot0 += sv.x; tot1 += sv.y; if (t2 < ts) { pre0 += sv.x; pre1 += sv.y; } }
        if (ts == 0) *(LAS f32x2*)(L + so + oDEC + 2 * cp * 4) = (f32x2){__builtin_amdgcn_exp2f(tot0), __builtin_amdgcn_exp2f(tot1)};
        float kta[4], ktb[4];
#pragma unroll
        for (int r = 0; r < 4; ++r) {
            const float b0 = pre0 + cs0[r], b1 = pre1 + cs1[r];
            const float q0 = bflo(q[r]), q1 = bfhi(q[r]);
            const float k0 = 1.0f - __builtin_amdgcn_exp2f(lc[r].x), k1 = 1.0f - __builtin_amdgcn_exp2f(lc[r].y);
            const int row = 4 * ts + r;
            *(LAS unsigned*)(L + so + oQT + row * RS + 4 * cp) = pg8::cvt_pk_bf16(q0 * __builtin_amdgcn_exp2f(b0), q1 * __builtin_amdgcn_exp2f(b1));
            *(LAS unsigned*)(L + so + oKH + row * RS + 4 * cp) = pg8::cvt_pk_bf16(k0 * __builtin_amdgcn_exp2f(fminf(-b0, 126.f)), k1 * __builtin_amdgcn_exp2f(fminf(-b1, 126.f)));
            kta[r] = k0 * __builtin_amdgcn_exp2f(tot0 - b0); ktb[r] = k1 * __builtin_amdgcn_exp2f(tot1 - b1);
        }
        *(LAS u32x2*)(L + so + oKT + (2 * cp) * TS + 8 * ts) = (u32x2){pg8::cvt_pk_bf16(kta[0], kta[1]), pg8::cvt_pk_bf16(kta[2], kta[3])};
        *(LAS u32x2*)(L + so + oKT + (2 * cp + 1) * TS + 8 * ts) = (u32x2){pg8::cvt_pk_bf16(ktb[0], ktb[1]), pg8::cvt_pk_bf16(ktb[2], ktb[3])};
        *(LAS u32x2*)(L + so + oVT + (2 * cp) * TS + 8 * ts) = (u32x2){(v[0] & 0xffffu) | (v[1] << 16), (v[2] & 0xffffu) | (v[3] << 16)};
        *(LAS u32x2*)(L + so + oVT + (2 * cp + 1) * TS + 8 * ts) = (u32x2){(v[0] >> 16) | (v[1] & 0xffff0000u), (v[2] >> 16) | (v[3] & 0xffff0000u)};
    };
    auto stage1 = [&](int so, f32x4 (&o)[2]) {
        f32x4 p = (f32x4){0.f, 0.f, 0.f, 0.f}; const int pmt = (w >> 1) & 1, pnt = w & 1;
#pragma unroll
        for (int ks = 0; ks < 4; ++ks) {
            const bf16x8 a0 = *(const LAS bf16x8*)(L + so + oQT + (fr) * RS + (32 * ks + 8 * fq) * 2), a1 = *(const LAS bf16x8*)(L + so + oQT + (16 + fr) * RS + (32 * ks + 8 * fq) * 2);
            const bf16x8 bs = *(const LAS bf16x8*)(L + pST + (16 * w + fr) * RS + (32 * ks + 8 * fq) * 2);
            o[0] = __builtin_amdgcn_mfma_f32_16x16x32_bf16(a0, bs, o[0], 0, 0, 0);
            o[1] = __builtin_amdgcn_mfma_f32_16x16x32_bf16(a1, bs, o[1], 0, 0, 0);
            if (w < 4) { const bf16x8 bk = *(const LAS bf16x8*)(L + so + oKH + (16 * pnt + fr) * RS + (32 * ks + 8 * fq) * 2);
                p = __builtin_amdgcn_mfma_f32_16x16x32_bf16(pmt ? a1 : a0, bk, p, 0, 0, 0); }
        }
        if (w < 4) {
#pragma unroll
            for (int rg = 0; rg < 4; ++rg) { const int t = 16 * pmt + 4 * fq + rg, sc = 16 * pnt + fr; const float pv = (sc <= t) ? p[rg] : 0.f;
                *(LAS unsigned short*)(L + pPB + t * TS + sc * 2) = (unsigned short)(pg8::cvt_pk_bf16(pv, 0.f) & 0xffffu); }
        }
    };
    auto stage2 = [&](int so, f32x4 (&o)[2]) {
        const bf16x8 bv = *(const LAS bf16x8*)(L + so + oVT + (16 * w + fr) * TS + 16 * fq);
#pragma unroll
        for (int mt = 0; mt < 2; ++mt) { const bf16x8 ap = *(const LAS bf16x8*)(L + pPB + (16 * mt + fr) * TS + 16 * fq);
            o[mt] = __builtin_amdgcn_mfma_f32_16x16x32_bf16(ap, bv, o[mt], 0, 0, 0);
#pragma unroll
            for (int rg = 0; rg < 4; ++rg) *(LAS float*)(L + pOT + ((16 * mt + 4 * fq + rg) * OTS + 16 * w + fr) * 4) = o[mt][rg]; }
#pragma unroll
        for (int i = 0; i < 8; ++i) {
            const f32x4 d4 = *(const LAS f32x4*)(L + so + oDEC + (16 * i + 4 * fq) * 4);
            const bf16x8 ak = *(const LAS bf16x8*)(L + so + oKT + (16 * i + fr) * TS + 16 * fq);
            s[i] = s[i] * d4;
            s[i] = __builtin_amdgcn_mfma_f32_16x16x32_bf16(ak, bv, s[i], 0, 0, 0);
            u32x2 pk; pk.x = pg8::cvt_pk_bf16(s[i][0], s[i][1]); pk.y = pg8::cvt_pk_bf16(s[i][2], s[i][3]);
            *(LAS u32x2*)(L + pST + (16 * w + fr) * RS + (16 * i + 4 * fq) * 2) = pk;
        }
    };
    auto combine = [&](int c, const v4u& obX, const v4u& gwX) {
        const int t = tid >> 4, vg = tid & 15; const size_t m = mrow(c, t);
        const f32x4 o0 = *(const LAS f32x4*)(L + pOT + (t * OTS + 8 * vg) * 4), o1 = *(const LAS f32x4*)(L + pOT + (t * OTS + 8 * vg + 4) * 4);
        if (MODE == 1) {
            v4u wv; wv.x = pg8::cvt_pk_bf16(o0[0], o0[1]); wv.y = pg8::cvt_pk_bf16(o0[2], o0[3]); wv.z = pg8::cvt_pk_bf16(o1[0], o1[1]); wv.w = pg8::cvt_pk_bf16(o1[2], o1[3]);
            *(v4u*)((bf16*)(F.ws + WS_OB) + m * DH + h * 128 + 8 * vg) = wv;
        } else {
            const v4u bw = obX, gwd = gwX;
            float ov[8] = {o0[0] + bflo(bw.x), o0[1] + bfhi(bw.x), o0[2] + bflo(bw.y), o0[3] + bfhi(bw.y), o1[0] + bflo(bw.z), o1[1] + bfhi(bw.z), o1[2] + bflo(bw.w), o1[3] + bfhi(bw.w)};
            float ss = 0.f;
#pragma unroll
            for (int q = 0; q < 8; ++q) ss += ov[q] * ov[q];
            ss += __builtin_bit_cast(float, __builtin_amdgcn_update_dpp(0, __builtin_bit_cast(int, ss), 0xB1, 0xF, 0xF, true));
            ss += __builtin_bit_cast(float, __builtin_amdgcn_update_dpp(0, __builtin_bit_cast(int, ss), 0x4E, 0xF, 0xF, true));
            ss += __builtin_bit_cast(float, __builtin_amdgcn_update_dpp(0, __builtin_bit_cast(int, ss), 0x141, 0xF, 0xF, true));
            ss += __builtin_bit_cast(float, __builtin_amdgcn_update_dpp(0, __builtin_bit_cast(int, ss), 0x140, 0xF, 0xF, true));
            const float rstd = __builtin_amdgcn_rsqf(ss * (1.f / 128.f) + EPS);
            const float gg[8] = {bflo(gwd.x), bfhi(gwd.x), bflo(gwd.y), bfhi(gwd.y), bflo(gwd.z), bfhi(gwd.z), bflo(gwd.w), bfhi(gwd.w)};
            v4u wv; wv.x = pg8::cvt_pk_bf16(ov[0] * rstd * g0[0] * gg[0], ov[1] * rstd * g0[1] * gg[1]); wv.y = pg8::cvt_pk_bf16(ov[2] * rstd * g0[2] * gg[2], ov[3] * rstd * g0[3] * gg[3]);
            wv.z = pg8::cvt_pk_bf16(ov[4] * rstd * g1[0] * gg[4], ov[5] * rstd * g1[1] * gg[5]); wv.w = pg8::cvt_pk_bf16(ov[6] * rstd * g1[2] * gg[6], ov[7] * rstd * g1[3] * gg[7]);
            *(v4u*)((bf16*)(F.ws + WS_XN) + m * D + h * 128 + 8 * vg) = wv;
        }
    };
    issue(0, qA, vA, lA); issue(1, qB, vB, lB);
    if (MODE == 2) { issue_comb(0, obA, gwA); issue_comb(1, obB, gwB); }
    seg_write(lA, 0); seg_write(lB, 1);
    __syncthreads();
    prep(qA, vA, lA, 0, 0); issue(2, qA, vA, lA);
    __syncthreads();
    auto step = [&](int c, int so, int sn, unsigned (&qX)[4], unsigned (&vX)[4], unsigned (&lX)[4], unsigned (&qY)[4], unsigned (&vY)[4], unsigned (&lY)[4], v4u& obP, v4u& gwP) {
        f32x4 o[2] = {(f32x4){0.f, 0.f, 0.f, 0.f}, (f32x4){0.f, 0.f, 0.f, 0.f}};
        stage1(so, o);
        if (c > 0) { combine(c - 1, obP, gwP); if (MODE == 2 && c + 1 < NCH) issue_comb(c + 1, obP, gwP); }
        if (c + 2 < NCH) seg_write(lX, c & 1);
        __syncthreads();
        stage2(so, o);
        if (c + 1 < NCH) { prep(qY, vY, lY, sn, (c + 1) & 1); if (c + 3 < NCH) issue(c + 3, qY, vY, lY); }
        __syncthreads();
    };
    for (int c = 0; c < NCH; c += 2) {
        step(c, 0, SETB, qA, vA, lA, qB, vB, lB, obB, gwB);
        step(c + 1, SETB, 0, qB, vB, lB, qA, vA, lA, obA, gwA);
    }
    combine(NCH - 1, obB, gwB);
    asm volatile("s_waitcnt vmcnt(0)" ::: "memory");
    __syncthreads();
}

__device__ __forceinline__ void pass0_direct(Frame& F, int b, int h, int j, int dir) {
    constexpr int KT2 = 0, VT2 = 34816, SEG2 = 69632;
    LAS unsigned char* L = F.lds + RING_OFF;
    const int lane = F.lane, w = F.wave, fr = lane & 15, fq = lane >> 4, cp = lane, ts = w;
    const bf16* ZV = (const bf16*)(F.ws + WS_ZV); const bf16* ZL = (const bf16*)(F.ws + (dir ? WS_ZLB : WS_ZLF));
    const int colq = h * 128 + 2 * cp;
    auto mrow = [&](int pos) -> size_t { return (size_t)b * T + (dir ? (SCT * j + SCT - 1 - pos) : (SCT * j + pos)); };
    f32x4 s[8];
#pragma unroll
    for (int i = 0; i < 8; ++i) s[i] = (f32x4){0.f, 0.f, 0.f, 0.f};
    float c0 = 0.f, c1 = 0.f;
    unsigned ln[16], vn[16];
#pragma unroll
    for (int r = 0; r < 16; ++r) { const size_t m = mrow(SCT - 128 + 16 * ts + r); ln[r] = *(const unsigned*)(ZL + m * DH + colq); vn[r] = *(const unsigned*)(ZV + m * DH + colq); }
    for (int blk = SCT / 128 - 1; blk >= 0; --blk) {
        float l0[16], l1[16]; unsigned vc[16];
#pragma unroll
        for (int r = 0; r < 16; ++r) { l0[r] = bflo(ln[r]); l1[r] = bfhi(ln[r]); vc[r] = vn[r]; }
        if (blk > 0) {
#pragma unroll
            for (int r = 0; r < 16; ++r) { const size_t m = mrow(128 * (blk - 1) + 16 * ts + r); ln[r] = *(const unsigned*)(ZL + m * DH + colq); vn[r] = *(const unsigned*)(ZV + m * DH + colq); }
        }
        float t0 = 0.f, t1 = 0.f;
#pragma unroll
        for (int r = 0; r < 16; ++r) { t0 += l0[r]; t1 += l1[r]; }
        *(LAS f32x2*)(L + SEG2 + (ts * 128 + 2 * cp) * 4) = (f32x2){t0, t1};
        __syncthreads();
        float a0 = c0, a1 = c1, tt0 = 0.f, tt1 = 0.f;
#pragma unroll
        for (int t2 = 0; t2 < 8; ++t2) { const f32x2 sv = *(const LAS f32x2*)(L + SEG2 + (t2 * 128 + 2 * cp) * 4); tt0 += sv.x; tt1 += sv.y; if (t2 > ts) { a0 += sv.x; a1 += sv.y; } }
        c0 += tt0; c1 += tt1;
        float k0v[16], k1v[16];
        float e0 = __builtin_amdgcn_exp2f(a0), e1 = __builtin_amdgcn_exp2f(a1);
#pragma unroll
        for (int r = 15; r >= 0; --r) {
            const float f0 = __builtin_amdgcn_exp2f(l0[r]), f1 = __builtin_amdgcn_exp2f(l1[r]);
            k0v[r] = (1.0f - f0) * e0; k1v[r] = (1.0f - f1) * e1;
            e0 *= f0; e1 *= f1; }
        v4u w0, w1;
#pragma unroll
        for (int hh = 0; hh < 2; ++hh) {
            w0.x = pg8::cvt_pk_bf16(k0v[8 * hh + 0], k0v[8 * hh + 1]); w0.y = pg8::cvt_pk_bf16(k0v[8 * hh + 2], k0v[8 * hh + 3]); w0.z = pg8::cvt_pk_bf16(k0v[8 * hh + 4], k0v[8 * hh + 5]); w0.w = pg8::cvt_pk_bf16(k0v[8 * hh + 6], k0v[8 * hh + 7]);
            w1.x = pg8::cvt_pk_bf16(k1v[8 * hh + 0], k1v[8 * hh + 1]); w1.y = pg8::cvt_pk_bf16(k1v[8 * hh + 2], k1v[8 * hh + 3]); w1.z = pg8::cvt_pk_bf16(k1v[8 * hh + 4], k1v[8 * hh + 5]); w1.w = pg8::cvt_pk_bf16(k1v[8 * hh + 6], k1v[8 * hh + 7]);
            *(LAS v4u*)(L + KT2 + (2 * cp) * RS + (16 * ts + 8 * hh) * 2) = w0; *(LAS v4u*)(L + KT2 + (2 * cp + 1) * RS + (16 * ts + 8 * hh) * 2) = w1;
            v4u x0, x1;
            x0.x = (vc[8 * hh + 0] & 0xffffu) | (vc[8 * hh + 1] << 16); x0.y = (vc[8 * hh + 2] & 0xffffu) | (vc[8 * hh + 3] << 16); x0.z = (vc[8 * hh + 4] & 0xffffu) | (vc[8 * hh + 5] << 16); x0.w = (vc[8 * hh + 6] & 0xffffu) | (vc[8 * hh + 7] << 16);
            x1.x = (vc[8 * hh + 0] >> 16) | (vc[8 * hh + 1] & 0xffff0000u); x1.y = (vc[8 * hh + 2] >> 16) | (vc[8 * hh + 3] & 0xffff0000u); x1.z = (vc[8 * hh + 4] >> 16) | (vc[8 * hh + 5] & 0xffff0000u); x1.w = (vc[8 * hh + 6] >> 16) | (vc[8 * hh + 7] & 0xffff0000u);
            *(LAS v4u*)(L + VT2 + (2 * cp) * RS + (16 * ts + 8 * hh) * 2) = x0; *(LAS v4u*)(L + VT2 + (2 * cp + 1) * RS + (16 * ts + 8 * hh) * 2) = x1;
        }
        __syncthreads();
#pragma unroll
        for (int ks = 0; ks < 4; ++ks) {
            const bf16x8 bv = *(const LAS bf16x8*)(L + VT2 + (16 * w + fr) * RS + (32 * ks + 8 * fq) * 2);
#pragma unroll
            for (int i = 0; i < 8; ++i) { const bf16x8 ak = *(const LAS bf16x8*)(L + KT2 + (16 * i + fr) * RS + (32 * ks + 8 * fq) * 2);
                s[i] = __builtin_amdgcn_mfma_f32_16x16x32_bf16(ak, bv, s[i], 0, 0, 0); }
        }
        __syncthreads();
    }
    bf16* SGp = (bf16*)(F.ws + WS_SG) + (size_t)slot_of(b, h, j, dir) * 16384;
#pragma unroll
    for (int i = 0; i < 8; ++i) *(u32x2*)(SGp + (16 * w + fr) * 128 + 16 * i + 4 * fq) = (u32x2){pg8::cvt_pk_bf16(s[i][0], s[i][1]), pg8::cvt_pk_bf16(s[i][2], s[i][3])};
    if (ts == 0) *(float2*)((float*)(F.ws + WS_DG) + (size_t)slot_of(b, h, j, dir) * 128 + 2 * cp) = make_float2(__builtin_amdgcn_exp2f(c0), __builtin_amdgcn_exp2f(c1));
    asm volatile("s_waitcnt vmcnt(0)" ::: "memory");
    __syncthreads();
}
__device__ __forceinline__ void pass2(Frame& F) {
    const unsigned* SU = (const unsigned*)(F.ws + WS_SG); unsigned* SC = (unsigned*)(F.ws + WS_SG + CARRY_OFF); const float* DG = (const float*)(F.ws + WS_DG);
    const int gt = F.bid * (NWAVES * 64) + F.tid, NT = F.G * NWAVES * 64;
    for (int i = gt; i < 16 * 8192; i += NT) {
        const int chain = i >> 13, e2 = i & 8191, dir = chain & 1, bh = chain >> 1, k0 = (2 * e2) & 127;
        f32x2 carry = (f32x2){0.f, 0.f};
        for (int st0 = 0; st0 < NSC; st0 += 16) {
            unsigned u[16]; f32x2 d[16];
#pragma unroll
            for (int q = 0; q < 16; ++q) { const int jj = dir ? NSC - 1 - (st0 + q) : (st0 + q); const size_t sl = (size_t)((bh * NSC + jj) * 2 + dir);
                u[q] = SU[sl * 8192 + e2]; d[q] = *(const f32x2*)(DG + sl * 128 + k0); }
#pragma unroll
            for (int q = 0; q < 16; ++q) { const int jj = dir ? NSC - 1 - (st0 + q) : (st0 + q); const size_t sl = (size_t)((bh * NSC + jj) * 2 + dir);
                SC[sl * 8192 + e2] = pg8::cvt_pk_bf16(carry.x, carry.y); carry = d[q] * carry + (f32x2){bflo(u[q]), bfhi(u[q])}; }
        }
    }
}
}
namespace rg {
#ifndef FIX_BATCH
#define FIX_BATCH 8
#endif
typedef short bf16x8 __attribute__((ext_vector_type(8)));
constexpr int XCS = 144, XCB = 256 * XCS + 256;
constexpr int OUTT = 2 * XCB, OTS = 272;
constexpr size_t WS_CIN = WS_DG + 512 * 1024;
constexpr size_t WS_RGSUB = 496 * MiB;

template <int DIR>
__device__ __forceinline__ void group_prefix(float Ag, float Hg, float& EA, float& EH, float& TA, float& TH, int lane) {
    const int g = lane >> 4; EA = 1.f; EH = 0.f;
#pragma unroll
    for (int rnd = 1; rnd < 4; ++rnd) {
        const float ca = Ag * EA, chh = Ag * EH + Hg;
        const float na = DIR == 0 ? __shfl_up(ca, 16) : __shfl_down(ca, 16), nh = DIR == 0 ? __shfl_up(chh, 16) : __shfl_down(chh, 16);
        const bool take = DIR == 0 ? (g == rnd) : (g == 3 - rnd);
        EA = take ? na : EA; EH = take ? nh : EH;
    }
    const int last = DIR == 0 ? 48 + (lane & 15) : (lane & 15);
    TA = __shfl(Ag * EA, last); TH = __shfl(Ag * EH + Hg, last);
}
template <int PASS>
__device__ __forceinline__ void item(Frame& F, int b, int j, int bp) {
    LAS unsigned char* L = F.lds + RING_OFF;
    const int tid = F.tid, lane = F.lane, w = F.wave, fr = lane & 15, fq = lane >> 4;
    const bf16* ZRX = (const bf16*)(F.ws + WS_ZRX);
    const int t0 = 256 * j;
    STAMPX(F, 30);
    const int blk = 2 * bp + (w >> 2), nt = w & 3, e = 16 * nt + fr, ch = 64 * blk + e, ss = 4 * j + fq;
    const bf16* RGW = (const bf16*)(F.ws + WS_RGW);
    const float* CL = (const float*)(F.ws + WS_RGCL);
    float2* TOT = (float2*)(F.ws + WS_RGSUB); float2* TSEG = (float2*)(F.ws + WS_RGTOT); const float* CIN = (const float*)(F.ws + WS_CIN);
    bf16x8 wa_[2][2], wx_[2][2]; float ba_[2], bx_[2], cl_[2]; float2 mine_[2] = {make_float2(1.f, 0.f), make_float2(1.f, 0.f)}; float cseg_[2] = {0.f, 0.f};
#pragma unroll
    for (int dir = 0; dir < 2; ++dir) {
#pragma unroll
        for (int ks = 0; ks < 2; ++ks) { wa_[dir][ks] = *(const bf16x8*)(RGW + (size_t)(((2 * dir) * 8 + blk) * 64 + e) * 64 + 32 * ks + 8 * fq); wx_[dir][ks] = *(const bf16x8*)(RGW + (size_t)(((2 * dir + 1) * 8 + blk) * 64 + e) * 64 + 32 * ks + 8 * fq); }
        ba_[dir] = (dir ? FIN(21) : FIN(16))[ch] * -1.44269504f; bx_[dir] = (dir ? FIN(23) : FIN(18))[ch] * -1.44269504f; cl_[dir] = CL[dir * DH + ch];
        if (PASS == 1) { mine_[dir] = TOT[(size_t)((b * 256 + ss) * 2 + dir) * DH + ch]; cseg_[dir] = CIN[(size_t)((b * 64 + j) * 2 + dir) * DH + ch]; }
    }
    v4u gt[8];
    if (PASS == 1) { const bf16* ZRG = (const bf16*)(F.ws + WS_ZRG);
#pragma unroll
        for (int q = 0; q < 8; ++q) { const int c16 = tid + 512 * q, tt = c16 >> 4, cc = c16 & 15; gt[q] = *(const v4u*)(ZRG + ((size_t)b * T + t0 + tt) * DH + 128 * bp + 8 * cc); } }
    {
        const int cp = lane, tg = w, cg = 128 * bp + 2 * cp;
        const float* cw = FIN(13); const float* cbp = FIN(14);
        const int tb = t0 + 32 * tg;
        unsigned x[35];
#pragma unroll
        for (int q = 0; q < 35; ++q) { const int t = tb + q - 2, tc = t < 0 ? 0 : (t >= T ? T - 1 : t); x[q] = *(const unsigned*)(ZRX + ((size_t)b * T + tc) * DH + cg); }
#pragma unroll
        for (int q = 0; q < 35; ++q) { const int t = tb + q - 2; x[q] = (t >= 0 && t < T) ? x[q] : 0u; }
        const float w00 = cw[cg], w01 = cw[cg + 1], w10 = cw[DH + cg], w11 = cw[DH + cg + 1], w20 = cw[2 * DH + cg], w21 = cw[2 * DH + cg + 1], w30 = cw[3 * DH + cg], w31 = cw[3 * DH + cg + 1], cb0 = cbp[cg], cb1 = cbp[cg + 1];
        LAS unsigned char* dst = L + (cp >> 5) * XCB + (32 * tg) * XCS + 64 * (tg >> 1) + 4 * (cp & 31);
#pragma unroll
        for (int q = 0; q < 32; ++q) {
            const float y0 = cb0 + w00 * bflo(x[q]) + w10 * bflo(x[q + 1]) + w20 * bflo(x[q + 2]) + w30 * bflo(x[q + 3]);
            const float y1 = cb1 + w01 * bfhi(x[q]) + w11 * bfhi(x[q + 1]) + w21 * bfhi(x[q + 2]) + w31 * bfhi(x[q + 3]);
            *(LAS unsigned*)(dst + q * XCS) = pg8::cvt_pk_bf16(y0, y1);
        }
    }
    __syncthreads();
    STAMPX(F, 31);
    const LAS unsigned char* XA = L + (w >> 2) * XCB + (64 * (fr >> 2) + (fr & 3)) * XCS + 64 * (fr >> 2) + 16 * fq;
    bf16x8 idf[2];
#pragma unroll
    for (int ks = 0; ks < 2; ++ks)
#pragma unroll
        for (int q = 0; q < 8; ++q) idf[ks][q] = (32 * ks + 8 * fq + q == e) ? (short)0x3F80 : (short)0;
#pragma unroll
    for (int dir = 0; dir < 2; ++dir) {
        const bf16x8 wa[2] = {wa_[dir][0], wa_[dir][1]}, wx[2] = {wx_[dir][0], wx_[dir][1]}; const float ba = ba_[dir], bx = bx_[dir], cl = cl_[dir];
        float carry = 0.f, atot = 1.f;
        if (PASS == 1) {
            const float2 mine = mine_[dir]; const float cseg = cseg_[dir];
            float EA, EH, TA, TH;
            if (dir == 0) group_prefix<0>(mine.x, mine.y, EA, EH, TA, TH, lane); else group_prefix<1>(mine.x, mine.y, EA, EH, TA, TH, lane);
            carry = EA * cseg + EH;
        }
        LAS unsigned char* const ot = L + OUTT + (64 * fq) * OTS + 64 * fq + 128 * (w >> 2) + 2 * e;
        const __amdgpu_buffer_rsrc_t locr = __builtin_amdgcn_make_buffer_rsrc((void*)((unsigned*)F.out + (size_t)dir * ((size_t)M * DH)), (short)0, (int)(M * DH * 4), 0x00020000);
        const unsigned locv = (unsigned)((((size_t)b * T + t0 + 64 * fq) * DH + ch) * 4);
#pragma unroll 2
        for (int mi = 0; mi < 16; ++mi) {
            const int mt = dir ? 15 - mi : mi;
            const bf16x8 a0 = *(const LAS bf16x8*)(XA + (4 * mt) * XCS), a1 = *(const LAS bf16x8*)(XA + (4 * mt) * XCS + 64);
            f32x4 cr = {ba, ba, ba, ba}, ci = {bx, bx, bx, bx}, cx = {0.f, 0.f, 0.f, 0.f};
            cr = __builtin_amdgcn_mfma_f32_16x16x32_bf16(a0, wa[0], cr, 0, 0, 0); cr = __builtin_amdgcn_mfma_f32_16x16x32_bf16(a1, wa[1], cr, 0, 0, 0);
            ci = __builtin_amdgcn_mfma_f32_16x16x32_bf16(a0, wx[0], ci, 0, 0, 0); ci = __builtin_amdgcn_mfma_f32_16x16x32_bf16(a1, wx[1], ci, 0, 0, 0);
            cx = __builtin_amdgcn_mfma_f32_16x16x32_bf16(a0, idf[0], cx, 0, 0, 0); cx = __builtin_amdgcn_mfma_f32_16x16x32_bf16(a1, idf[1], cx, 0, 0, 0);
            float hv[4];
#pragma unroll
            for (int q = 0; q < 4; ++q) {
                const int r = dir ? 3 - q : q;
                const float rr = __builtin_amdgcn_rcpf(1.0f + __builtin_amdgcn_exp2f(cr[r])), ii = __builtin_amdgcn_rcpf(1.0f + __builtin_amdgcn_exp2f(ci[r])), l2a = cl * rr;
                const float av = __builtin_amdgcn_exp2f(l2a), uv = __builtin_amdgcn_sqrtf(__builtin_fmaf(-av, av, 1.0f)) * ii * cx[r];
                carry = av * carry + uv; atot *= av; hv[r] = carry;
                if (PASS == 0) __builtin_amdgcn_raw_buffer_store_b32(pg8::cvt_pk_bf16(carry, atot), locr, locv + (unsigned)(r * DH * 4), (unsigned)(mt * 4 * DH * 4), 0);
            }
            if (PASS == 1) {
#pragma unroll
                for (int r = 0; r < 4; ++r) { LAS unsigned short* p = (LAS unsigned short*)(ot + (4 * mt + r) * OTS);
                    const float hsum = dir == 0 ? hv[r] : hv[r] + bf2f(*p);
                    *p = (unsigned short)(pg8::cvt_pk_bf16(hsum, 0.f) & 0xffffu); }
            }
        }
        if (PASS == 0) {
            TOT[(size_t)((b * 256 + ss) * 2 + dir) * DH + ch] = make_float2(atot, carry);
            float EA, EH, TA, TH;
            if (dir == 0) group_prefix<0>(atot, carry, EA, EH, TA, TH, lane); else group_prefix<1>(atot, carry, EA, EH, TA, TH, lane);
            if (fq == 0) TSEG[(size_t)((b * 64 + j) * 2 + dir) * DH + ch] = make_float2(TA, TH);
        }
    }
    STAMPX(F, 32);
    __syncthreads();
    STAMPX(F, 33);
    if (PASS == 1) {
        bf16* YM = (bf16*)(F.ws + WS_XN);
#pragma unroll
        for (int q = 0; q < 8; ++q) { const int c16 = tid + 512 * q, tt = c16 >> 4, cc = c16 & 15;
            const v4u hw = *(const LAS v4u*)(L + OUTT + tt * OTS + 64 * (tt >> 6) + 16 * cc);
            v4u o; o.x = pg8::cvt_pk_bf16(bflo(hw.x) * bflo(gt[q].x), bfhi(hw.x) * bfhi(gt[q].x)); o.y = pg8::cvt_pk_bf16(bflo(hw.y) * bflo(gt[q].y), bfhi(hw.y) * bfhi(gt[q].y));
            o.z = pg8::cvt_pk_bf16(bflo(hw.z) * bflo(gt[q].z), bfhi(hw.z) * bfhi(gt[q].z)); o.w = pg8::cvt_pk_bf16(bflo(hw.w) * bflo(gt[q].w), bfhi(hw.w) * bfhi(gt[q].w));
            *(v4u*)(YM + ((size_t)b * T + t0 + tt) * D + DH + 128 * bp + 8 * cc) = o; }
        __syncthreads();
    }
    STAMPX(F, 34);
}
__device__ __forceinline__ void fix(Frame& F, int b, int j, int bp) {
    LAS float* CAR = (LAS float*)(F.lds + RING_OFF);
    int t_ = threadIdx.x; asm volatile("" : "+v"(t_));
    const int tid = t_, t0 = 256 * j;
    const float2* TOT = (const float2*)(F.ws + WS_RGSUB); const float* CIN = (const float*)(F.ws + WS_CIN);
    const unsigned* L0 = (const unsigned*)F.out; const unsigned* L1 = L0 + (size_t)M * DH;
    const bf16* ZRG = (const bf16*)(F.ws + WS_ZRG); bf16* YM = (bf16*)(F.ws + WS_XN);
    constexpr int NB = FIX_BATCH;
    v4u lf[NB][2], lb[NB][2], gt[NB];
    auto issue = [&](int hb) {
#pragma unroll
        for (int q = 0; q < NB; ++q) { const int p = tid + 512 * (NB * hb + q), tt = p >> 4, cc = p & 15; const size_t m = (size_t)b * T + t0 + tt;
            const v4u* pf = (const v4u*)(L0 + m * DH + 128 * bp + 8 * cc); const v4u* pb = (const v4u*)(L1 + m * DH + 128 * bp + 8 * cc);
            lf[q][0] = pf[0]; lf[q][1] = pf[1]; lb[q][0] = pb[0]; lb[q][1] = pb[1]; gt[q] = *(const v4u*)(ZRG + m * DH + 128 * bp + 8 * cc); } };
    issue(0);
    if (tid < 256) { const int dir = tid >> 7, c = tid & 127, ch = 128 * bp + c;
        float2 tt[4];
#pragma unroll
        for (int g = 0; g < 4; ++g) tt[g] = TOT[(size_t)((b * 256 + 4 * j + g) * 2 + dir) * DH + ch];
        float cv = CIN[(size_t)((b * 64 + j) * 2 + dir) * DH + ch];
#pragma unroll
        for (int q = 0; q < 4; ++q) { const int g = dir ? 3 - q : q; CAR[(dir * 4 + g) * 128 + c] = cv; cv = tt[g].x * cv + tt[g].y; }
    }
    __syncthreads();
#pragma unroll
    for (int hb = 0; hb < 8 / NB; ++hb) {
        if (hb > 0) issue(hb);
#pragma unroll
        for (int q = 0; q < NB; ++q) { const int p = tid + 512 * (NB * hb + q), tt = p >> 4, cc = p & 15, g = tt >> 6; const size_t m = (size_t)b * T + t0 + tt;
            const f32x4 cf0 = *(const LAS f32x4*)(CAR + (0 * 4 + g) * 128 + 8 * cc), cf1 = *(const LAS f32x4*)(CAR + (0 * 4 + g) * 128 + 8 * cc + 4);
            const f32x4 cb0 = *(const LAS f32x4*)(CAR + (1 * 4 + g) * 128 + 8 * cc), cb1 = *(const LAS f32x4*)(CAR + (1 * 4 + g) * 128 + 8 * cc + 4);
            const unsigned uf[8] = {lf[q][0].x, lf[q][0].y, lf[q][0].z, lf[q][0].w, lf[q][1].x, lf[q][1].y, lf[q][1].z, lf[q][1].w};
            const unsigned ub[8] = {lb[q][0].x, lb[q][0].y, lb[q][0].z, lb[q][0].w, lb[q][1].x, lb[q][1].y, lb[q][1].z, lb[q][1].w};
            const float cf[8] = {cf0[0], cf0[1], cf0[2], cf0[3], cf1[0], cf1[1], cf1[2], cf1[3]}, cb[8] = {cb0[0], cb0[1], cb0[2], cb0[3], cb1[0], cb1[1], cb1[2], cb1[3]};
            const float gg[8] = {bflo(gt[q].x), bfhi(gt[q].x), bflo(gt[q].y), bfhi(gt[q].y), bflo(gt[q].z), bfhi(gt[q].z), bflo(gt[q].w), bfhi(gt[q].w)};
            float o[8];
#pragma unroll
            for (int k = 0; k < 8; ++k) o[k] = ((bflo(uf[k]) + bfhi(uf[k]) * cf[k]) + (bflo(ub[k]) + bfhi(ub[k]) * cb[k])) * gg[k];
            v4u w; w.x = pg8::cvt_pk_bf16(o[0], o[1]); w.y = pg8::cvt_pk_bf16(o[2], o[3]); w.z = pg8::cvt_pk_bf16(o[4], o[5]); w.w = pg8::cvt_pk_bf16(o[6], o[7]);
            *(v4u*)(YM + m * D + DH + 128 * bp + 8 * cc) = w; }
    }
    __syncthreads();
}
__device__ __forceinline__ void pass2(Frame& F) {
    const float2* TOT = (const float2*)(F.ws + WS_RGTOT); float* CIN = (float*)(F.ws + WS_CIN);
    const int gt = (F.G - 1 - F.bid) * (NWAVES * 64) + F.tid;
    if (gt < 4 * 2 * 2 * DH) {
        const int part = gt & 3, chn = gt >> 2, ch = chn & (DH - 1), dir = (chn >> 9) & 1, b = chn >> 10, lane = F.tid & 63;
        float2 tt[16];
#pragma unroll
        for (int q = 0; q < 16; ++q) { const int s = 16 * part + q, jj = dir ? 63 - s : s; tt[q] = TOT[(size_t)((b * 64 + jj) * 2 + dir) * DH + ch]; }
        float A = 1.f, H = 0.f;
#pragma unroll
        for (int q = 0; q < 16; ++q) { H = tt[q].x * H + tt[q].y; A *= tt[q].x; }
        float c = 0.f;
#pragma unroll
        for (int p = 0; p < 3; ++p) { const float Ap = __shfl(A, (lane & ~3) + p), Hp = __shfl(H, (lane & ~3) + p); if (p < part) c = Ap * c + Hp; }
        float h = c;
#pragma unroll
        for (int q = 0; q < 16; ++q) { const int s = 16 * part + q, jj = dir ? 63 - s : s; CIN[(size_t)((b * 64 + jj) * 2 + dir) * DH + ch] = h; h = tt[q].x * h + tt[q].y; }
    }
}
}
#ifndef REP_A
#define REP_A 1
#endif
#ifndef REP_N
#define REP_N 1
#endif
#ifndef REP_IN
#define REP_IN 1
#endif
#ifndef REP_UP
#define REP_UP 1
#endif
#ifndef S1_START
#define S1_START 0
#endif
#ifndef S1_LIMIT
#define S1_LIMIT (512 * REP_H0 + 512 * REP_R0)
#endif
#ifndef REP_S1
#define REP_S1 1
#endif
#ifndef REP_H0
#define REP_H0 1
#endif
#ifndef REP_R0
#define REP_R0 1
#endif
#ifndef REP_H3
#define REP_H3 1
#endif
#ifndef REP_R3
#define REP_R3 1
#endif
#ifndef REP_S2
#define REP_S2 1
#endif
#ifndef REP_S3
#define REP_S3 1
#endif
#ifndef REP_BAR
#define REP_BAR 0
#endif
struct Args { const float* in[31]; float* out; unsigned char* ws; };
__global__ void __launch_bounds__(NWAVES * 64, 2) hymba_fwd(Args args) {
    extern __shared__ __attribute__((aligned(16))) unsigned char lds[];
    Frame F;
    F.lds = (LAS unsigned char*)lds;
    F.MISC = (volatile LAS unsigned*)(F.lds + MISC_OFF);
    F.tid = threadIdx.x; F.lane = F.tid & 63; F.wave = __builtin_amdgcn_readfirstlane(F.tid >> 6);
    F.G = gridDim.x; F.bid = blockIdx.x;
    F.ka = (const __attribute__((address_space(4))) unsigned long long*)__builtin_amdgcn_kernarg_segment_ptr();
    F.out = args.out; F.ws = args.ws;
    F.ctl = (gu32*)(F.ws + WS_CTL);
    for (int u = F.tid; u < (LDS_BYTES - LDSCTL_OFF) / 4; u += NWAVES * 64) ((LAS unsigned*)(F.lds + LDSCTL_OFF))[u] = 0u;
    __syncthreads();
    int n_stamp = 0;
    XcdBarrier bar = xcd_barrier_post((unsigned*)(F.ctl + CW_BAR), F.MISC + 8);
#define REFRESH() do { int t_ = threadIdx.x; asm volatile("" : "+v"(t_)); F.tid = t_; F.lane = t_ & 63; } while (0)
#ifndef STAMP_SCALE
#define STAMP_SCALE 0.05f
#endif
#ifdef STAMP_A
#define STAMP() do { if (blockIdx.x == 0 && threadIdx.x == 0) { ((unsigned long long*)(F.ws + WS_CTL + 768 * 1024))[n_stamp] = __builtin_amdgcn_s_memrealtime(); } ++n_stamp; } while (0)
#else
#define STAMP() do { } while (0)
#endif
#if defined(STAMP_A) && defined(STAMP_PB)
#define PB_STAMP(id) do { if (STAMP_PB == (id) && threadIdx.x == 0) ((unsigned long long*)(F.ws + WS_CTL + 768 * 1024))[64 + blockIdx.x] = __builtin_amdgcn_s_memrealtime(); } while (0)
#else
#define PB_STAMP(id) do { } while (0)
#endif
#define GRID_BAR() do { PB_STAMP(n_stamp); xcd_barrier(bar); REFRESH(); STAMP(); } while (0)
    STAMP();
    unsigned char* ws = F.ws;
    const float* MOD = (const float*)(ws + WS_MOD);
    bf16* XN = (bf16*)(ws + WS_XN); bf16* HB = (bf16*)(ws + WS_HB); bf16* XB = (bf16*)(ws + WS_XB);

    for (int rep = 0; rep < REP_A; ++rep) { p0a(F); __syncthreads(); } GRID_BAR();
    for (int rep = 0; rep < REP_BAR; ++rep) GRID_BAR();
    for (int rep = 0; rep < REP_N; ++rep) p0b(F); GRID_BAR();
    { pg8::Gemm g{XB, (const bf16*)(ws + WS_W13A), M, 2 * FF, D, W13_COPY}; pg8::StaticOrder S; S.init(M, 2 * FF, F.G, F.bid);
      pg8::EpiSwiGLU E{HB, FF, (const float*)(ws + WS_SSQ1), (const float*)(ws + WS_BIAS1), 2 * FF, T};
      for (int rep = 0; rep < REP_UP; ++rep) pg8::gemm_phase<pg8::EpiSwiGLU, pg8::StaticOrder, true, true>(F.lds + RING_OFF, g, S, E); GRID_BAR(); }
    { pg8::Gemm g{HB, (const bf16*)(ws + WS_W2A), M, D, FF, 0}; pg8::StaticOrder S; S.init(M, D, F.G, F.bid);
      pg8::EpiResid<false, 1, false, false> E{XB, XB, MOD + 2 * D, nullptr, nullptr, (float*)(ws + WS_SSQ2)};
      pg8::gemm_phase<pg8::EpiResid<false, 1, false, false>, pg8::StaticOrder, true, true>(F.lds + RING_OFF, g, S, E); GRID_BAR(); }
    { pg8::Gemm g{XB, (const bf16*)(ws + WS_WIN), M, NIN, D, WIN_COPY}; pg8::StaticOrder S; S.init(M, NIN, F.G, F.bid);
      pg8::EpiInProj E{(bf16*)(ws + WS_ZQ), (bf16*)(ws + WS_ZV), (bf16*)(ws + WS_ZG), (bf16*)(ws + WS_ZRX), (bf16*)(ws + WS_ZRG), (bf16*)(ws + WS_ZLF), (bf16*)(ws + WS_ZLB), (const float*)(ws + WS_LBF), (const float*)(ws + WS_LBB),
                       (const float*)(ws + WS_SSQ2), (const float*)(ws + WS_BIAS2), NIN, T};
      for (int rep = 0; rep < REP_IN; ++rep) pg8::gemm_phase<pg8::EpiInProj, pg8::StaticOrder, true, true>(F.lds + RING_OFF, g, S, E); GRID_BAR(); }
    {
        gu32* ctr = F.ctl + CW_QUEUE;
        for (;;) {
            if (F.tid == 0) F.MISC[16] = __hip_atomic_fetch_add(ctr, 1u, __ATOMIC_RELAXED, __HIP_MEMORY_SCOPE_AGENT);
            __syncthreads(); const int it = (int)F.MISC[16] + S1_START; __syncthreads();
            if (it >= S1_LIMIT) break;
            if (it < 512 * REP_H0) { const int i2 = it & 511; hg::pass0_direct(F, i2 >> 8, (i2 >> 6) & 3, (i2 >> 1) & 31, i2 & 1); }
            else { const int r = (it - 512 * REP_H0) & 511; rg::item<0>(F, r >> 8, (r >> 2) & 63, r & 3); }
        }
    }
    GRID_BAR();
    for (int rep = 0; rep < REP_S2; ++rep) { hg::pass2(F); rg::pass2(F); }
    GRID_BAR();
    {
        const int cls = (F.bid >> 3) & 7, idx = ((F.bid >> 6) << 3) | (F.bid & 7);
        { const int first = 2 * (cls * 32 + idx), n = cls < 2 ? 2 : 0;
#pragma unroll 1
          for (int q2 = 0; q2 < n; ++q2) { const int it = first + q2; rg::fix(F, it >> 8, (it >> 2) & 63, it & 3); } }
        for (int it = F.bid; it < 8 * hg::NSC; it += F.G) { const int b = it >> 7, h = (it >> 5) & 3, j = it & 31;
            hg::pass_pipe<1>(F, b, h, j, 1);
            { const int first = 128 + 2 * ((cls - 2) * 32 + idx), n = (cls >= 2 && cls < 5) ? 2 : 0;
#pragma unroll 1
              for (int q2 = 0; q2 < n; ++q2) { const int it2 = first + q2; rg::fix(F, it2 >> 8, (it2 >> 2) & 63, it2 & 3); } }
            hg::pass_pipe<2>(F, b, h, j, 0); }
        gu32* ctr = F.ctl + CW_QUEUE + 64;
        for (;;) {
            if (F.tid == 0) F.MISC[16] = __hip_atomic_fetch_add(ctr, 1u, __ATOMIC_RELAXED, __HIP_MEMORY_SCOPE_AGENT);
            __syncthreads(); const int it = 320 + (int)F.MISC[16]; __syncthreads();
            if (it >= 512) break;
            rg::fix(F, it >> 8, (it >> 2) & 63, it & 3);
        }
    }
    GRID_BAR();
    { pg8::Gemm g{XN, (const bf16*)(ws + WS_WOUT), M, D, D, 0}; pg8::StaticOrder S; S.init(M, D, F.G, F.bid);
      pg8::EpiResid<false, 2, false, false> E{XB, XB, MOD + 5 * D, nullptr, nullptr, (float*)(ws + WS_SSQ3)};
      pg8::gemm_phase<pg8::EpiResid<false, 2, false, false>, pg8::StaticOrder, true, true>(F.lds + RING_OFF, g, S, E); GRID_BAR(); }
    { pg8::Gemm g{XB, (const bf16*)(ws + WS_W13B), M, 2 * FF, D, W13_COPY}; pg8::StaticOrder S; S.init(M, 2 * FF, F.G, F.bid);
      pg8::EpiSwiGLU E{HB, FF, (const float*)(ws + WS_SSQ3), (const float*)(ws + WS_BIAS3), 2 * FF, T};
      pg8::gemm_phase<pg8::EpiSwiGLU, pg8::StaticOrder, true, true>(F.lds + RING_OFF, g, S, E); GRID_BAR(); }
    { pg8::Gemm g{HB, (const bf16*)(ws + WS_W2B), M, D, FF, 0}; pg8::StaticOrder S; S.init(M, D, F.G, F.bid);
      pg8::EpiFinal E{XB, F.out, MOD + 8 * D, FIN(30), (float*)(ws + WS_SSQ4), (unsigned*)(ws + WS_CTL) + CW_FIN};
      pg8::gemm_phase<pg8::EpiFinal, pg8::StaticOrder, true, true>(F.lds + RING_OFF, g, S, E); }
#ifdef STAMP_A
    GRID_BAR();
    if (blockIdx.x == 0 && threadIdx.x == 0) { asm volatile("s_waitcnt vmcnt(0)" ::: "memory"); const unsigned long long* tsp = (const unsigned long long*)(F.ws + WS_CTL + 768 * 1024);
#if STAMP_B == 999
        long long mx = 0; for (int q = 0; q < 256; ++q) { const long long d = (long long)(tsp[64 + q] - tsp[STAMP_A]); mx = d > mx ? d : mx; } F.out[0] = 0.0005f * (float)mx; }
#elif STAMP_B == 970
        F.out[0] = 0.01f * STAMP_SCALE * (float)(long long)((tsp[4] - tsp[3]) + (tsp[9] - tsp[8]) + (tsp[11] - tsp[10])); }
#elif STAMP_B == 996
        unsigned long long mx = 0; for (int q = 0; q < 256; ++q) { mx = tsp[64 + q] > mx ? tsp[64 + q] : mx; } F.out[0] = 0.0005f * (float)(long long)(tsp[6] - mx); }
#elif STAMP_B == 995
        int msk = 0; const long long d0 = (long long)(tsp[64] - tsp[STAMP_A]); for (int q = 0; q < 256; ++q) { const long long d = (long long)(tsp[64 + q] - tsp[STAMP_A]); if (5 * d > 6 * d0) msk |= 1 << (q & 7); } F.out[0] = 0.05f * (float)msk; }
#elif STAMP_B == 994
        long long mn = 1ll << 40; for (int q = 0; q < 256; ++q) { const long long d = (long long)(tsp[64 + q] - tsp[STAMP_A]); mn = d < mn ? d : mn; } F.out[0] = 0.0005f * (float)mn; }
#elif STAMP_B == 993
        long long mx = 0; for (int q = 0; q < 256; ++q) { if ((q & 7) == 6) continue; const long long d = (long long)(tsp[64 + q] - tsp[STAMP_A]); mx = d > mx ? d : mx; } F.out[0] = 0.0005f * (float)mx; }
#elif STAMP_B >= 980 && STAMP_B < 988
        long long mx = 0; for (int q = 0; q < 256; ++q) { if ((q & 7) != STAMP_B - 980) continue; const long long d = (long long)(tsp[64 + q] - tsp[STAMP_A]); mx = d > mx ? d : mx; } F.out[0] = 0.01f * STAMP_SCALE * (float)mx; }
#elif STAMP_B == 998
        long long mx = 0; int am = 0; for (int q = 0; q < 256; ++q) { const long long d = (long long)(tsp[64 + q] - tsp[STAMP_A]); if (d > mx) { mx = d; am = q; } } F.out[0] = 0.1f * (float)am; }
#elif STAMP_B == 997
        int cnt = 0; const long long d0 = (long long)(tsp[64] - tsp[STAMP_A]); for (int q = 0; q < 256; ++q) { const long long d = (long long)(tsp[64 + q] - tsp[STAMP_A]); if (5 * d > 6 * d0) ++cnt; } F.out[0] = 0.1f * (float)cnt; }
#else
        F.out[0] = 0.01f * STAMP_SCALE * (float)(long long)(tsp[STAMP_B] - tsp[STAMP_A]); }
#endif
#endif
}

extern "C" void kernel_launch(void* const* d_in, const int* in_sizes, int n_in, void* d_out, int out_size, void* d_ws, size_t ws_size, hipStream_t stream) {
    static int grid = 0;
    if (grid == 0) {
        if (n_in != 31 || in_sizes[0] != M * D || out_size != M * D || ws_size < WS_END) { fprintf(stderr, "kernel_launch: unexpected shapes (n_in %d, in0 %d, out %d, ws %zu)\n", n_in, n_in > 0 ? in_sizes[0] : -1, out_size, ws_size); grid = -1; return; }
        int dev = 0, cus = 0;
        if (hipGetDevice(&dev) != hipSuccess || hipDeviceGetAttribute(&cus, hipDeviceAttributeMultiprocessorCount, dev) != hipSuccess) { grid = -1; return; }
        if (hipFuncSetAttribute((const void*)hymba_fwd, hipFuncAttributeMaxDynamicSharedMemorySize, LDS_BYTES) != hipSuccess) { fprintf(stderr, "kernel_launch: hipFuncSetAttribute failed\n"); grid = -1; return; }
        (void)hipGetLastError();
        grid = cus;
    }
    if (grid < 0) return;
    if (hipMemsetAsync((char*)d_ws + WS_CTL, 0, CTL_ZERO_BYTES, stream) != hipSuccess) return;
    Args a{};
    for (int i = 0; i < 31; ++i) a.in[i] = (const float*)d_in[i];
    a.out = (float*)d_out; a.ws = (unsigned char*)d_ws;
    hipLaunchKernelGGL(hymba_fwd, dim3(grid), dim3(NWAVES * 64), LDS_BYTES, stream, a);
}
```

```cpp
#include <hip/hip_runtime.h>
#include <cstdio>
#include <cstdint>
namespace pg8 {
#define PG8_LAS __attribute__((address_space(3)))
typedef unsigned short bf16_t;
typedef short bf16x8 __attribute__((ext_vector_type(8)));
typedef float f32x4 __attribute__((ext_vector_type(4)));
typedef unsigned u32x4 __attribute__((ext_vector_type(4)));
constexpr int BM = 256, BK = 64, HALF = 128, HTB = HALF * BK * 2  , STAGE_BYTES = 8 * HTB, NXCD = 8, WGM = 8;

__host__ __device__ __forceinline__ int lds_byte(int r, int c) { const int st = (r >> 4) * 2 + (c >> 5), rr = r & 15, cc = c & 31, ob = rr * 64 + cc * 2; return st * 1024 + (ob ^ (((ob >> 9) & 1) << 5)); }
__host__ __device__ __forceinline__ void stage_rc(int b, int& R, int& C) { const int st = b / 1024, sb = b % 1024, swz = sb ^ (((sb >> 9) & 1) << 5); R = (st >> 1) * 16 + swz / 64; C = (st & 1) * 32 + (swz % 64) / 2; }
__host__ __device__ __forceinline__ int perm32(int rho) { const int n = rho >> 4, i = rho & 15; return 8 * (i >> 2) + 4 * n + (i & 3); }

struct Unit { int pm, pn; };
struct Gemm { const bf16_t* A; const bf16_t* Bt; int M, N, K; size_t bt_batch_bytes; };

struct StaticOrder {
    int nM, nN, nwg, G, c;
    __host__ __device__ void init(int M, int N, int G_, int c_) { nM = M / BM; nN = N / BM; nwg = nM * nN; G = G_; c = c_; }
    __host__ __device__ bool next(int i, Unit& u) const {
        const long L = (long)i * G + c; if (L >= nwg) return false;
        int wgid = (int)L; { const int q = nwg / NXCD, r = nwg % NXCD, xcd = wgid % NXCD, off = wgid / NXCD; wgid = (xcd < r ? xcd * (q + 1) : r * (q + 1) + (xcd - r) * q) + off; }
        const int nig = WGM * nN, gid = wgid / nig, fm = gid * WGM, gsz = (nM - fm) < WGM ? (nM - fm) : WGM;
        u.pm = fm + ((wgid % nig) % gsz); u.pn = (wgid % nig) / gsz; return true;
    }
    __device__ __forceinline__ void a_ready(const Unit&) const {}
    __device__ __forceinline__ void done(const Unit&) const {}
};
typedef __bf16 bf16v2_t __attribute__((ext_vector_type(2)));
__device__ __forceinline__ unsigned cvt_pk_bf16(float lo, float hi) { bf16v2_t v; v.x = (__bf16)lo; v.y = (__bf16)hi; return __builtin_bit_cast(unsigned, v); }
typedef float f32x2 __attribute__((ext_vector_type(2)));
__device__ __forceinline__ float sigmoid_f(float x) { return __builtin_amdgcn_rcpf(1.0f + __builtin_amdgcn_exp2f(-1.44269504f * x)); }
__device__ __forceinline__ float silu_f(float x) { return x * sigmoid_f(x); }
__device__ __forceinline__ float gelu_tanh_f(float x) { return x * sigmoid_f(1.5957691216f * (x + 0.044715f * x * x * x)); }

struct EpiSwiGLU {
    static constexpr bool PERM = true, AFTER_DRAIN = false, PRE = true;
    bf16_t* O; int ldc; const float* ssq; const float* bias; int bstride; int rows_per_batch;
    __device__ __forceinline__ float pre_load(const Unit& u, int tid) const { const float* p = tid < 256 ? ssq + u.pm * BM + tid : bias + (size_t)((u.pm * BM) / rows_per_batch) * bstride + u.pn * BM + tid - 256;
        float v; asm volatile("global_load_dword %0, %1, off" : "=v"(v) : "v"(p) : "memory"); return v; }
    __device__ __forceinline__ void pre_store(PG8_LAS float* p, float v, int tid) const { p[tid] = tid < 256 ? __builtin_amdgcn_rsqf(v * (1.0f / 1024.0f) + 1e-6f) : v; }
    __device__ __forceinline__ void operator()(const f32x4 (&acc)[2][2][4][2], const Unit& u, int wr, int wc, int fr, int fq, const PG8_LAS float* pre) const {
        const int row0 = u.pm * BM + wr * 64 + fr, col0 = u.pn * 128 + wc * 32 + 8 * fq;
        const PG8_LAS float* bp = pre + 256 + wc * 32 + 8 * fq;
        const f32x4 bg0 = *(const PG8_LAS f32x4*)bp, bg1 = *(const PG8_LAS f32x4*)(bp + 4), bu0 = *(const PG8_LAS f32x4*)(bp + HALF), bu1 = *(const PG8_LAS f32x4*)(bp + HALF + 4);
#pragma unroll
        for (int ai = 0; ai < 2; ++ai)
#pragma unroll
            for (int m = 0; m < 4; ++m) { bf16_t* rowp = O + (size_t)(row0 + ai * HALF + m * 16) * ldc + col0;
                const float rs = pre[wr * 64 + fr + ai * HALF + m * 16];
                const f32x4 g0 = acc[ai][0][m][0] * rs + bg0, g1 = acc[ai][0][m][1] * rs + bg1, u0 = acc[ai][1][m][0] * rs + bu0, u1 = acc[ai][1][m][1] * rs + bu1;
                f32x4 v0, v1;
#pragma unroll
                for (int j = 0; j < 4; ++j) { v0[j] = silu_f(g0[j]) * u0[j]; v1[j] = silu_f(g1[j]) * u1[j]; }
                u32x4 w; w.x = cvt_pk_bf16(v0[0], v0[1]); w.y = cvt_pk_bf16(v0[2], v0[3]); w.z = cvt_pk_bf16(v1[0], v1[1]); w.w = cvt_pk_bf16(v1[2], v1[3]);
                *(u32x4*)rowp = w; }
    }
};
template <bool HAS_XG, int SCALE2  , bool BASE_F32, bool OUT_F32> struct EpiResid {
    static constexpr bool PERM = true, AFTER_DRAIN = false, PRE = false;
    const void* base; void* out; const float* gate; bf16_t* xg; const float* gvn; float* ssq;
    static constexpr int gstride = 9216, rows_per_batch = 16384; static constexpr float scale = 0.5f * SCALE2;
    __device__ __forceinline__ void operator()(const f32x4 (&acc)[2][2][4][2], const Unit& u, int wr, int wc, int fr, int fq, const PG8_LAS float*) const {
        const int row0 = u.pm * BM + wr * 64 + fr, col0 = u.pn * BM + wc * 32 + 8 * fq, bidx = (u.pm * BM) / rows_per_batch;
        const float* gp = gate + (size_t)bidx * gstride + col0;
        f32x4 gv[2][2], gn[2][2];
#pragma unroll
        for (int bj = 0; bj < 2; ++bj)
#pragma unroll
            for (int n = 0; n < 2; ++n) { gv[bj][n] = *(const f32x4*)(gp + bj * HALF + n * 4) * scale; gn[bj][n] = HAS_XG ? *(const f32x4*)(gvn + (size_t)bidx * 1024 + col0 + bj * HALF + n * 4) : (f32x4){0.f, 0.f, 0.f, 0.f}; }
#pragma unroll
        for (int ai = 0; ai < 2; ++ai)
#pragma unroll
            for (int mp = 0; mp < 2; ++mp) {
            f32x4 bs[2][2][2];
#pragma unroll
            for (int mm = 0; mm < 2; ++mm)
#pragma unroll
                for (int bj = 0; bj < 2; ++bj) { const size_t off = (size_t)(row0 + ai * HALF + (2 * mp + mm) * 16) * 1024 + col0 + bj * HALF;
                    if (BASE_F32) { bs[mm][bj][0] = *(const f32x4*)((const float*)base + off); bs[mm][bj][1] = *(const f32x4*)((const float*)base + off + 4); }
                    else { const u32x4 w = *(const u32x4*)((const bf16_t*)base + off);
                        bs[mm][bj][0] = (f32x4){__builtin_bit_cast(float, w.x << 16), __builtin_bit_cast(float, w.x & 0xffff0000u), __builtin_bit_cast(float, w.y << 16), __builtin_bit_cast(float, w.y & 0xffff0000u)};
                        bs[mm][bj][1] = (f32x4){__builtin_bit_cast(float, w.z << 16), __builtin_bit_cast(float, w.z & 0xffff0000u), __builtin_bit_cast(float, w.w << 16), __builtin_bit_cast(float, w.w & 0xffff0000u)}; } }
#pragma unroll
            for (int mm = 0; mm < 2; ++mm) { const int m = 2 * mp + mm; float sq = 0.f;
#pragma unroll
                for (int bj = 0; bj < 2; ++bj) { const size_t off = (size_t)(row0 + ai * HALF + m * 16) * 1024 + col0 + bj * HALF;
                    const f32x4 o0 = bs[mm][bj][0] + gv[bj][0] * acc[ai][bj][m][0], o1 = bs[mm][bj][1] + gv[bj][1] * acc[ai][bj][m][1];
                    if (OUT_F32) { *(f32x4*)((float*)out + off) = o0; *(f32x4*)((float*)out + off + 4) = o1; }
                    else { u32x4 w; w.x = cvt_pk_bf16(o0[0], o0[1]); w.y = cvt_pk_bf16(o0[2], o0[3]); w.z = cvt_pk_bf16(o1[0], o1[1]); w.w = cvt_pk_bf16(o1[2], o1[3]); *(u32x4*)((bf16_t*)out + off) = w; }
                    sq += ((o0[0] * o0[0] + o0[1] * o0[1]) + (o0[2] * o0[2] + o0[3] * o0[3])) + ((o1[0] * o1[0] + o1[1] * o1[1]) + (o1[2] * o1[2] + o1[3] * o1[3]));
                    if (HAS_XG) { const f32x4 q0 = o0 * gn[bj][0], q1 = o1 * gn[bj][1]; u32x4 w; w.x = cvt_pk_bf16(q0[0], q0[1]); w.y = cvt_pk_bf16(q0[2], q0[3]); w.z = cvt_pk_bf16(q1[0], q1[1]); w.w = cvt_pk_bf16(q1[2], q1[3]); *(u32x4*)(xg + off) = w; } }
                sq += __shfl_xor(sq, 16); sq += __shfl_xor(sq, 32);
                if (fq == 0) atomicAdd(ssq + row0 + ai * HALF + m * 16, sq); }
            asm volatile("" ::: "memory"); }
    }
};
typedef __attribute__((address_space(1))) unsigned epi_gu32;
typedef __attribute__((address_space(1))) float epi_gf32;
struct EpiFinal {
    static constexpr bool PERM = true, AFTER_DRAIN = false, PRE = false;
    const bf16_t* base; float* out; const float* gate; const float* gain; float* ssq; unsigned* cnt;
    static constexpr int gstride = 9216, rows_per_batch = 16384;
    __device__ __forceinline__ void operator()(const f32x4 (&acc)[2][2][4][2], const Unit& u, int wr, int wc, int fr, int fq, const PG8_LAS float*) const {
        const int row0 = u.pm * BM + wr * 64 + fr, col0 = u.pn * BM + wc * 32 + 8 * fq, bidx = (u.pm * BM) / rows_per_batch;
        const float* gp = gate + (size_t)bidx * gstride + col0;
        f32x4 gv[2][2];
#pragma unroll
        for (int bj = 0; bj < 2; ++bj)
#pragma unroll
            for (int n = 0; n < 2; ++n) gv[bj][n] = *(const f32x4*)(gp + bj * HALF + n * 4) * 0.5f;
        f32x4 o[2][2][4][2]; float sq[2][4];
#pragma unroll
        for (int ai = 0; ai < 2; ++ai)
#pragma unroll
            for (int mp = 0; mp < 2; ++mp) {
            u32x4 bw[2][2];
#pragma unroll
            for (int mm = 0; mm < 2; ++mm)
#pragma unroll
                for (int bj = 0; bj < 2; ++bj) bw[mm][bj] = *(const u32x4*)(base + (size_t)(row0 + ai * HALF + (2 * mp + mm) * 16) * 1024 + col0 + bj * HALF);
#pragma unroll
            for (int mm = 0; mm < 2; ++mm) { const int m = 2 * mp + mm; float sqv = 0.f;
#pragma unroll
                for (int bj = 0; bj < 2; ++bj) { const u32x4 w = bw[mm][bj];
                    const f32x4 b0 = (f32x4){__builtin_bit_cast(float, w.x << 16), __builtin_bit_cast(float, w.x & 0xffff0000u), __builtin_bit_cast(float, w.y << 16), __builtin_bit_cast(float, w.y & 0xffff0000u)};
                    const f32x4 b1 = (f32x4){__builtin_bit_cast(float, w.z << 16), __builtin_bit_cast(float, w.z & 0xffff0000u), __builtin_bit_cast(float, w.w << 16), __builtin_bit_cast(float, w.w & 0xffff0000u)};
                    const f32x4 o0 = b0 + gv[bj][0] * acc[ai][bj][m][0], o1 = b1 + gv[bj][1] * acc[ai][bj][m][1];
                    o[ai][bj][m][0] = o0; o[ai][bj][m][1] = o1;
                    sqv += ((o0[0] * o0[0] + o0[1] * o0[1]) + (o0[2] * o0[2] + o0[3] * o0[3])) + ((o1[0] * o1[0] + o1[1] * o1[1]) + (o1[2] * o1[2] + o1[3] * o1[3])); }
                sq[ai][m] = sqv; }
            asm volatile("" ::: "memory"); }
#pragma unroll
        for (int ai = 0; ai < 2; ++ai)
#pragma unroll
            for (int m = 0; m < 4; ++m) sq[ai][m] += __shfl_xor(sq[ai][m], 16);
#pragma unroll
        for (int ai = 0; ai < 2; ++ai)
#pragma unroll
            for (int m = 0; m < 4; ++m) sq[ai][m] += __shfl_xor(sq[ai][m], 32);
        if (fq == 0) {
#pragma unroll
            for (int ai = 0; ai < 2; ++ai)
#pragma unroll
                for (int m = 0; m < 4; ++m) atomicAdd(ssq + row0 + ai * HALF + m * 16, sq[ai][m]); }
        asm volatile("s_waitcnt vmcnt(0)" ::: "memory");
        epi_gu32* c = (epi_gu32*)(cnt + u.pm * 16);
        if (fr == 0 && fq == 0) __hip_atomic_fetch_add(c, 1u, __ATOMIC_RELAXED, __HIP_MEMORY_SCOPE_AGENT);
        f32x4 gn[2][2];
#pragma unroll
        for (int bj = 0; bj < 2; ++bj)
#pragma unroll
            for (int n = 0; n < 2; ++n) gn[bj][n] = *(const f32x4*)(gain + col0 + bj * HALF + n * 4);
        for (unsigned spins = 0; (unsigned)__builtin_amdgcn_readfirstlane((int)__hip_atomic_load(c, __ATOMIC_RELAXED, __HIP_MEMORY_SCOPE_AGENT)) < 32u; ) { __builtin_amdgcn_s_sleep(1); if (++spins > (1u << 20)) break; }
        float rs[2][4];
#pragma unroll
        for (int ai = 0; ai < 2; ++ai)
#pragma unroll
            for (int m = 0; m < 4; ++m) rs[ai][m] = __hip_atomic_load((epi_gf32*)(ssq + row0 + ai * HALF + m * 16), __ATOMIC_RELAXED, __HIP_MEMORY_SCOPE_AGENT);
#pragma unroll
        for (int ai = 0; ai < 2; ++ai)
#pragma unroll
            for (int m = 0; m < 4; ++m) { const float r = __builtin_amdgcn_rsqf(rs[ai][m] * (1.0f / 1024.0f) + 1e-6f);
#pragma unroll
                for (int bj = 0; bj < 2; ++bj) { float* p = out + (size_t)(row0 + ai * HALF + m * 16) * 1024 + col0 + bj * HALF;
                    *(f32x4*)p = o[ai][bj][m][0] * r * gn[bj][0]; *(f32x4*)(p + 4) = o[ai][bj][m][1] * r * gn[bj][1]; } }
    }
};
struct EpiInProj {
    static constexpr bool PERM = true, AFTER_DRAIN = false, PRE = true;
    bf16_t *ZQ, *ZV, *ZG, *ZRX, *ZRG, *ZLF, *ZLB; const float *LBF, *LBB; const float* ssq; const float* bias; int bstride; int rows_per_batch;
    __device__ __forceinline__ float pre_load(const Unit& u, int tid) const { const float* p = tid < 256 ? ssq + u.pm * BM + tid : bias + (size_t)((u.pm * BM) / rows_per_batch) * bstride + u.pn * BM + tid - 256;
        float v; asm volatile("global_load_dword %0, %1, off" : "=v"(v) : "v"(p) : "memory"); return v; }
    __device__ __forceinline__ void pre_store(PG8_LAS float* p, float v, int tid) const { p[tid] = tid < 256 ? __builtin_amdgcn_rsqf(v * (1.0f / 1024.0f) + 1e-6f) : v; }
    __device__ __forceinline__ void operator()(const f32x4 (&acc)[2][2][4][2], const Unit& u, int wr, int wc, int fr, int fq, const PG8_LAS float* pre) const {
        const int row0 = u.pm * BM + wr * 64 + fr, seg = u.pn >> 1, cs0 = (u.pn & 1) * 256 + wc * 32 + 8 * fq;
        const PG8_LAS float* bp = pre + 256 + wc * 32 + 8 * fq;
        f32x4 bb[2][2];
#pragma unroll
        for (int bj = 0; bj < 2; ++bj) { bb[bj][0] = *(const PG8_LAS f32x4*)(bp + bj * HALF); bb[bj][1] = *(const PG8_LAS f32x4*)(bp + bj * HALF + 4); }
        float rs[2][4];
#pragma unroll
        for (int ai = 0; ai < 2; ++ai)
#pragma unroll
            for (int m = 0; m < 4; ++m) rs[ai][m] = pre[wr * 64 + fr + ai * HALF + m * 16];
        if (seg == 1 || seg == 2) {
            bf16_t* Z = seg == 1 ? ZLF : ZLB; const float* LB = seg == 1 ? LBF : LBB;
#pragma unroll
            for (int bj = 0; bj < 2; ++bj) { const f32x4 l0 = *(const f32x4*)(LB + cs0 + bj * HALF), l1 = *(const f32x4*)(LB + cs0 + bj * HALF + 4);
#pragma unroll
                for (int ai = 0; ai < 2; ++ai)
#pragma unroll
                    for (int m = 0; m < 4; ++m) { bf16_t* rowp = Z + (size_t)(row0 + ai * HALF + m * 16) * 512 + cs0 + bj * HALF;
                        const f32x4 a0 = acc[ai][bj][m][0] * rs[ai][m] + bb[bj][0], a1 = acc[ai][bj][m][1] * rs[ai][m] + bb[bj][1]; f32x4 v0, v1;
#pragma unroll
                        for (int j = 0; j < 4; ++j) { v0[j] = __builtin_amdgcn_logf(l0[j] + (1.0f - l0[j]) * sigmoid_f(a0[j])); v1[j] = __builtin_amdgcn_logf(l1[j] + (1.0f - l1[j]) * sigmoid_f(a1[j])); }
                        u32x4 w; w.x = cvt_pk_bf16(v0[0], v0[1]); w.y = cvt_pk_bf16(v0[2], v0[3]); w.z = cvt_pk_bf16(v1[0], v1[1]); w.w = cvt_pk_bf16(v1[2], v1[3]); *(u32x4*)rowp = w; } }
        } else {
            bf16_t* Z = seg == 0 ? ZQ : seg == 3 ? ZV : seg == 4 ? ZG : seg == 5 ? ZRX : ZRG;
            const int act = (seg == 0 || seg == 4) ? 1 : (seg == 6 ? 2 : 0);
#pragma unroll
            for (int ai = 0; ai < 2; ++ai)
#pragma unroll
                for (int m = 0; m < 4; ++m) { bf16_t* rowp = Z + (size_t)(row0 + ai * HALF + m * 16) * 512 + cs0;
#pragma unroll
                    for (int bj = 0; bj < 2; ++bj) { f32x4 v0 = acc[ai][bj][m][0] * rs[ai][m] + bb[bj][0], v1 = acc[ai][bj][m][1] * rs[ai][m] + bb[bj][1];
                        if (act == 1) {
#pragma unroll
                            for (int j = 0; j < 4; ++j) { v0[j] = silu_f(v0[j]); v1[j] = silu_f(v1[j]); } }
                        else if (act == 2) {
#pragma unroll
                            for (int j = 0; j < 4; ++j) { v0[j] = gelu_tanh_f(v0[j]); v1[j] = gelu_tanh_f(v1[j]); } }
                        u32x4 w; w.x = cvt_pk_bf16(v0[0], v0[1]); w.y = cvt_pk_bf16(v0[2], v0[3]); w.z = cvt_pk_bf16(v1[0], v1[1]); w.w = cvt_pk_bf16(v1[2], v1[3]);
                        *(u32x4*)(rowp + bj * HALF) = w; } }
        }
    }
};
#ifdef GSTAMP_K
#define GSTAMP(k) do { if (g.K == GSTAMP_K && blockIdx.x == 0 && threadIdx.x == 0) ((unsigned long long*)((char*)g.A - GSTAMP_AOFF + 768 * 1024))[k] = __builtin_amdgcn_s_memrealtime(); } while (0)
#else
#define GSTAMP(k) do { } while (0)
#endif
template <class Epi, class Sched, bool ALIGN_EPI = false, bool SP2 = false>
__device__ __forceinline__ void gemm_phase(PG8_LAS unsigned char* lds, const Gemm g, const Sched& S, const Epi& E) {
    const int tid = threadIdx.x, wid = __builtin_amdgcn_readfirstlane(tid >> 6), lane = tid & 63, wr = wid >> 2, wc = wid & 3, fr = lane & 15, fq = lane >> 4;
    const int K = g.K, nt = K / BK;
    unsigned voffA[2], voffB[2];
#pragma unroll
    for (int i = 0; i < 2; ++i) { int R, C; stage_rc(tid * 16 + i * 8192, R, C); const int Rb = Epi::PERM ? ((R & ~31) + perm32(R & 31)) : R;
        voffA[i] = (unsigned)(R * K + C) * 2u; voffB[i] = (unsigned)(Rb * K + C) * 2u; }
    asm volatile("" : "+v"(voffA[0]), "+v"(voffA[1]), "+v"(voffB[0]), "+v"(voffB[1]));
    const size_t kstep = (size_t)(BK * 2);
    const size_t hstep = (size_t)HALF * K * 2;
    const size_t tstep = 2 * hstep;
    const unsigned ldsw = (unsigned)wid * 1024u;
    const int aoff = lds_byte(wr * 64 + fr, fq * 8), boff = lds_byte(wc * 32 + fr, fq * 8);
#define PG8_SA(b, h) (((b) * 2 + (h)) * HTB)
#define PG8_SB(b, h) ((4 + (b) * 2 + (h)) * HTB)
#define PG8_STAGE(bufoff, gbase, voff) do { _Pragma("unroll") for (int _i = 0; _i < 2; ++_i) \
        __builtin_amdgcn_global_load_lds((const unsigned*)((const char*)(gbase) + (voff)[_i]), (PG8_LAS unsigned*)(lds + (bufoff) + ldsw + _i * 8192), 16, 0, 0); } while (0)
#define PG8_LDA(dst, b, h) do { _Pragma("unroll") for (int m = 0; m < 4; ++m) _Pragma("unroll") for (int k = 0; k < 2; ++k) dst[m][k] = *(const PG8_LAS bf16x8*)(lds + PG8_SA(b, h) + aoff + m * 2048 + k * 1024); } while (0)
#define PG8_LDB(dst, b, h) do { _Pragma("unroll") for (int n = 0; n < 2; ++n) _Pragma("unroll") for (int k = 0; k < 2; ++k) dst[n][k] = *(const PG8_LAS bf16x8*)(lds + PG8_SB(b, h) + boff + n * 2048 + k * 1024); } while (0)
#define PG8_MMA(ai, bj, At, Bt) do { __builtin_amdgcn_s_setprio(1); _Pragma("unroll") for (int m = 0; m < 4; ++m) _Pragma("unroll") for (int n = 0; n < 2; ++n) _Pragma("unroll") for (int k = 0; k < 2; ++k) \
        acc[ai][bj][m][n] = __builtin_amdgcn_mfma_f32_16x16x32_bf16(Bt[n][k], At[m][k], acc[ai][bj][m][n], 0, 0, 0); __builtin_amdgcn_s_setprio(0); } while (0)
#define PG8_WAIT_V(n) asm volatile("s_waitcnt vmcnt(" #n ")" ::: "memory")
#define PG8_WAIT_L(n) asm volatile("s_waitcnt lgkmcnt(" #n ")" ::: "memory")
#define PG8_BAR __builtin_amdgcn_s_barrier()
#define PG8_SCHED __builtin_amdgcn_sched_barrier(0)
    Unit cur, nxt; int ui = 0; float pre_v = 0.f;
    if (!S.next(0, cur)) return;
    f32x4 acc[2][2][4][2];
#pragma unroll
    for (int a = 0; a < 2; ++a)
#pragma unroll
        for (int b = 0; b < 2; ++b)
#pragma unroll
            for (int m = 0; m < 4; ++m)
#pragma unroll
                for (int n = 0; n < 2; ++n) acc[a][b][m][n] = (f32x4){0.f, 0.f, 0.f, 0.f};
    bf16x8 At[4][2], B0[2][2], B1[2][2];
    const char* cA = (const char*)g.A + (size_t)cur.pm * tstep; const char* cB = (const char*)g.Bt + (size_t)cur.pn * tstep + (cur.pm >= 64 ? g.bt_batch_bytes : 0);
    S.a_ready(cur);
    if constexpr (SP2) {
        PG8_STAGE(PG8_SB(0, 0), cB, voffB); PG8_STAGE(PG8_SB(0, 1), cB + hstep, voffB); PG8_STAGE(PG8_SA(0, 0), cA, voffA); PG8_STAGE(PG8_SA(0, 1), cA + hstep, voffA);
        if (wr == 1) PG8_BAR;
        PG8_WAIT_V(2); PG8_BAR;
        PG8_STAGE(PG8_SB(1, 0), cB + kstep, voffB); PG8_STAGE(PG8_SA(1, 0), cA + kstep, voffA); PG8_STAGE(PG8_SB(1, 1), cB + hstep + kstep, voffB);
        PG8_WAIT_V(6); PG8_BAR;
    } else {
        PG8_STAGE(PG8_SB(0, 0), cB, voffB); PG8_STAGE(PG8_SA(0, 0), cA, voffA); PG8_STAGE(PG8_SB(0, 1), cB + hstep, voffB); PG8_STAGE(PG8_SA(0, 1), cA + hstep, voffA);
        if (wr == 1) PG8_BAR;
        PG8_WAIT_V(4); PG8_BAR;
        PG8_STAGE(PG8_SB(1, 0), cB + kstep, voffB); PG8_STAGE(PG8_SA(1, 0), cA + kstep, voffA); PG8_STAGE(PG8_SB(1, 1), cB + hstep + kstep, voffB);
        PG8_WAIT_V(6); PG8_BAR;
    }
    for (;;) {
        GSTAMP(22);
        const bool has_next = S.next(ui + 1, nxt);
        const char* nA = has_next ? (const char*)g.A + (size_t)nxt.pm * tstep : cA; const char* nB = has_next ? (const char*)g.Bt + (size_t)nxt.pn * tstep + (nxt.pm >= 64 ? g.bt_batch_bytes : 0) : cB;
        for (int t = 0; t < nt; t += 2) {
            const bool last = (t == nt - 2);
            const char* a1 = cA + (size_t)(t + 1) * kstep;
            const char* a2 = last ? nA : cA + (size_t)(t + 2) * kstep; const char* b2 = last ? nB : cB + (size_t)(t + 2) * kstep;
            const char* a3 = a2 + kstep; const char* b3 = b2 + kstep;
            if (last) { if constexpr (Epi::PRE) pre_v = E.pre_load(cur, tid); if (has_next) S.a_ready(nxt); }
            if constexpr (SP2) {
            PG8_LDB(B0, 0, 0); PG8_LDB(B1, 0, 1); PG8_SCHED; PG8_LDA(At, 0, 0); PG8_STAGE(PG8_SA(1, 1), a1 + hstep, voffA);
            PG8_WAIT_V(8); PG8_WAIT_L(0); PG8_BAR; PG8_MMA(0, 0, At, B0); PG8_MMA(0, 1, At, B1); PG8_BAR; PG8_SCHED;
            PG8_LDA(At, 0, 1); PG8_STAGE(PG8_SB(0, 0), b2, voffB); PG8_STAGE(PG8_SB(0, 1), b2 + hstep, voffB); PG8_STAGE(PG8_SA(0, 0), a2, voffA);
            PG8_WAIT_V(8); PG8_WAIT_L(0); PG8_BAR; PG8_MMA(1, 0, At, B0); PG8_MMA(1, 1, At, B1); PG8_BAR; PG8_SCHED;
            PG8_LDB(B0, 1, 0); PG8_LDB(B1, 1, 1); PG8_SCHED; PG8_LDA(At, 1, 0); PG8_STAGE(PG8_SA(0, 1), a2 + hstep, voffA);
            PG8_WAIT_V(8); PG8_WAIT_L(0); PG8_BAR; PG8_MMA(0, 0, At, B0); PG8_MMA(0, 1, At, B1); PG8_BAR; PG8_SCHED;
            PG8_LDA(At, 1, 1); PG8_STAGE(PG8_SB(1, 0), b3, voffB); PG8_STAGE(PG8_SB(1, 1), b3 + hstep, voffB); PG8_STAGE(PG8_SA(1, 0), a3, voffA);
            PG8_WAIT_V(8); PG8_WAIT_L(0); PG8_BAR; PG8_MMA(1, 0, At, B0); PG8_MMA(1, 1, At, B1); PG8_BAR; PG8_SCHED;
            } else {
            PG8_LDB(B0, 0, 0); PG8_SCHED; PG8_LDA(At, 0, 0); PG8_STAGE(PG8_SA(1, 1), a1 + hstep, voffA);
            PG8_WAIT_L(8); PG8_BAR; PG8_WAIT_L(0); PG8_MMA(0, 0, At, B0); PG8_BAR; PG8_SCHED;
            PG8_LDB(B1, 0, 1); PG8_STAGE(PG8_SB(0, 0), b2, voffB);
            PG8_BAR; PG8_WAIT_L(0); PG8_MMA(0, 1, At, B1); PG8_BAR;
            PG8_LDA(At, 0, 1); PG8_STAGE(PG8_SA(0, 0), a2, voffA);
            PG8_BAR; PG8_WAIT_L(0); PG8_MMA(1, 0, At, B0); PG8_BAR; PG8_SCHED;
            PG8_STAGE(PG8_SB(0, 1), b2 + hstep, voffB);
            PG8_WAIT_V(6); PG8_BAR; PG8_MMA(1, 1, At, B1); PG8_BAR;
            PG8_LDB(B0, 1, 0); PG8_SCHED; PG8_LDA(At, 1, 0); PG8_STAGE(PG8_SA(0, 1), a2 + hstep, voffA);
            PG8_WAIT_L(8); PG8_BAR; PG8_WAIT_L(0); PG8_MMA(0, 0, At, B0); PG8_BAR; PG8_SCHED;
            PG8_LDB(B1, 1, 1); PG8_STAGE(PG8_SB(1, 0), b3, voffB);
            PG8_BAR; PG8_WAIT_L(0); PG8_MMA(0, 1, At, B1); PG8_BAR;
            PG8_LDA(At, 1, 1); PG8_STAGE(PG8_SA(1, 0), a3, voffA);
            PG8_BAR; PG8_WAIT_L(0); PG8_MMA(1, 0, At, B0); PG8_BAR; PG8_SCHED;
            PG8_STAGE(PG8_SB(1, 1), b3 + hstep, voffB);
            PG8_WAIT_V(6); PG8_BAR; PG8_MMA(1, 1, At, B1); PG8_BAR;
            }
        }
        if constexpr (ALIGN_EPI) { if (wr == 0) PG8_BAR; }
        if constexpr (Epi::PRE) { asm volatile("s_waitcnt vmcnt(16)" : "+v"(pre_v) :: "memory"); E.pre_store((PG8_LAS float*)(lds + STAGE_BYTES), pre_v, tid); PG8_WAIT_L(0); PG8_BAR; }
        GSTAMP(20);
        if constexpr (!Epi::AFTER_DRAIN) { int t2 = threadIdx.x; asm volatile("" : "+v"(t2));
            E(acc, cur, wr, wc, t2 & 15, (t2 >> 4) & 3, (const PG8_LAS float*)(lds + STAGE_BYTES)); S.done(cur); }
        GSTAMP(21);
        if (!has_next) break;
#pragma unroll
        for (int a = 0; a < 2; ++a)
#pragma unroll
            for (int b = 0; b < 2; ++b)
#pragma unroll
                for (int m = 0; m < 4; ++m)
#pragma unroll
                    for (int n = 0; n < 2; ++n) acc[a][b][m][n] = (f32x4){0.f, 0.f, 0.f, 0.f};
        cur = nxt; cA = nA; cB = nB; ++ui;
        if constexpr (ALIGN_EPI) { if (wr == 1) PG8_BAR; }
    }
    PG8_WAIT_V(0);
    if constexpr (!ALIGN_EPI) { if (wr == 0) PG8_BAR; }
    PG8_BAR;
    if constexpr (Epi::AFTER_DRAIN) { E.fused(acc, cur, wr, wc, fr, fq, lds, wid, lane); S.done(cur); }
#undef PG8_SA
#undef PG8_SB
#undef PG8_STAGE
#undef PG8_LDA
#undef PG8_LDB
#undef PG8_MMA
#undef PG8_WAIT_V
#undef PG8_WAIT_L
#undef PG8_BAR
#undef PG8_SCHED
}
}
#define GAS __attribute__((address_space(1)))
#define LAS __attribute__((address_space(3)))
typedef unsigned short bf16;
typedef unsigned v4u __attribute__((ext_vector_type(4)));
typedef float f32x4 __attribute__((ext_vector_type(4)));
typedef short bf16x8 __attribute__((ext_vector_type(8)));
typedef GAS unsigned gu32;
typedef GAS unsigned long long gu64;
#define RLX_AGENT __ATOMIC_RELAXED, __HIP_MEMORY_SCOPE_AGENT
#define LDS_WAIT() asm volatile("s_waitcnt lgkmcnt(0)" ::: "memory")
#define VM_WAIT() asm volatile("s_waitcnt vmcnt(0)" ::: "memory")
__device__ __forceinline__ unsigned long long rt() { return __builtin_amdgcn_s_memrealtime(); }
__device__ __forceinline__ unsigned f2bf(float f) { unsigned u = __builtin_bit_cast(unsigned, f); return (u + 0x7fffu + ((u >> 16) & 1u)) >> 16; }
__device__ __forceinline__ unsigned pk2(float lo, float hi) { return pg8::cvt_pk_bf16(lo, hi); }

#define XB_TMO      128
#define XB_XCNT(j)  (256  + 64 * (j))
#define XB_XSUB(j)  (1280 + 64 * (j))
#define XB_XGEN(j)  (2304 + 64 * (j))
#define XB_TOP      3328
#define XB_TOPGEN   3392
#define XCD_BAR_WORDS 3456
#define XB_SPIN_CAP (1u << 23)

__device__ __forceinline__ unsigned xb_ld(unsigned* p)              { return __hip_atomic_load(p, __ATOMIC_RELAXED, __HIP_MEMORY_SCOPE_AGENT); }
__device__ __forceinline__ unsigned xb_add(unsigned* p, unsigned v) { return __hip_atomic_fetch_add(p, v, __ATOMIC_RELAXED, __HIP_MEMORY_SCOPE_AGENT); }
__device__ __forceinline__ unsigned xb_xcc_id() { return (unsigned)__builtin_amdgcn_s_getreg((3 << 11) | 20) & 0xFu; }
#define XB_SPIN(cond, bar) do { unsigned _sp = 0; while (cond) { __builtin_amdgcn_s_sleep(1); \
    if ((++_sp & 255u) == 0u) { if (xb_ld(&(bar)[XB_TMO])) break; if (_sp > XB_SPIN_CAP) { atomicAdd(&(bar)[XB_TMO], 1u); break; } } } } while (0)

struct XcdBarrier {
    unsigned* bar; unsigned x;
    volatile LAS unsigned* st;
};

__device__ __forceinline__ XcdBarrier xcd_barrier_post(unsigned* bar, volatile LAS unsigned* st) {
    XcdBarrier b; b.bar = bar; b.x = xb_xcc_id(); b.st = st;
    if (threadIdx.x == 0) (void)xb_add(&bar[XB_XCNT(b.x)], 1u);
    return b;
}
__device__ __forceinline__ void xcd_barrier_complete(unsigned* bar, unsigned x, unsigned& nloc, unsigned& nx) {
    const unsigned G = gridDim.x * gridDim.y * gridDim.z;
    unsigned sum, cnt, mine, sp = 0u;
    for (;;) {
        sum = 0u; cnt = 0u; mine = 0u;
#pragma unroll
        for (unsigned j = 0; j < 16; ++j) { const unsigned c = xb_ld(&bar[XB_XCNT(j)]); sum += c; cnt += (c > 0u) ? 1u : 0u; mine = (j == x) ? c : mine; }
        if (sum == G) break;
        __builtin_amdgcn_s_sleep(1);
        if ((++sp & 255u) == 0u) { if (xb_ld(&bar[XB_TMO])) break; if (sp > XB_SPIN_CAP) { atomicAdd(&bar[XB_TMO], 1u); break; } }
    }
    nloc = mine > 0u ? mine : 1u; nx = cnt > 0u ? cnt : 1u;
}

__device__ __forceinline__ void xcd_barrier(const XcdBarrier& b) {
    asm volatile("s_waitcnt vmcnt(0)" ::: "memory");
    __syncthreads();
    if (threadIdx.x == 0) {
        unsigned* bar = b.bar;
        __builtin_amdgcn_s_waitcnt(0);
        unsigned nloc = b.st[0], nx = b.st[1];
        if (nloc == 0u) { xcd_barrier_complete(bar, b.x, nloc, nx); b.st[0] = nloc; b.st[1] = nx; }
        const unsigned old = xb_add(&bar[XB_XSUB(b.x)], 1u);
        const unsigned gen = old / nloc;
        if (old + 1u == (gen + 1u) * nloc) {
            __builtin_amdgcn_fence(__ATOMIC_RELEASE, "agent");
            asm volatile("s_waitcnt vmcnt(0)" ::: "memory");
            const unsigned og = xb_add(&bar[XB_TOP], 1u);
            const unsigned tg = og / nx;
            if (og + 1u == (tg + 1u) * nx) xb_add(&bar[XB_TOPGEN], 1u);
            else XB_SPIN(xb_ld(&bar[XB_TOPGEN]) == tg, bar);
            __builtin_amdgcn_fence(__ATOMIC_ACQUIRE, "agent");
            xb_add(&bar[XB_XGEN(b.x)], 1u);
            asm volatile("s_waitcnt vmcnt(0)" ::: "memory");
        } else {
            XB_SPIN(xb_ld(&bar[XB_XGEN(b.x)]) == gen, bar);
            __builtin_amdgcn_fence(__ATOMIC_ACQUIRE, "agent");
            asm volatile("s_waitcnt vmcnt(0)" ::: "memory");
        }
    }
    __syncthreads();
}
constexpr int NWAVES = 8;
constexpr int BATCH = 2, T = 16384, D = 1024, FF = 2816, NIN = 3584, DH = 512, NMOD = 9 * D;
constexpr int M = BATCH * T;
constexpr float EPS = 1e-6f;
constexpr size_t MiB = 1u << 20;
constexpr size_t WS_CTL = 0, CTL_ZERO_BYTES = 128 * 1024;
constexpr size_t WS_MOD = 1 * MiB;
constexpr size_t WS_SSQ2 = 128 * 1024, WS_SSQ3 = 256 * 1024, WS_SSQ4 = 384 * 1024, WS_SSQ1 = 512 * 1024;
constexpr size_t WS_GV = WS_MOD + 80 * 1024;
constexpr size_t WS_BIAS1 = 640 * 1024, WS_BIAS2 = 688 * 1024, WS_BIAS3 = 720 * 1024;
constexpr size_t WS_LBF = WS_MOD + 128 * 1024, WS_LBB = WS_LBF + 4096, WS_RGCL = WS_LBB + 4096;
constexpr size_t WS_RGTOT = 2 * MiB;
constexpr size_t WS_DG = 3 * MiB;
constexpr size_t WS_W13B = 4 * MiB, WS_W2A = 26 * MiB, WS_W2B = 32 * MiB, WS_WOUT = 45 * MiB, WS_RGW = 47 * MiB;
constexpr size_t WS_W13A = 400 * MiB, WS_WIN = 464 * MiB;
constexpr size_t W13_COPY = (size_t)2 * 2816 * 1024 * 2, WIN_COPY = (size_t)3584 * 1024 * 2;
constexpr size_t WS_XN = 48 * MiB;
constexpr size_t WS_HB = 112 * MiB;
constexpr size_t WS_ZQ = 112 * MiB, WS_ZV = 144 * MiB, WS_ZG = 176 * MiB, WS_ZRX = 208 * MiB, WS_ZRG = 240 * MiB, WS_ZLF = 272 * MiB, WS_ZLB = 304 * MiB;
constexpr size_t WS_XB = 336 * MiB;
constexpr size_t WS_SG = 400 * MiB;
constexpr size_t WS_OB = 464 * MiB;
constexpr size_t WS_END = 500 * MiB;
static_assert(WS_HB + (size_t)M * FF * 2 <= WS_SG && WS_XB + (size_t)M * D * 2 <= WS_SG && WS_W13B + 2 * W13_COPY <= WS_W2A && WS_W13A + 2 * W13_COPY <= WS_SG + 32 * MiB && WS_WIN + 2 * WIN_COPY <= WS_OB + 32 * MiB && WS_W2A + (size_t)D * FF * 2 <= WS_W2B && WS_W2B + (size_t)D * FF * 2 <= WS_WOUT, "ws map");
constexpr int CW_BAR = 4096;
constexpr int CW_FIN = 20480;
constexpr int CW_QUEUE = 16384;
constexpr int RING_OFF = 0, RING_BYTES = 145408;
constexpr int LDSCTL_OFF = RING_BYTES, MISC_OFF = LDSCTL_OFF + 320;
constexpr int LDS_BYTES = 147456;
static_assert(MISC_OFF + 128 <= LDS_BYTES, "LDS map");

struct Frame {
    LAS unsigned char* lds;
    volatile LAS unsigned* MISC;
    gu32* ctl;
    int tid, lane, wave, G, bid;
    const __attribute__((address_space(4))) unsigned long long* ka;
    float* out; unsigned char* ws;
};
#ifdef STAMP_A
#define STAMPX(F, k) do { if (blockIdx.x == 0 && threadIdx.x == 0) ((unsigned long long*)((F).ws + WS_CTL + 768 * 1024))[k] = __builtin_amdgcn_s_memrealtime(); } while (0)
#else
#define STAMPX(F, k) do { } while (0)
#endif
#define FIN(k) ((const float*)(const __attribute__((address_space(1))) float*)F.ka[k])
__device__ __forceinline__ float wave_sum(float v) {
#pragma unroll
    for (int o = 1; o < 64; o <<= 1) v += __shfl_xor(v, o);
    return v;
}
__device__ __forceinline__ float bf2f(unsigned short b) { return __builtin_bit_cast(float, ((unsigned)b) << 16); }
__device__ __forceinline__ float bflo(unsigned w) { return __builtin_bit_cast(float, w << 16); }
__device__ __forceinline__ float bfhi(unsigned w) { return __builtin_bit_cast(float, w & 0xffff0000u); }
__device__ __forceinline__ float sigmoidf_(float x) { return __builtin_amdgcn_rcpf(1.0f + __builtin_amdgcn_exp2f(-1.44269504f * x)); }

__device__ __forceinline__ void p0_transpose_item(const float* W, int K, int N, bf16* WT, int k0, int n0, int drow0, LAS float* scr, int lane, float scale = 1.0f) {
    {
        const int r8 = lane >> 3, c4 = 4 * (lane & 7); f32x4 tv[8];
#pragma unroll
        for (int i = 0; i < 8; ++i) tv[i] = *(const f32x4*)(W + (size_t)(k0 + 8 * i + r8) * N + n0 + c4);
#pragma unroll
        for (int i = 0; i < 8; ++i) { LAS float* d = scr + (8 * i + r8) * 33 + c4; d[0] = tv[i][0] * scale; d[1] = tv[i][1] * scale; d[2] = tv[i][2] * scale; d[3] = tv[i][3] * scale; } }
    LDS_WAIT(); asm volatile("" ::: "memory");
    const int c = lane & 7;
#pragma unroll
    for (int j = 0; j < 4; ++j) { const int n = (lane >> 3) + 8 * j; const LAS float* s = scr + (8 * c) * 33 + n;
        v4u o; o.x = pk2(s[0 * 33], s[1 * 33]); o.y = pk2(s[2 * 33], s[3 * 33]); o.z = pk2(s[4 * 33], s[5 * 33]); o.w = pk2(s[6 * 33], s[7 * 33]);
        *(GAS v4u*)(WT + (size_t)(drow0 + n) * K + k0 + 8 * c) = o; }
    LDS_WAIT(); asm volatile("" ::: "memory");
}
__device__ __forceinline__ void p0_item_w13(const float* W, int mat, bf16* WT, int item, LAS float* scr, int lane) {
    const int nblk = FF / 32, kb = item / nblk, nb = item % nblk, n0 = 32 * nb;
    p0_transpose_item(W, D, FF, WT, 64 * kb, n0, 256 * (n0 / 128) + 128 * mat + (n0 % 128), scr, lane);
}
__device__ __forceinline__ void p0_item_plain(const float* W, int K, int N, bf16* WT, int item, LAS float* scr, int lane) {
    const int nblk = N / 32, kb = item / nblk, nb = item % nblk;
    p0_transpose_item(W, K, N, WT, 64 * kb, 32 * nb, 32 * nb, scr, lane);
}

__device__ __forceinline__ void p0a(Frame& F) {
    LAS float* L = (LAS float*)(F.lds + RING_OFF);
    const float* c = FIN(1); const float* w_ada = FIN(2); const float* b_ada = FIN(3);
    float* MOD = (float*)(F.ws + WS_MOD);
    for (int gi = F.bid; gi < NMOD / 64; gi += F.G) {
        for (int i = F.tid; i < 2 * D; i += NWAVES * 64) { const float v = c[i]; L[i] = v * sigmoidf_(v); }
        __syncthreads();
        const int n = 64 * gi + F.lane;
        {
            const int c4 = F.lane & 15, kq = F.lane >> 4; f32x4 a0 = {0.f, 0.f, 0.f, 0.f}, a1 = {0.f, 0.f, 0.f, 0.f};
            const float* wp = w_ada + (size_t)(128 * F.wave + kq) * NMOD + 64 * gi + 4 * c4;
#pragma unroll 16
            for (int i = 0; i < 32; ++i) { const f32x4 wv = *(const f32x4*)(wp + (size_t)(4 * i) * NMOD); a0 += wv * L[128 * F.wave + 4 * i + kq]; a1 += wv * L[D + 128 * F.wave + 4 * i + kq]; }
#pragma unroll
            for (int q = 0; q < 4; ++q) { a0[q] += __shfl_xor(a0[q], 16); a0[q] += __shfl_xor(a0[q], 32); a1[q] += __shfl_xor(a1[q], 16); a1[q] += __shfl_xor(a1[q], 32); }
            if (kq == 0) { *(LAS f32x4*)(L + 2 * D + (F.wave * 2 + 0) * 64 + 4 * c4) = a0; *(LAS f32x4*)(L + 2 * D + (F.wave * 2 + 1) * 64 + 4 * c4) = a1; } }
        __syncthreads();
        if (F.wave < 2) { float s = b_ada[n];
#pragma unroll
            for (int w = 0; w < 8; ++w) s += L[2 * D + (w * 2 + F.wave) * 64 + F.lane];
            MOD[F.wave * NMOD + n] = s; }
        __syncthreads();
    }
    {
        f32x4* z0 = (f32x4*)(F.ws + 128 * 1024); f32x4* z1 = (f32x4*)(F.ws + 640 * 1024); const f32x4 zz = {0.f, 0.f, 0.f, 0.f};
        for (int i = F.bid * NWAVES * 64 + F.tid; i < (384 * 1024) / 16; i += F.G * NWAVES * 64) z0[i] = zz;
        for (int i = F.bid * NWAVES * 64 + F.tid; i < (128 * 1024) / 16; i += F.G * NWAVES * 64) z1[i] = zz;
    }
    if (F.bid == F.G - 1) {
        const float* lbf = FIN(10); const float* lbb = FIN(11); float* LBF = (float*)(F.ws + WS_LBF); float* LBB = (float*)(F.ws + WS_LBB); float* CL = (float*)(F.ws + WS_RGCL);
        for (int i = F.tid; i < DH; i += NWAVES * 64) {
            LBF[i] = sigmoidf_(lbf[DH + i] - lbf[i]); LBB[i] = sigmoidf_(lbb[DH + i] - lbb[i]);
            const float lf = FIN(19)[i], lb = FIN(24)[i];
            CL[i] = -8.0f * 1.44269504f * log1pf(expf(-lf)); CL[DH + i] = -8.0f * 1.44269504f * log1pf(expf(-lb));
        }
    }
    LAS float* scr = (LAS float*)(F.lds + RING_OFF + 16384 + F.wave * 12288);
    const int gw = F.bid * NWAVES + F.wave, NGW = F.G * NWAVES;
    constexpr int I_2 = (FF / 64) * (D / 32), I_OUT = (D / 64) * (D / 32), I_RG = 2;
    constexpr int NITEMS = 2 * I_2 + I_OUT + 32 * I_RG;
    for (int it = gw; it < NITEMS; it += NGW) {
        int r = it;
        if (r < I_2) { p0_item_plain(FIN(7), FF, D, (bf16*)(F.ws + WS_W2A), r, scr, F.lane); continue; } r -= I_2;
        if (r < I_2) { p0_item_plain(FIN(29), FF, D, (bf16*)(F.ws + WS_W2B), r, scr, F.lane); continue; } r -= I_2;
        if (r < I_OUT) { p0_item_plain(FIN(25), D, D, (bf16*)(F.ws + WS_WOUT), r, scr, F.lane); continue; } r -= I_OUT;
        { const int mb = r / I_RG, half = r % I_RG, mat = mb >> 3, blk = mb & 7;
          const float* src = (mat == 0 ? FIN(15) : mat == 1 ? FIN(17) : mat == 2 ? FIN(20) : FIN(22)) + (size_t)blk * 4096;
          p0_transpose_item(src, 64, 64, (bf16*)(F.ws + WS_RGW) + (size_t)mb * 4096, 0, 32 * half, 32 * half, scr, F.lane, -1.44269504f); }
    }
    const float* xin = FIN(0); bf16* XB = (bf16*)(F.ws + WS_XB); float* SSQ = (float*)(F.ws + WS_SSQ1);
    for (;;) {
        __syncthreads();
        if (F.tid == 0) F.MISC[16] = __hip_atomic_fetch_add(F.ctl + CW_QUEUE + 128, 1u, __ATOMIC_RELAXED, __HIP_MEMORY_SCOPE_AGENT);
        __syncthreads(); const int bt = (int)F.MISC[16];
        if (bt >= M / 32) break;
        const int mb = 32 * bt + 4 * F.wave;
        f32x4 v[4][4];
#pragma unroll
        for (int r = 0; r < 4; ++r) { const GAS f32x4* xr = (const GAS f32x4*)(xin + (size_t)(mb + r) * D) + F.lane;
#pragma unroll
            for (int j = 0; j < 4; ++j) v[r][j] = xr[64 * j]; }
#pragma unroll
        for (int r = 0; r < 4; ++r) { const int m = mb + r; float s = 0.f;
#pragma unroll
            for (int j = 0; j < 4; ++j) s += (v[r][j].x * v[r][j].x + v[r][j].y * v[r][j].y) + (v[r][j].z * v[r][j].z + v[r][j].w * v[r][j].w);
            s = wave_sum(s);
            if (F.lane == 0) SSQ[m] = s;
            GAS unsigned long long* o8 = (GAS unsigned long long*)(XB + (size_t)m * D) + F.lane;
#pragma unroll
            for (int j = 0; j < 4; ++j) o8[64 * j] = (unsigned long long)pk2(v[r][j].x, v[r][j].y) | ((unsigned long long)pk2(v[r][j].z, v[r][j].w) << 32); }
    }
}

__device__ __forceinline__ void p0_fold_item(const float* W, int N, bf16* WT, size_t copy_elems, int k0, int n0, int drow0, const float* gain, const float* sc, const float* sh, float* bias, int bstride, LAS float* scr, int lane) {
    const int r8 = lane >> 3, c4 = 4 * (lane & 7), c = lane & 7; f32x4 tv[8];
#pragma unroll
    for (int i = 0; i < 8; ++i) tv[i] = *(const f32x4*)(W + (size_t)(k0 + 8 * i + r8) * N + n0 + c4);
    const f32x4 ga = *(const f32x4*)(gain + k0 + 8 * c), gb = *(const f32x4*)(gain + k0 + 8 * c + 4);
    f32x4 sa[2], sb[2];
#pragma unroll
    for (int bb = 0; bb < 2; ++bb) { sa[bb] = *(const f32x4*)(sc + (size_t)bb * NMOD + k0 + 8 * c); sb[bb] = *(const f32x4*)(sc + (size_t)bb * NMOD + k0 + 8 * c + 4); }
    const float sh0 = sh[k0 + lane], sh1 = sh[(size_t)NMOD + k0 + lane];
    LAS float* shl = scr + 64 * 33;
#pragma unroll
    for (int i = 0; i < 8; ++i) { LAS float* d = scr + (8 * i + r8) * 33 + c4; d[0] = tv[i][0]; d[1] = tv[i][1]; d[2] = tv[i][2]; d[3] = tv[i][3]; }
    shl[lane] = sh0; shl[64 + lane] = sh1;
    LDS_WAIT(); asm volatile("" ::: "memory");
#pragma unroll
    for (int b = 0; b < 2; ++b) {
        const f32x4 va = ga * (1.0f + sa[b]), vb = gb * (1.0f + sb[b]);
        const float gv[8] = {va[0], va[1], va[2], va[3], vb[0], vb[1], vb[2], vb[3]};
#pragma unroll
        for (int j = 0; j < 4; ++j) { const int n = (lane >> 3) + 8 * j; const LAS float* s = scr + (8 * c) * 33 + n;
            v4u o; o.x = pk2(s[0 * 33] * gv[0], s[1 * 33] * gv[1]); o.y = pk2(s[2 * 33] * gv[2], s[3 * 33] * gv[3]); o.z = pk2(s[4 * 33] * gv[4], s[5 * 33] * gv[5]); o.w = pk2(s[6 * 33] * gv[6], s[7 * 33] * gv[7]);
            *(GAS v4u*)(WT + (size_t)b * copy_elems + (size_t)(drow0 + n) * D + k0 + 8 * c) = o; }
    }
    { const int n = lane & 31, b = lane >> 5; float a = 0.f;
#pragma unroll 16
      for (int kk = 0; kk < 64; ++kk) a += scr[kk * 33 + n] * shl[b * 64 + kk];
      atomicAdd(bias + (size_t)b * bstride + drow0 + n, a); }
    LDS_WAIT(); asm volatile("" ::: "memory");
}
__device__ __forceinline__ void p0b(Frame& F) {
    const float* MOD = (const float*)(F.ws + WS_MOD);
    const int gw = F.bid * NWAVES + F.wave, NGW = F.G * NWAVES;
    {
        LAS float* scr = (LAS float*)(F.lds + RING_OFF + F.wave * 12288);
        constexpr int I_13 = (D / 64) * (FF / 32), I_IN = (D / 64) * (NIN / 32);
        constexpr int NITEMS = 4 * I_13 + I_IN;
        auto tile = [&](int it, int& N) -> const float* {
            int r = it;
            if (r < 2 * I_13) { const int mat = r >= I_13; r -= mat * I_13; const int nblk = FF / 32, kb = r / nblk, nb = r % nblk; N = FF; return (mat ? FIN(6) : FIN(5)) + (size_t)(64 * kb) * FF + 32 * nb; }
            r -= 2 * I_13;
            if (r < 2 * I_13) { const int mat = r >= I_13; r -= mat * I_13; const int nblk = FF / 32, kb = r / nblk, nb = r % nblk; N = FF; return (mat ? FIN(28) : FIN(27)) + (size_t)(64 * kb) * FF + 32 * nb; }
            r -= 2 * I_13;
            { const int nblk = NIN / 32, kb = r / nblk, nb = r % nblk; N = NIN; return FIN(9) + (size_t)(64 * kb) * NIN + 32 * nb; } };
        for (int it = gw; it < NITEMS; it += NGW) {
            int r = it;
            if (r < 2 * I_13) { const int mat = r >= I_13; r -= mat * I_13; const int nblk = FF / 32, kb = r / nblk, nb = r % nblk, n0 = 32 * nb;
                p0_fold_item(mat ? FIN(6) : FIN(5), FF, (bf16*)(F.ws + WS_W13A), W13_COPY / 2, 64 * kb, n0, 256 * (n0 / 128) + 128 * mat + (n0 % 128), FIN(4), MOD + 1 * D, MOD + 0 * D, (float*)(F.ws + WS_BIAS1), 2 * FF, scr, F.lane); }
            else if (r < 4 * I_13) { r -= 2 * I_13; const int mat = r >= I_13; r -= mat * I_13; const int nblk = FF / 32, kb = r / nblk, nb = r % nblk, n0 = 32 * nb;
                p0_fold_item(mat ? FIN(28) : FIN(27), FF, (bf16*)(F.ws + WS_W13B), W13_COPY / 2, 64 * kb, n0, 256 * (n0 / 128) + 128 * mat + (n0 % 128), FIN(26), MOD + 7 * D, MOD + 6 * D, (float*)(F.ws + WS_BIAS3), 2 * FF, scr, F.lane); }
            else { r -= 4 * I_13; const int nblk = NIN / 32, kb = r / nblk, nb = r % nblk;
              p0_fold_item(FIN(9), NIN, (bf16*)(F.ws + WS_WIN), WIN_COPY / 2, 64 * kb, 32 * nb, 32 * nb, FIN(8), MOD + 4 * D, MOD + 3 * D, (float*)(F.ws + WS_BIAS2), NIN, scr, F.lane); }
        }
    }
}
__device__ __forceinline__ void final_norm_rows(Frame& F, const bf16* xb, float* out, const float* gain, const float* ssq) {
    const int gw = F.bid * NWAVES + F.wave, NGW = F.G * NWAVES;
    f32x4 g[4];
#pragma unroll
    for (int j = 0; j < 2; ++j) { g[2 * j] = *(const f32x4*)(gain + 512 * j + 8 * F.lane); g[2 * j + 1] = *(const f32x4*)(gain + 512 * j + 8 * F.lane + 4); }
    for (int m0 = gw; m0 < M; m0 += 4 * NGW) {
        v4u v[4][2]; float sq[4];
#pragma unroll
        for (int r = 0; r < 4; ++r) { const bf16* xr = xb + (size_t)(m0 + r * NGW) * D + 8 * F.lane; sq[r] = ssq[m0 + r * NGW]; v[r][0] = *(const v4u*)xr; v[r][1] = *(const v4u*)(xr + 512); }
#pragma unroll
        for (int r = 0; r < 4; ++r) { float* orow = out + (size_t)(m0 + r * NGW) * D + 8 * F.lane; const float rs = __builtin_amdgcn_rsqf(sq[r] * (1.f / D) + EPS);
#pragma unroll
            for (int j = 0; j < 2; ++j) { const v4u w = v[r][j];
                *(f32x4*)(orow + 512 * j) = (f32x4){bflo(w.x), bfhi(w.x), bflo(w.y), bfhi(w.y)} * rs * g[2 * j];
                *(f32x4*)(orow + 512 * j + 4) = (f32x4){bflo(w.z), bfhi(w.z), bflo(w.w), bfhi(w.w)} * rs * g[2 * j + 1]; } }
    }
}
__device__ __forceinline__ void hgrn2_naive(Frame& F, int ci) {
    const int dir = ci & 1, h = (ci >> 1) & 3, b = ci >> 3;
    LAS float* QS = (LAS float*)(F.lds + RING_OFF); LAS float* FS = QS + 2048; LAS float* KS = FS + 2048; LAS float* VS = KS + 2048; LAS float* PART = VS + 2048;
    const bf16* ZQ = (const bf16*)(F.ws + WS_ZQ); const bf16* ZV = (const bf16*)(F.ws + WS_ZV); const bf16* ZL = (const bf16*)(F.ws + (dir ? WS_ZLB : WS_ZLF));
    float* OF = (float*)(F.ws + WS_SG); bf16* OB = (bf16*)(F.ws + WS_OB);
    const int v = F.tid & 127, kq = F.tid >> 7;
    float S[32];
#pragma unroll
    for (int i = 0; i < 32; ++i) S[i] = 0.f;
    for (int tl = 0; tl < T / 16; ++tl) {
        { const int tt = F.tid >> 5, k4 = (F.tid & 31) * 4; const int p = 16 * tl + tt, t = dir ? (T - 1 - p) : p; const size_t off = (size_t)(b * T + t) * DH + h * 128 + k4;
          const uint2 qw = *(const uint2*)(ZQ + off); const uint2 vw = *(const uint2*)(ZV + off); const uint2 lw = *(const uint2*)(ZL + off); const f32x4 lg = {bflo(lw.x), bfhi(lw.x), bflo(lw.y), bfhi(lw.y)};
          LAS float* q = QS + tt * 128 + k4; q[0] = bflo(qw.x); q[1] = bfhi(qw.x); q[2] = bflo(qw.y); q[3] = bfhi(qw.y);
          LAS float* vv = VS + tt * 128 + k4; vv[0] = bflo(vw.x); vv[1] = bfhi(vw.x); vv[2] = bflo(vw.y); vv[3] = bfhi(vw.y);
#pragma unroll
          for (int j = 0; j < 4; ++j) { const float f = __builtin_amdgcn_exp2f(lg[j]); FS[tt * 128 + k4 + j] = f; KS[tt * 128 + k4 + j] = 1.0f - f; } }
        __syncthreads();
        for (int tt = 0; tt < 16; ++tt) { const float vv = VS[tt * 128 + v]; float a = 0.f; const LAS float* fp = FS + tt * 128 + 32 * kq; const LAS float* kp = KS + tt * 128 + 32 * kq; const LAS float* qp = QS + tt * 128 + 32 * kq;
#pragma unroll
            for (int kk = 0; kk < 32; ++kk) { S[kk] = fp[kk] * S[kk] + kp[kk] * vv; a += S[kk] * qp[kk]; }
            PART[(kq * 16 + tt) * 128 + v] = a; }
        __syncthreads();
        { const int tt = F.tid >> 5, v4 = (F.tid & 31) * 4; const int p = 16 * tl + tt, t = dir ? (T - 1 - p) : p; const size_t off = (size_t)(b * T + t) * DH + h * 128 + v4;
          f32x4 o = {0.f, 0.f, 0.f, 0.f};
#pragma unroll
          for (int q = 0; q < 4; ++q) o += *(const LAS f32x4*)(PART + (q * 16 + tt) * 128 + v4);
          if (dir == 0) *(f32x4*)(OF + off) = o; else { uint2 w; w.x = pk2(o[0], o[1]); w.y = pk2(o[2], o[3]); *(uint2*)(OB + off) = w; } }
    }
}
__device__ __forceinline__ void rglru_seg(Frame& F, int pass) {
    const int b = F.bid >> 7, blk = (F.bid >> 4) & 7, sg = F.bid & 15;
    LAS float* L = (LAS float*)(F.lds + RING_OFF);
    for (int i = F.tid; i < 4 * 4096; i += NWAVES * 64) { const int mat = i >> 12; const float* src = mat == 0 ? FIN(15) : mat == 1 ? FIN(17) : mat == 2 ? FIN(20) : FIN(22); L[i] = src[(size_t)blk * 4096 + (i & 4095)]; }
    __syncthreads();
    if (F.wave < 4) {
        const int seg = sg * 4 + F.wave, e = F.lane, ch = 64 * blk + e, t0 = seg * 256;
        const bf16* ZRX = (const bf16*)(F.ws + WS_ZRX); const bf16* ZRG = (const bf16*)(F.ws + WS_ZRG); bf16* YM = (bf16*)(F.ws + WS_XN);
        const float* CL = (const float*)(F.ws + WS_RGCL); float2* TOT = (float2*)(F.ws + WS_RGTOT);
        const float* cw = FIN(13); const float c0 = cw[ch], c1 = cw[DH + ch], c2 = cw[2 * DH + ch], c3 = cw[3 * DH + ch], cb = FIN(14)[ch];
        for (int dir = 0; dir < 2; ++dir) {
            const LAS float* wa = L + (2 * dir) * 4096 + e; const LAS float* wx = L + (2 * dir + 1) * 4096 + e;
            const float ba = (dir ? FIN(21) : FIN(16))[ch], bx = (dir ? FIN(23) : FIN(18))[ch], cl = CL[dir * DH + ch];
            float hs = 0.f, A = 1.f;
            if (pass == 1) {
                if (dir == 0) { for (int s = 0; s < seg; ++s) { const float2 tt = TOT[(size_t)((b * 64 + s) * 2 + 0) * DH + ch]; hs = tt.x * hs + tt.y; } }
                else { for (int s = 63; s > seg; --s) { const float2 tt = TOT[(size_t)((b * 64 + s) * 2 + 1) * DH + ch]; hs = tt.x * hs + tt.y; } }
            }
            for (int p = 0; p < 256; ++p) {
                const int t = dir ? (t0 + 255 - p) : (t0 + p); const size_t m = (size_t)b * T + t;
                const float x0 = t >= 2 ? bf2f(ZRX[(m - 2) * DH + ch]) : 0.f, x1 = t >= 1 ? bf2f(ZRX[(m - 1) * DH + ch]) : 0.f, x2 = bf2f(ZRX[m * DH + ch]), x3 = t + 1 < T ? bf2f(ZRX[(m + 1) * DH + ch]) : 0.f;
                const float xc = cb + c0 * x0 + c1 * x1 + c2 * x2 + c3 * x3;
                float rp = ba, ip = bx;
#pragma unroll 8
                for (int d = 0; d < 64; ++d) { const float xd = __shfl(xc, d); rp += xd * wa[d * 64]; ip += xd * wx[d * 64]; }
                const float r = sigmoidf_(rp), ii = sigmoidf_(ip), l2a = cl * r, a = __builtin_amdgcn_exp2f(l2a);
                const float u = sqrtf(fmaxf(1.0f - __builtin_amdgcn_exp2f(2.0f * l2a), 0.f)) * ii * xc;
                hs = a * hs + u; A *= a;
                if (pass == 1) { bf16* yp = YM + m * D + DH + ch;
                    if (dir == 0) *yp = (bf16)f2bf(hs); else *yp = (bf16)f2bf((bf2f(*yp) + hs) * bf2f(ZRG[m * DH + ch])); }
            }
            if (pass == 0) TOT[(size_t)((b * 64 + seg) * 2 + dir) * DH + ch] = make_float2(A, hs);
            asm volatile("s_waitcnt vmcnt(0)" ::: "memory");
        }
    }
    __syncthreads();
}
__device__ __forceinline__ void hgrn2_combine_rows(Frame& F) {
    const float* OF = (const float*)(F.ws + WS_SG); const bf16* OB = (const bf16*)(F.ws + WS_OB); const bf16* ZG = (const bf16*)(F.ws + WS_ZG); bf16* YM = (bf16*)(F.ws + WS_XN);
    const float* gn = FIN(12);
    const int gw = F.bid * NWAVES + F.wave, NGW = F.G * NWAVES;
    for (int m = gw; m < M; m += NGW) {
        const size_t off = (size_t)m * DH + 8 * F.lane;
        const f32x4 a0 = *(const f32x4*)(OF + off), a1 = *(const f32x4*)(OF + off + 4); const v4u bw = *(const v4u*)(OB + off), gwd = *(const v4u*)(ZG + off);
        float o[8] = {a0[0] + bflo(bw.x), a0[1] + bfhi(bw.x), a0[2] + bflo(bw.y), a0[3] + bfhi(bw.y), a1[0] + bflo(bw.z), a1[1] + bfhi(bw.z), a1[2] + bflo(bw.w), a1[3] + bfhi(bw.w)};
        float s = 0.f;
#pragma unroll
        for (int j = 0; j < 8; ++j) s += o[j] * o[j];
        s += __shfl_xor(s, 1); s += __shfl_xor(s, 2); s += __shfl_xor(s, 4); s += __shfl_xor(s, 8);
        const float rstd = rsqrtf(s * (1.f / 128.f) + EPS);
        const f32x4 g0 = *(const f32x4*)(gn + (8 * F.lane & 127)), g1 = *(const f32x4*)(gn + (8 * F.lane & 127) + 4);
        const float gg[8] = {bflo(gwd.x), bfhi(gwd.x), bflo(gwd.y), bfhi(gwd.y), bflo(gwd.z), bfhi(gwd.z), bflo(gwd.w), bfhi(gwd.w)};
        v4u w; w.x = pk2(o[0] * rstd * g0[0] * gg[0], o[1] * rstd * g0[1] * gg[1]); w.y = pk2(o[2] * rstd * g0[2] * gg[2], o[3] * rstd * g0[3] * gg[3]);
        w.z = pk2(o[4] * rstd * g1[0] * gg[4], o[5] * rstd * g1[1] * gg[5]); w.w = pk2(o[6] * rstd * g1[2] * gg[6], o[7] * rstd * g1[3] * gg[7]);
        *(v4u*)(YM + (size_t)m * D + 8 * F.lane) = w;
    }
}
namespace hg {
constexpr int QT = 0, KH = 8704, KT = 17408, VT = 27648, PB = 37888, ST = 40448, DEC = 75264, SEG = 75776, OT = 79872;
constexpr int RS = 272, TS = 80, OTS = 132;
typedef short bf16x8 __attribute__((ext_vector_type(8)));
typedef unsigned u32x2 __attribute__((ext_vector_type(2)));
typedef float f32x2 __attribute__((ext_vector_type(2)));
constexpr int NSC = 32, SCT = 512, NCH = 16;
constexpr size_t CARRY_OFF = 32 * MiB;
__device__ __forceinline__ int slot_of(int b, int h, int j, int dir) { return (((b * 4 + h) * NSC + j) * 2 + dir); }

template <int MODE>
__device__ __forceinline__ void pass(Frame& F, int b, int h, int j, int dir) {
    LAS unsigned char* L = F.lds + RING_OFF;
    const int tid = F.tid, lane = F.lane, w = F.wave, fr = lane & 15, fq = lane >> 4, cp = lane, ts = w;
    const bf16* ZQ = (const bf16*)(F.ws + WS_ZQ); const bf16* ZV = (const bf16*)(F.ws + WS_ZV); const bf16* ZL = (const bf16*)(F.ws + (dir ? WS_ZLB : WS_ZLF));
    float* SGp = (float*)(F.ws + WS_SG + (MODE != 0 ? CARRY_OFF : 0)) + (size_t)slot_of(b, h, j, dir) * 16384;
    const int colq = h * 128 + 2 * cp;
    auto mrow = [&](int c, int r) -> size_t { const int pos = 32 * c + r; return (size_t)b * T + (dir ? (SCT * j + SCT - 1 - pos) : (SCT * j + pos)); };
    STAMPX(F, 40);
    f32x4 s[8];
#pragma unroll
    for (int i = 0; i < 8; ++i) s[i] = (f32x4){0.f, 0.f, 0.f, 0.f};
    if (MODE != 0) {
#pragma unroll
        for (int i = 0; i < 8; ++i) { s[i] = *(const f32x4*)(SGp + (16 * w + fr) * 128 + 16 * i + 4 * fq);
            u32x2 pk; pk.x = pg8::cvt_pk_bf16(s[i][0], s[i][1]); pk.y = pg8::cvt_pk_bf16(s[i][2], s[i][3]);
            *(LAS u32x2*)(L + ST + (16 * w + fr) * RS + (16 * i + 4 * fq) * 2) = pk; }
    }
    float dsum0 = 0.f, dsum1 = 0.f;
    f32x4 g0 = {0.f, 0.f, 0.f, 0.f}, g1 = {0.f, 0.f, 0.f, 0.f};
    if (MODE == 2) { g0 = *(const f32x4*)(FIN(12) + 8 * (tid & 15)); g1 = *(const f32x4*)(FIN(12) + 8 * (tid & 15) + 4); }
    unsigned qA[4], vA[4], lA[4], qB[4], vB[4], lB[4];
    v4u obA = {0u, 0u, 0u, 0u}, gwA = {0u, 0u, 0u, 0u}, obB = {0u, 0u, 0u, 0u}, gwB = {0u, 0u, 0u, 0u};
    auto issue = [&](int c, unsigned (&q)[4], unsigned (&v)[4], unsigned (&l)[4]) {
#pragma unroll
        for (int r = 0; r < 4; ++r) { const size_t m = mrow(c, 4 * ts + r); q[r] = *(const unsigned*)(ZQ + m * DH + colq); v[r] = *(const unsigned*)(ZV + m * DH + colq); l[r] = *(const unsigned*)(ZL + m * DH + colq); } };
    auto issue_comb = [&](int c, v4u& ob, v4u& gw) { const size_t m = mrow(c, tid >> 4); ob = *(const v4u*)((const bf16*)(F.ws + WS_OB) + m * DH + h * 128 + 8 * (tid & 15)); gw = *(const v4u*)((const bf16*)(F.ws + WS_ZG) + m * DH + h * 128 + 8 * (tid & 15)); };
    issue(0, qA, vA, lA); issue(1, qB, vB, lB);
    if (MODE == 2) { issue_comb(0, obA, gwA); issue_comb(1, obB, gwB); }
    auto body = [&](int c, unsigned (&qX)[4], unsigned (&vX)[4], unsigned (&lX)[4], v4u& obX, v4u& gwX) {
        unsigned qc[4], vc[4]; float2 lc[4];
#pragma unroll
        for (int r = 0; r < 4; ++r) { qc[r] = qX[r]; vc[r] = vX[r]; lc[r] = make_float2(bflo(lX[r]), bfhi(lX[r])); }
        if (c < NCH - 2) issue(c + 2, qX, vX, lX);
        float cs0[4], cs1[4];
        cs0[0] = lc[0].x; cs1[0] = lc[0].y;
#pragma unroll
        for (int r = 1; r < 4; ++r) { cs0[r] = cs0[r - 1] + lc[r].x; cs1[r] = cs1[r - 1] + lc[r].y; }
        *(LAS f32x2*)(L + SEG + (ts * 128 + 2 * cp) * 4) = (f32x2){cs0[3], cs1[3]};
        __syncthreads();
        float pre0 = 0.f, pre1 = 0.f, tot0 = 0.f, tot1 = 0.f;
#pragma unroll
        for (int t2 = 0; t2 < 8; ++t2) { const f32x2 sv = *(const LAS f32x2*)(L + SEG + (t2 * 128 + 2 * cp) * 4); tot0 += sv.x; tot1 += sv.y; if (t2 < ts) { pre0 += sv.x; pre1 += sv.y; } }
        dsum0 += tot0; dsum1 += tot1;
        if (ts == 0) *(LAS f32x2*)(L + DEC + 2 * cp * 4) = (f32x2){__builtin_amdgcn_exp2f(tot0), __builtin_amdgcn_exp2f(tot1)};
        unsigned kt0[2], kt1[2];
        float kta[4], ktb[4];
#pragma unroll
        for (int r = 0; r < 4; ++r) {
            const float b0 = pre0 + cs0[r], b1 = pre1 + cs1[r];
            const float q0 = bflo(qc[r]), q1 = bfhi(qc[r]);
            const float k0 = 1.0f - __builtin_amdgcn_exp2f(lc[r].x), k1 = 1.0f - __builtin_amdgcn_exp2f(lc[r].y);
            const int row = 4 * ts + r;
            if (MODE != 0) {
                *(LAS unsigned*)(L + QT + row * RS + 4 * cp) = pg8::cvt_pk_bf16(q0 * __builtin_amdgcn_exp2f(b0), q1 * __builtin_amdgcn_exp2f(b1));
                *(LAS unsigned*)(L + KH + row * RS + 4 * cp) = pg8::cvt_pk_bf16(k0 * __builtin_amdgcn_exp2f(fminf(-b0, 126.f)), k1 * __builtin_amdgcn_exp2f(fminf(-b1, 126.f)));
            }
            kta[r] = k0 * __builtin_amdgcn_exp2f(tot0 - b0); ktb[r] = k1 * __builtin_amdgcn_exp2f(tot1 - b1);
        }
        kt0[0] = pg8::cvt_pk_bf16(kta[0], kta[1]); kt0[1] = pg8::cvt_pk_bf16(kta[2], kta[3]); kt1[0] = pg8::cvt_pk_bf16(ktb[0], ktb[1]); kt1[1] = pg8::cvt_pk_bf16(ktb[2], ktb[3]);
        *(LAS u32x2*)(L + KT + (2 * cp) * TS + 8 * ts) = (u32x2){kt0[0], kt0[1]};
        *(LAS u32x2*)(L + KT + (2 * cp + 1) * TS + 8 * ts) = (u32x2){kt1[0], kt1[1]};
        {
            const unsigned a0 = (vc[0] & 0xffffu) | (vc[1] << 16), a1 = (vc[2] & 0xffffu) | (vc[3] << 16);
            const unsigned c0 = (vc[0] >> 16) | (vc[1] & 0xffff0000u), c1 = (vc[2] >> 16) | (vc[3] & 0xffff0000u);
            *(LAS u32x2*)(L + VT + (2 * cp) * TS + 8 * ts) = (u32x2){a0, a1};
            *(LAS u32x2*)(L + VT + (2 * cp + 1) * TS + 8 * ts) = (u32x2){c0, c1};
        }
        __syncthreads();
        f32x4 o[2] = {(f32x4){0.f, 0.f, 0.f, 0.f}, (f32x4){0.f, 0.f, 0.f, 0.f}};
        if (MODE != 0) {
            f32x4 p = (f32x4){0.f, 0.f, 0.f, 0.f}; const int pmt = (w >> 1) & 1, pnt = w & 1;
#pragma unroll
            for (int ks = 0; ks < 4; ++ks) {
                const bf16x8 a0 = *(const LAS bf16x8*)(L + QT + (fr) * RS + (32 * ks + 8 * fq) * 2), a1 = *(const LAS bf16x8*)(L + QT + (16 + fr) * RS + (32 * ks + 8 * fq) * 2);
                const bf16x8 bs = *(const LAS bf16x8*)(L + ST + (16 * w + fr) * RS + (32 * ks + 8 * fq) * 2);
                o[0] = __builtin_amdgcn_mfma_f32_16x16x32_bf16(a0, bs, o[0], 0, 0, 0);
                o[1] = __builtin_amdgcn_mfma_f32_16x16x32_bf16(a1, bs, o[1], 0, 0, 0);
                if (w < 4) { const bf16x8 bk = *(const LAS bf16x8*)(L + KH + (16 * pnt + fr) * RS + (32 * ks + 8 * fq) * 2);
                    p = __builtin_amdgcn_mfma_f32_16x16x32_bf16(pmt ? a1 : a0, bk, p, 0, 0, 0); }
            }
            if (w < 4) {
#pragma unroll
                for (int rg = 0; rg < 4; ++rg) { const int t = 16 * pmt + 4 * fq + rg, sc = 16 * pnt + fr; const float pv = (sc <= t) ? p[rg] : 0.f;
                    *(LAS unsigned short*)(L + PB + t * TS + sc * 2) = (unsigned short)(pg8::cvt_pk_bf16(pv, 0.f) & 0xffffu); }
            }
            __syncthreads();
        }
        const bf16x8 bv = *(const LAS bf16x8*)(L + VT + (16 * w + fr) * TS + 16 * fq);
        if (MODE != 0) {
#pragma unroll
            for (int mt = 0; mt < 2; ++mt) { const bf16x8 ap = *(const LAS bf16x8*)(L + PB + (16 * mt + fr) * TS + 16 * fq);
                o[mt] = __builtin_amdgcn_mfma_f32_16x16x32_bf16(ap, bv, o[mt], 0, 0, 0);
#pragma unroll
                for (int rg = 0; rg < 4; ++rg) *(LAS float*)(L + OT + ((16 * mt + 4 * fq + rg) * OTS + 16 * w + fr) * 4) = o[mt][rg]; }
        }
#pragma unroll
        for (int i = 0; i < 8; ++i) {
            const f32x4 d4 = *(const LAS f32x4*)(L + DEC + (16 * i + 4 * fq) * 4);
            const bf16x8 ak = *(const LAS bf16x8*)(L + KT + (16 * i + fr) * TS + 16 * fq);
            s[i] = s[i] * d4;
            s[i] = __builtin_amdgcn_mfma_f32_16x16x32_bf16(ak, bv, s[i], 0, 0, 0);
            if (MODE != 0) { u32x2 pk; pk.x = pg8::cvt_pk_bf16(s[i][0], s[i][1]); pk.y = pg8::cvt_pk_bf16(s[i][2], s[i][3]);
                *(LAS u32x2*)(L + ST + (16 * w + fr) * RS + (16 * i + 4 * fq) * 2) = pk; }
        }
        __syncthreads();
        if (MODE != 0) {
            const int t = tid >> 4, vg = tid & 15; const size_t m = mrow(c, t);
            const f32x4 o0 = *(const LAS f32x4*)(L + OT + (t * OTS + 8 * vg) * 4), o1 = *(const LAS f32x4*)(L + OT + (t * OTS + 8 * vg + 4) * 4);
            if (MODE == 1) {
                v4u wv; wv.x = pg8::cvt_pk_bf16(o0[0], o0[1]); wv.y = pg8::cvt_pk_bf16(o0[2], o0[3]); wv.z = pg8::cvt_pk_bf16(o1[0], o1[1]); wv.w = pg8::cvt_pk_bf16(o1[2], o1[3]);
                *(v4u*)((bf16*)(F.ws + WS_OB) + m * DH + h * 128 + 8 * vg) = wv;
            } else {
                const v4u bw = obX, gwd = gwX;
                float ov[8] = {o0[0] + bflo(bw.x), o0[1] + bfhi(bw.x), o0[2] + bflo(bw.y), o0[3] + bfhi(bw.y), o1[0] + bflo(bw.z), o1[1] + bfhi(bw.z), o1[2] + bflo(bw.w), o1[3] + bfhi(bw.w)};
                float ss = 0.f;
#pragma unroll
                for (int q = 0; q < 8; ++q) ss += ov[q] * ov[q];
                ss += __builtin_bit_cast(float, __builtin_amdgcn_update_dpp(0, __builtin_bit_cast(int, ss), 0xB1, 0xF, 0xF, true));
                ss += __builtin_bit_cast(float, __builtin_amdgcn_update_dpp(0, __builtin_bit_cast(int, ss), 0x4E, 0xF, 0xF, true));
                ss += __builtin_bit_cast(float, __builtin_amdgcn_update_dpp(0, __builtin_bit_cast(int, ss), 0x141, 0xF, 0xF, true));
                ss += __builtin_bit_cast(float, __builtin_amdgcn_update_dpp(0, __builtin_bit_cast(int, ss), 0x140, 0xF, 0xF, true));
                const float rstd = __builtin_amdgcn_rsqf(ss * (1.f / 128.f) + EPS);
                const float gg[8] = {bflo(gwd.x), bfhi(gwd.x), bflo(gwd.y), bfhi(gwd.y), bflo(gwd.z), bfhi(gwd.z), bflo(gwd.w), bfhi(gwd.w)};
                v4u wv; wv.x = pg8::cvt_pk_bf16(ov[0] * rstd * g0[0] * gg[0], ov[1] * rstd * g0[1] * gg[1]); wv.y = pg8::cvt_pk_bf16(ov[2] * rstd * g0[2] * gg[2], ov[3] * rstd * g0[3] * gg[3]);
                wv.z = pg8::cvt_pk_bf16(ov[4] * rstd * g1[0] * gg[4], ov[5] * rstd * g1[1] * gg[5]); wv.w = pg8::cvt_pk_bf16(ov[6] * rstd * g1[2] * gg[6], ov[7] * rstd * g1[3] * gg[7]);
                *(v4u*)((bf16*)(F.ws + WS_XN) + m * D + h * 128 + 8 * vg) = wv;
            }
            if (MODE == 2 && c < NCH - 2) issue_comb(c + 2, obX, gwX);
        }
    };
    STAMPX(F, 41);
    for (int c = 0; c < NCH; c += 2) { body(c, qA, vA, lA, obA, gwA); if (c == 6) STAMPX(F, 43); body(c + 1, qB, vB, lB, obB, gwB); if (c == 6) STAMPX(F, 44); }
    STAMPX(F, 42);
    if (MODE == 0) {
#pragma unroll
        for (int i = 0; i < 8; ++i) *(f32x4*)(SGp + (16 * w + fr) * 128 + 16 * i + 4 * fq) = s[i];
        if (ts == 0) *(float2*)((float*)(F.ws + WS_DG) + (size_t)slot_of(b, h, j, dir) * 128 + 2 * cp) = make_float2(__builtin_amdgcn_exp2f(dsum0), __builtin_amdgcn_exp2f(dsum1));
    }
    asm volatile("s_waitcnt vmcnt(0)" ::: "memory");
    __syncthreads();
}

template <int MODE>
__device__ __forceinline__ void pass_pipe(Frame& F, int b, int h, int j, int dir) {
    constexpr int SETB = 38400, oQT = 0, oKH = 8704, oKT = 17408, oVT = 27648, oDEC = 37888;
    constexpr int pPB = 76800, pST = 79360, pSEG = 114176, pOT = 122368;
    LAS unsigned char* L = F.lds + RING_OFF;
    int t_ = threadIdx.x; asm volatile("" : "+v"(t_));
    const int tid = t_, lane = t_ & 63, w = F.wave, fr = lane & 15, fq = lane >> 4, cp = lane, ts = w;
    const bf16* ZQ = (const bf16*)(F.ws + WS_ZQ); const bf16* ZV = (const bf16*)(F.ws + WS_ZV); const bf16* ZL = (const bf16*)(F.ws + (dir ? WS_ZLB : WS_ZLF));
    const bf16* SGp = (const bf16*)(F.ws + WS_SG + CARRY_OFF) + (size_t)slot_of(b, h, j, dir) * 16384;
    const int colq = h * 128 + 2 * cp;
    auto mrow = [&](int c, int r) -> size_t { const int pos = 32 * c + r; return (size_t)b * T + (dir ? (SCT * j + SCT - 1 - pos) : (SCT * j + pos)); };
    f32x4 s[8];
#pragma unroll
    for (int i = 0; i < 8; ++i) { const u32x2 pk = *(const u32x2*)(SGp + (16 * w + fr) * 128 + 16 * i + 4 * fq);
        s[i] = (f32x4){bflo(pk.x), bfhi(pk.x), bflo(pk.y), bfhi(pk.y)};
        *(LAS u32x2*)(L + pST + (16 * w + fr) * RS + (16 * i + 4 * fq) * 2) = pk; }
    f32x4 g0 = {0.f, 0.f, 0.f, 0.f}, g1 = {0.f, 0.f, 0.f, 0.f};
    if (MODE == 2) { g0 = *(const f32x4*)(FIN(12) + 8 * (tid & 15)); g1 = *(const f32x4*)(FIN(12) + 8 * (tid & 15) + 4); }
    unsigned qA[4], vA[4], lA[4], qB[4], vB[4], lB[4];
    v4u obA = {0u, 0u, 0u, 0u}, gwA = {0u, 0u, 0u, 0u}, obB = {0u, 0u, 0u, 0u}, gwB = {0u, 0u, 0u, 0u};
    auto issue = [&](int c, unsigned (&q)[4], unsigned (&v)[4], unsigned (&l)[4]) {
#pragma unroll
        for (int r = 0; r < 4; ++r) { const size_t m = mrow(c, 4 * ts + r); q[r] = *(const unsigned*)(ZQ + m * DH + colq); v[r] = *(const unsigned*)(ZV + m * DH + colq); l[r] = *(const unsigned*)(ZL + m * DH + colq); } };
    auto issue_comb = [&](int c, v4u& ob, v4u& gw) { const size_t m = mrow(c, tid >> 4); ob = *(const v4u*)((const bf16*)(F.ws + WS_OB) + m * DH + h * 128 + 8 * (tid & 15)); gw = *(const v4u*)((const bf16*)(F.ws + WS_ZG) + m * DH + h * 128 + 8 * (tid & 15)); };
    auto seg_write = [&](const unsigned (&l)[4], int sb) { float t0 = 0.f, t1 = 0.f;
#pragma unroll
        for (int r = 0; r < 4; ++r) { t0 += bflo(l[r]); t1 += bfhi(l[r]); }
        *(LAS f32x2*)(L + pSEG + sb * 4096 + (ts * 128 + 2 * cp) * 4) = (f32x2){t0, t1}; };
    auto prep = [&](const unsigned (&q)[4], const unsigned (&v)[4], const unsigned (&l)[4], int so, int sb) {
        float2 lc[4]; float cs0[4], cs1[4];
#pragma unroll
        for (int r = 0; r < 4; ++r) lc[r] = make_float2(bflo(l[r]), bfhi(l[r]));
        cs0[0] = lc[0].x; cs1[0] = lc[0].y;
#pragma unroll
        for (int r = 1; r < 4; ++r) { cs0[r] = cs0[r - 1] + lc[r].x; cs1[r] = cs1[r - 1] + lc[r].y; }
        float pre0 = 0.f, pre1 = 0.f, tot0 = 0.f, tot1 = 0.f;
#pragma unroll
        for (int t2 = 0; t2 < 8; ++t2) { const f32x2 sv = *(const LAS f32x2*)(L + pSEG + sb * 4096 + (t2 * 128 + 2 * cp) * 4); tot0 += sv.x; tot1 += sv.y; if (t2 < ts) { pre0 += sv.x; pre1 += sv.y; } }
        if (ts == 0) *(LAS f32x2*)(L + so + oDEC + 2 * cp * 4) = (f32x2){__builtin_amdgcn_exp2f(tot0), __builtin_amdgcn_exp2f(tot1)};
        float kta[4], ktb[4];
#pragma unroll
        for (int r = 0; r < 4; ++r) {
            const float b0 = pre0 + cs0[r], b1 = pre1 + cs1[r];
            const float q0 = bflo(q[r]), q1 = bfhi(q[r]);
            const float k0 = 1.0f - __builtin_amdgcn_exp2f(lc[r].x), k1 = 1.0f - __builtin_amdgcn_exp2f(lc[r].y);
            const int row = 4 * ts + r;
            *(LAS unsigned*)(L + so + oQT + row * RS + 4 * cp) = pg8::cvt_pk_bf16(q0 * __builtin_amdgcn_exp2f(b0), q1 * __builtin_amdgcn_exp2f(b1));
            *(LAS unsigned*)(L + so + oKH + row * RS + 4 * cp) = pg8::cvt_pk_bf16(k0 * __builtin_amdgcn_exp2f(fminf(-b0, 126.f)), k1 * __builtin_amdgcn_exp2f(fminf(-b1, 126.f)));
            kta[r] = k0 * __builtin_amdgcn_exp2f(tot0 - b0); ktb[r] = k1 * __builtin_amdgcn_exp2f(tot1 - b1);
        }
        *(LAS u32x2*)(L + so + oKT + (2 * cp) * TS + 8 * ts) = (u32x2){pg8::cvt_pk_bf16(kta[0], kta[1]), pg8::cvt_pk_bf16(kta[2], kta[3])};
        *(LAS u32x2*)(L + so + oKT + (2 * cp + 1) * TS + 8 * ts) = (u32x2){pg8::cvt_pk_bf16(ktb[0], ktb[1]), pg8::cvt_pk_bf16(ktb[2], ktb[3])};
        *(LAS u32x2*)(L + so + oVT + (2 * cp) * TS + 8 * ts) = (u32x2){(v[0] & 0xffffu) | (v[1] << 16), (v[2] & 0xffffu) | (v[3] << 16)};
        *(LAS u32x2*)(L + so + oVT + (2 * cp + 1) * TS + 8 * ts) = (u32x2){(v[0] >> 16) | (v[1] & 0xffff0000u), (v[2] >> 16) | (v[3] & 0xffff0000u)};
    };
    auto stage1 = [&](int so, f32x4 (&o)[2]) {
        f32x4 p = (f32x4){0.f, 0.f, 0.f, 0.f}; const int pmt = (w >> 1) & 1, pnt = w & 1;
#pragma unroll
        for (int ks = 0; ks < 4; ++ks) {
            const bf16x8 a0 = *(const LAS bf16x8*)(L + so + oQT + (fr) * RS + (32 * ks + 8 * fq) * 2), a1 = *(const LAS bf16x8*)(L + so + oQT + (16 + fr) * RS + (32 * ks + 8 * fq) * 2);
            const bf16x8 bs = *(const LAS bf16x8*)(L + pST + (16 * w + fr) * RS + (32 * ks + 8 * fq) * 2);
            o[0] = __builtin_amdgcn_mfma_f32_16x16x32_bf16(a0, bs, o[0], 0, 0, 0);
            o[1] = __builtin_amdgcn_mfma_f32_16x16x32_bf16(a1, bs, o[1], 0, 0, 0);
            if (w < 4) { const bf16x8 bk = *(const LAS bf16x8*)(L + so + oKH + (16 * pnt + fr) * RS + (32 * ks + 8 * fq) * 2);
                p = __builtin_amdgcn_mfma_f32_16x16x32_bf16(pmt ? a1 : a0, bk, p, 0, 0, 0); }
        }
        if (w < 4) {
#pragma unroll
            for (int rg = 0; rg < 4; ++rg) { const int t = 16 * pmt + 4 * fq + rg, sc = 16 * pnt + fr; const float pv = (sc <= t) ? p[rg] : 0.f;
                *(LAS unsigned short*)(L + pPB + t * TS + sc * 2) = (unsigned short)(pg8::cvt_pk_bf16(pv, 0.f) & 0xffffu); }
        }
    };
    auto stage2 = [&](int so, f32x4 (&o)[2]) {
        const bf16x8 bv = *(const LAS bf16x8*)(L + so + oVT + (16 * w + fr) * TS + 16 * fq);
#pragma unroll
        for (int mt = 0; mt < 2; ++mt) { const bf16x8 ap = *(const LAS bf16x8*)(L + pPB + (16 * mt + fr) * TS + 16 * fq);
            o[mt] = __builtin_amdgcn_mfma_f32_16x16x32_bf16(ap, bv, o[mt], 0, 0, 0);
#pragma unroll
            for (int rg = 0; rg < 4; ++rg) *(LAS float*)(L + pOT + ((16 * mt + 4 * fq + rg) * OTS + 16 * w + fr) * 4) = o[mt][rg]; }
#pragma unroll
        for (int i = 0; i < 8; ++i) {
            const f32x4 d4 = *(const LAS f32x4*)(L + so + oDEC + (16 * i + 4 * fq) * 4);
            const bf16x8 ak = *(const LAS bf16x8*)(L + so + oKT + (16 * i + fr) * TS + 16 * fq);
            s[i] = s[i] * d4;
            s[i] = __builtin_amdgcn_mfma_f32_16x16x32_bf16(ak, bv, s[i], 0, 0, 0);
            u32x2 pk; pk.x = pg8::cvt_pk_bf16(s[i][0], s[i][1]); pk.y = pg8::cvt_pk_bf16(s[i][2], s[i][3]);
            *(LAS u32x2*)(L + pST + (16 * w + fr) * RS + (16 * i + 4 * fq) * 2) = pk;
        }
    };
    auto combine = [&](int c, const v4u& obX, const v4u& gwX) {
        const int t = tid >> 4, vg = tid & 15; const size_t m = mrow(c, t);
        const f32x4 o0 = *(const LAS f32x4*)(L + pOT + (t * OTS + 8 * vg) * 4), o1 = *(const LAS f32x4*)(L + pOT + (t * OTS + 8 * vg + 4) * 4);
        if (MODE == 1) {
            v4u wv; wv.x = pg8::cvt_pk_bf16(o0[0], o0[1]); wv.y = pg8::cvt_pk_bf16(o0[2], o0[3]); wv.z = pg8::cvt_pk_bf16(o1[0], o1[1]); wv.w = pg8::cvt_pk_bf16(o1[2], o1[3]);
            *(v4u*)((bf16*)(F.ws + WS_OB) + m * DH + h * 128 + 8 * vg) = wv;
        } else {
            const v4u bw = obX, gwd = gwX;
            float ov[8] = {o0[0] + bflo(bw.x), o0[1] + bfhi(bw.x), o0[2] + bflo(bw.y), o0[3] + bfhi(bw.y), o1[0] + bflo(bw.z), o1[1] + bfhi(bw.z), o1[2] + bflo(bw.w), o1[3] + bfhi(bw.w)};
            float ss = 0.f;
#pragma unroll
            for (int q = 0; q < 8; ++q) ss += ov[q] * ov[q];
            ss += __builtin_bit_cast(float, __builtin_amdgcn_update_dpp(0, __builtin_bit_cast(int, ss), 0xB1, 0xF, 0xF, true));
            ss += __builtin_bit_cast(float, __builtin_amdgcn_update_dpp(0, __builtin_bit_cast(int, ss), 0x4E, 0xF, 0xF, true));
            ss += __builtin_bit_cast(float, __builtin_amdgcn_update_dpp(0, __builtin_bit_cast(int, ss), 0x141, 0xF, 0xF, true));
            ss += __builtin_bit_cast(float, __builtin_amdgcn_update_dpp(0, __builtin_bit_cast(int, ss), 0x140, 0xF, 0xF, true));
            const float rstd = __builtin_amdgcn_rsqf(ss * (1.f / 128.f) + EPS);
            const float gg[8] = {bflo(gwd.x), bfhi(gwd.x), bflo(gwd.y), bfhi(gwd.y), bflo(gwd.z), bfhi(gwd.z), bflo(gwd.w), bfhi(gwd.w)};
            v4u wv; wv.x = pg8::cvt_pk_bf16(ov[0] * rstd * g0[0] * gg[0], ov[1] * rstd * g0[1] * gg[1]); wv.y = pg8::cvt_pk_bf16(ov[2] * rstd * g0[2] * gg[2], ov[3] * rstd * g0[3] * gg[3]);
            wv.z = pg8::cvt_pk_bf16(ov[4] * rstd * g1[0] * gg[4], ov[5] * rstd * g1[1] * gg[5]); wv.w = pg8::cvt_pk_bf16(ov[6] * rstd * g1[2] * gg[6], ov[7] * rstd * g1[3] * gg[7]);
            *(v4u*)((bf16*)(F.ws + WS_XN) + m * D + h * 128 + 8 * vg) = wv;
        }
    };
    issue(0, qA, vA, lA); issue(1, qB, vB, lB);
    if (MODE == 2) { issue_comb(0, obA, gwA); issue_comb(1, obB, gwB); }
    seg_write(lA, 0); seg_write(lB, 1);
    __syncthreads();
    prep(qA, vA, lA, 0, 0); issue(2, qA, vA, lA);
    __syncthreads();
    auto step = [&](int c, int so, int sn, unsigned (&qX)[4], unsigned (&vX)[4], unsigned (&lX)[4], unsigned (&qY)[4], unsigned (&vY)[4], unsigned (&lY)[4], v4u& obP, v4u& gwP) {
        f32x4 o[2] = {(f32x4){0.f, 0.f, 0.f, 0.f}, (f32x4){0.f, 0.f, 0.f, 0.f}};
        stage1(so, o);
        if (c > 0) { combine(c - 1, obP, gwP); if (MODE == 2 && c + 1 < NCH) issue_comb(c + 1, obP, gwP); }
        if (c + 2 < NCH) seg_write(lX, c & 1);
        __syncthreads();
        stage2(so, o);
        if (c + 1 < NCH) { prep(qY, vY, lY, sn, (c + 1) & 1); if (c + 3 < NCH) issue(c + 3, qY, vY, lY); }
        __syncthreads();
    };
    for (int c = 0; c < NCH; c += 2) {
        step(c, 0, SETB, qA, vA, lA, qB, vB, lB, obB, gwB);
        step(c + 1, SETB, 0, qB, vB, lB, qA, vA, lA, obA, gwA);
    }
    combine(NCH - 1, obB, gwB);
    asm volatile("s_waitcnt vmcnt(0)" ::: "memory");
    __syncthreads();
}

__device__ __forceinline__ void pass0_direct(Frame& F, int b, int h, int j, int dir) {
    constexpr int KT2 = 0, VT2 = 34816, SEG2 = 69632;
    LAS unsigned char* L = F.lds + RING_OFF;
    const int lane = F.lane, w = F.wave, fr = lane & 15, fq = lane >> 4, cp = lane, ts = w;
    const bf16* ZV = (const bf16*)(F.ws + WS_ZV); const bf16* ZL = (const bf16*)(F.ws + (dir ? WS_ZLB : WS_ZLF));
    const int colq = h * 128 + 2 * cp;
    auto mrow = [&](int pos) -> size_t { return (size_t)b * T + (dir ? (SCT * j + SCT - 1 - pos) : (SCT * j + pos)); };
    f32x4 s[8];
#pragma unroll
    for (int i = 0; i < 8; ++i) s[i] = (f32x4){0.f, 0.f, 0.f, 0.f};
    float c0 = 0.f, c1 = 0.f;
    unsigned ln[16], vn[16];
#pragma unroll
    for (int r = 0; r < 16; ++r) { const size_t m = mrow(SCT - 128 + 16 * ts + r); ln[r] = *(const unsigned*)(ZL + m * DH + colq); vn[r] = *(const unsigned*)(ZV + m * DH + colq); }
    for (int blk = SCT / 128 - 1; blk >= 0; --blk) {
        float l0[16], l1[16]; unsigned vc[16];
#pragma unroll
        for (int r = 0; r < 16; ++r) { l0[r] = bflo(ln[r]); l1[r] = bfhi(ln[r]); vc[r] = vn[r]; }
        if (blk > 0) {
#pragma unroll
            for (int r = 0; r < 16; ++r) { const size_t m = mrow(128 * (blk - 1) + 16 * ts + r); ln[r] = *(const unsigned*)(ZL + m * DH + colq); vn[r] = *(const unsigned*)(ZV + m * DH + colq); }
        }
        float t0 = 0.f, t1 = 0.f;
#pragma unroll
        for (int r = 0; r < 16; ++r) { t0 += l0[r]; t1 += l1[r]; }
        *(LAS f32x2*)(L + SEG2 + (ts * 128 + 2 * cp) * 4) = (f32x2){t0, t1};
        __syncthreads();
        float a0 = c0, a1 = c1, tt0 = 0.f, tt1 = 0.f;
#pragma unroll
        for (int t2 = 0; t2 < 8; ++t2) { const f32x2 sv = *(const LAS f32x2*)(L + SEG2 + (t2 * 128 + 2 * cp) * 4); tt0 += sv.x; tt1 += sv.y; if (t2 > ts) { a0 += sv.x; a1 += sv.y; } }
        c0 += tt0; c1 += tt1;
        float k0v[16], k1v[16];
        float e0 = __builtin_amdgcn_exp2f(a0), e1 = __builtin_amdgcn_exp2f(a1);
#pragma unroll
        for (int r = 15; r >= 0; --r) {
            const float f0 = __builtin_amdgcn_exp2f(l0[r]), f1 = __builtin_amdgcn_exp2f(l1[r]);
            k0v[r] = (1.0f - f0) * e0; k1v[r] = (1.0f - f1) * e1;
            e0 *= f0; e1 *= f1; }
        v4u w0, w1;
#pragma unroll
        for (int hh = 0; hh < 2; ++hh) {
            w0.x = pg8::cvt_pk_bf16(k0v[8 * hh + 0], k0v[8 * hh + 1]); w0.y = pg8::cvt_pk_bf16(k0v[8 * hh + 2], k0v[8 * hh + 3]); w0.z = pg8::cvt_pk_bf16(k0v[8 * hh + 4], k0v[8 * hh + 5]); w0.w = pg8::cvt_pk_bf16(k0v[8 * hh + 6], k0v[8 * hh + 7]);
            w1.x = pg8::cvt_pk_bf16(k1v[8 * hh + 0], k1v[8 * hh + 1]); w1.y = pg8::cvt_pk_bf16(k1v[8 * hh + 2], k1v[8 * hh + 3]); w1.z = pg8::cvt_pk_bf16(k1v[8 * hh + 4], k1v[8 * hh + 5]); w1.w = pg8::cvt_pk_bf16(k1v[8 * hh + 6], k1v[8 * hh + 7]);
            *(LAS v4u*)(L + KT2 + (2 * cp) * RS + (16 * ts + 8 * hh) * 2) = w0; *(LAS v4u*)(L + KT2 + (2 * cp + 1) * RS + (16 * ts + 8 * hh) * 2) = w1;
            v4u x0, x1;
            x0.x = (vc[8 * hh + 0] & 0xffffu) | (vc[8 * hh + 1] << 16); x0.y = (vc[8 * hh + 2] & 0xffffu) | (vc[8 * hh + 3] << 16); x0.z = (vc[8 * hh + 4] & 0xffffu) | (vc[8 * hh + 5] << 16); x0.w = (vc[8 * hh + 6] & 0xffffu) | (vc[8 * hh + 7] << 16);
            x1.x = (vc[8 * hh + 0] >> 16) | (vc[8 * hh + 1] & 0xffff0000u); x1.y = (vc[8 * hh + 2] >> 16) | (vc[8 * hh + 3] & 0xffff0000u); x1.z = (vc[8 * hh + 4] >> 16) | (vc[8 * hh + 5] & 0xffff0000u); x1.w = (vc[8 * hh + 6] >> 16) | (vc[8 * hh + 7] & 0xffff0000u);
            *(LAS v4u*)(L + VT2 + (2 * cp) * RS + (16 * ts + 8 * hh) * 2) = x0; *(LAS v4u*)(L + VT2 + (2 * cp + 1) * RS + (16 * ts + 8 * hh) * 2) = x1;
        }
        __syncthreads();
#pragma unroll
        for (int ks = 0; ks < 4; ++ks) {
            const bf16x8 bv = *(const LAS bf16x8*)(L + VT2 + (16 * w + fr) * RS + (32 * ks + 8 * fq) * 2);
#pragma unroll
            for (int i = 0; i < 8; ++i) { const bf16x8 ak = *(const LAS bf16x8*)(L + KT2 + (16 * i + fr) * RS + (32 * ks + 8 * fq) * 2);
                s[i] = __builtin_amdgcn_mfma_f32_16x16x32_bf16(ak, bv, s[i], 0, 0, 0); }
        }
        __syncthreads();
    }
    bf16* SGp = (bf16*)(F.ws + WS_SG) + (size_t)slot_of(b, h, j, dir) * 16384;
#pragma unroll
    for (int i = 0; i < 8; ++i) *(u32x2*)(SGp + (16 * w + fr) * 128 + 16 * i + 4 * fq) = (u32x2){pg8::cvt_pk_bf16(s[i][0], s[i][1]), pg8::cvt_pk_bf16(s[i][2], s[i][3])};
    if (ts == 0) *(float2*)((float*)(F.ws + WS_DG) + (size_t)slot_of(b, h, j, dir) * 128 + 2 * cp) = make_float2(__builtin_amdgcn_exp2f(c0), __builtin_amdgcn_exp2f(c1));
    asm volatile("s_waitcnt vmcnt(0)" ::: "memory");
    __syncthreads();
}
__device__ __forceinline__ void pass2(Frame& F) {
    const unsigned* SU = (const unsigned*)(F.ws + WS_SG); unsigned* SC = (unsigned*)(F.ws + WS_SG + CARRY_OFF); const float* DG = (const float*)(F.ws + WS_DG);
    const int gt = F.bid * (NWAVES * 64) + F.tid, NT = F.G * NWAVES * 64;
    for (int i = gt; i < 16 * 8192; i += NT) {
        const int chain = i >> 13, e2 = i & 8191, dir = chain & 1, bh = chain >> 1, k0 = (2 * e2) & 127;
        f32x2 carry = (f32x2){0.f, 0.f};
        for (int st0 = 0; st0 < NSC; st0 += 16) {
            unsigned u[16]; f32x2 d[16];
#pragma unroll
            for (int q = 0; q < 16; ++q) { const int jj = dir ? NSC - 1 - (st0 + q) : (st0 + q); const size_t sl = (size_t)((bh * NSC + jj) * 2 + dir);
                u[q] = SU[sl * 8192 + e2]; d[q] = *(const f32x2*)(DG + sl * 128 + k0); }
#pragma unroll
            for (int q = 0; q < 16; ++q) { const int jj = dir ? NSC - 1 - (st0 + q) : (st0 + q); const size_t sl = (size_t)((bh * NSC + jj) * 2 + dir);
                SC[sl * 8192 + e2] = pg8::cvt_pk_bf16(carry.x, carry.y); carry = d[q] * carry + (f32x2){bflo(u[q]), bfhi(u[q])}; }
        }
    }
}
}
namespace rg {
#ifndef FIX_BATCH
#define FIX_BATCH 8
#endif
typedef short bf16x8 __attribute__((ext_vector_type(8)));
constexpr int XCS = 144, XCB = 256 * XCS + 256;
constexpr int OUTT = 2 * XCB, OTS = 272;
constexpr size_t WS_CIN = WS_DG + 512 * 1024;
constexpr size_t WS_RGSUB = 496 * MiB;

template <int DIR>
__device__ __forceinline__ void group_prefix(float Ag, float Hg, float& EA, float& EH, float& TA, float& TH, int lane) {
    const int g = lane >> 4; EA = 1.f; EH = 0.f;
#pragma unroll
    for (int rnd = 1; rnd < 4; ++rnd) {
        const float ca = Ag * EA, chh = Ag * EH + Hg;
        const float na = DIR == 0 ? __shfl_up(ca, 16) : __shfl_down(ca, 16), nh = DIR == 0 ? __shfl_up(chh, 16) : __shfl_down(chh, 16);
        const bool take = DIR == 0 ? (g == rnd) : (g == 3 - rnd);
        EA = take ? na : EA; EH = take ? nh : EH;
    }
    const int last = DIR == 0 ? 48 + (lane & 15) : (lane & 15);
    TA = __shfl(Ag * EA, last); TH = __shfl(Ag * EH + Hg, last);
}
template <int PASS>
__device__ __forceinline__ void item(Frame& F, int b, int j, int bp) {
    LAS unsigned char* L = F.lds + RING_OFF;
    const int tid = F.tid, lane = F.lane, w = F.wave, fr = lane & 15, fq = lane >> 4;
    const bf16* ZRX = (const bf16*)(F.ws + WS_ZRX);
    const int t0 = 256 * j;
    STAMPX(F, 30);
    const int blk = 2 * bp + (w >> 2), nt = w & 3, e = 16 * nt + fr, ch = 64 * blk + e, ss = 4 * j + fq;
    const bf16* RGW = (const bf16*)(F.ws + WS_RGW);
    const float* CL = (const float*)(F.ws + WS_RGCL);
    float2* TOT = (float2*)(F.ws + WS_RGSUB); float2* TSEG = (float2*)(F.ws + WS_RGTOT); const float* CIN = (const float*)(F.ws + WS_CIN);
    bf16x8 wa_[2][2], wx_[2][2]; float ba_[2], bx_[2], cl_[2]; float2 mine_[2] = {make_float2(1.f, 0.f), make_float2(1.f, 0.f)}; float cseg_[2] = {0.f, 0.f};
#pragma unroll
    for (int dir = 0; dir < 2; ++dir) {
#pragma unroll
        for (int ks = 0; ks < 2; ++ks) { wa_[dir][ks] = *(const bf16x8*)(RGW + (size_t)(((2 * dir) * 8 + blk) * 64 + e) * 64 + 32 * ks + 8 * fq); wx_[dir][ks] = *(const bf16x8*)(RGW + (size_t)(((2 * dir + 1) * 8 + blk) * 64 + e) * 64 + 32 * ks + 8 * fq); }
        ba_[dir] = (dir ? FIN(21) : FIN(16))[ch] * -1.44269504f; bx_[dir] = (dir ? FIN(23) : FIN(18))[ch] * -1.44269504f; cl_[dir] = CL[dir * DH + ch];
        if (PASS == 1) { mine_[dir] = TOT[(size_t)((b * 256 + ss) * 2 + dir) * DH + ch]; cseg_[dir] = CIN[(size_t)((b * 64 + j) * 2 + dir) * DH + ch]; }
    }
    v4u gt[8];
    if (PASS == 1) { const bf16* ZRG = (const bf16*)(F.ws + WS_ZRG);
#pragma unroll
        for (int q = 0; q < 8; ++q) { const int c16 = tid + 512 * q, tt = c16 >> 4, cc = c16 & 15; gt[q] = *(const v4u*)(ZRG + ((size_t)b * T + t0 + tt) * DH + 128 * bp + 8 * cc); } }
    {
        const int cp = lane, tg = w, cg = 128 * bp + 2 * cp;
        const float* cw = FIN(13); const float* cbp = FIN(14);
        const int tb = t0 + 32 * tg;
        unsigned x[35];
#pragma unroll
        for (int q = 0; q < 35; ++q) { const int t = tb + q - 2, tc = t < 0 ? 0 : (t >= T ? T - 1 : t); x[q] = *(const unsigned*)(ZRX + ((size_t)b * T + tc) * DH + cg); }
#pragma unroll
        for (int q = 0; q < 35; ++q) { const int t = tb + q - 2; x[q] = (t >= 0 && t < T) ? x[q] : 0u; }
        const float w00 = cw[cg], w01 = cw[cg + 1], w10 = cw[DH + cg], w11 = cw[DH + cg + 1], w20 = cw[2 * DH + cg], w21 = cw[2 * DH + cg + 1], w30 = cw[3 * DH + cg], w31 = cw[3 * DH + cg + 1], cb0 = cbp[cg], cb1 = cbp[cg + 1];
        LAS unsigned char* dst = L + (cp >> 5) * XCB + (32 * tg) * XCS + 64 * (tg >> 1) + 4 * (cp & 31);
#pragma unroll
        for (int q = 0; q < 32; ++q) {
            const float y0 = cb0 + w00 * bflo(x[q]) + w10 * bflo(x[q + 1]) + w20 * bflo(x[q + 2]) + w30 * bflo(x[q + 3]);
            const float y1 = cb1 + w01 * bfhi(x[q]) + w11 * bfhi(x[q + 1]) + w21 * bfhi(x[q + 2]) + w31 * bfhi(x[q + 3]);
            *(LAS unsigned*)(dst + q * XCS) = pg8::cvt_pk_bf16(y0, y1);
        }
    }
    __syncthreads();
    STAMPX(F, 31);
    const LAS unsigned char* XA = L + (w >> 2) * XCB + (64 * (fr >> 2) + (fr & 3)) * XCS + 64 * (fr >> 2) + 16 * fq;
    bf16x8 idf[2];
#pragma unroll
    for (int ks = 0; ks < 2; ++ks)
#pragma unroll
        for (int q = 0; q < 8; ++q) idf[ks][q] = (32 * ks + 8 * fq + q == e) ? (short)0x3F80 : (short)0;
#pragma unroll
    for (int dir = 0; dir < 2; ++dir) {
        const bf16x8 wa[2] = {wa_[dir][0], wa_[dir][1]}, wx[2] = {wx_[dir][0], wx_[dir][1]}; const float ba = ba_[dir], bx = bx_[dir], cl = cl_[dir];
        float carry = 0.f, atot = 1.f;
        if (PASS == 1) {
            const float2 mine = mine_[dir]; const float cseg = cseg_[dir];
            float EA, EH, TA, TH;
            if (dir == 0) group_prefix<0>(mine.x, mine.y, EA, EH, TA, TH, lane); else group_prefix<1>(mine.x, mine.y, EA, EH, TA, TH, lane);
            carry = EA * cseg + EH;
        }
        LAS unsigned char* const ot = L + OUTT + (64 * fq) * OTS + 64 * fq + 128 * (w >> 2) + 2 * e;
        const __amdgpu_buffer_rsrc_t locr = __builtin_amdgcn_make_buffer_rsrc((void*)((unsigned*)F.out + (size_t)dir * ((size_t)M * DH)), (short)0, (int)(M * DH * 4), 0x00020000);
        const unsigned locv = (unsigned)((((size_t)b * T + t0 + 64 * fq) * DH + ch) * 4);
#pragma unroll 2
        for (int mi = 0; mi < 16; ++mi) {
            const int mt = dir ? 15 - mi : mi;
            const bf16x8 a0 = *(const LAS bf16x8*)(XA + (4 * mt) * XCS), a1 = *(const LAS bf16x8*)(XA + (4 * mt) * XCS + 64);
            f32x4 cr = {ba, ba, ba, ba}, ci = {bx, bx, bx, bx}, cx = {0.f, 0.f, 0.f, 0.f};
            cr = __builtin_amdgcn_mfma_f32_16x16x32_bf16(a0, wa[0], cr, 0, 0, 0); cr = __builtin_amdgcn_mfma_f32_16x16x32_bf16(a1, wa[1], cr, 0, 0, 0);
            ci = __builtin_amdgcn_mfma_f32_16x16x32_bf16(a0, wx[0], ci, 0, 0, 0); ci = __builtin_amdgcn_mfma_f32_16x16x32_bf16(a1, wx[1], ci, 0, 0, 0);
            cx = __builtin_amdgcn_mfma_f32_16x16x32_bf16(a0, idf[0], cx, 0, 0, 0); cx = __builtin_amdgcn_mfma_f32_16x16x32_bf16(a1, idf[1], cx, 0, 0, 0);
            float hv[4];
#pragma unroll
            for (int q = 0; q < 4; ++q) {
                const int r = dir ? 3 - q : q;
                const float rr = __builtin_amdgcn_rcpf(1.0f + __builtin_amdgcn_exp2f(cr[r])), ii = __builtin_amdgcn_rcpf(1.0f + __builtin_amdgcn_exp2f(ci[r])), l2a = cl * rr;
                const float av = __builtin_amdgcn_exp2f(l2a), uv = __builtin_amdgcn_sqrtf(__builtin_fmaf(-av, av, 1.0f)) * ii * cx[r];
                carry = av * carry + uv; atot *= av; hv[r] = carry;
                if (PASS == 0) __builtin_amdgcn_raw_buffer_store_b32(pg8::cvt_pk_bf16(carry, atot), locr, locv + (unsigned)(r * DH * 4), (unsigned)(mt * 4 * DH * 4), 0);
            }
            if (PASS == 1) {
#pragma unroll
                for (int r = 0; r < 4; ++r) { LAS unsigned short* p = (LAS unsigned short*)(ot + (4 * mt + r) * OTS);
                    const float hsum = dir == 0 ? hv[r] : hv[r] + bf2f(*p);
                    *p = (unsigned short)(pg8::cvt_pk_bf16(hsum, 0.f) & 0xffffu); }
            }
        }
        if (PASS == 0) {
            TOT[(size_t)((b * 256 + ss) * 2 + dir) * DH + ch] = make_float2(atot, carry);
            float EA, EH, TA, TH;
            if (dir == 0) group_prefix<0>(atot, carry, EA, EH, TA, TH, lane); else group_prefix<1>(atot, carry, EA, EH, TA, TH, lane);
            if (fq == 0) TSEG[(size_t)((b * 64 + j) * 2 + dir) * DH + ch] = make_float2(TA, TH);
        }
    }
    STAMPX(F, 32);
    __syncthreads();
    STAMPX(F, 33);
    if (PASS == 1) {
        bf16* YM = (bf16*)(F.ws + WS_XN);
#pragma unroll
        for (int q = 0; q < 8; ++q) { const int c16 = tid + 512 * q, tt = c16 >> 4, cc = c16 & 15;
            const v4u hw = *(const LAS v4u*)(L + OUTT + tt * OTS + 64 * (tt >> 6) + 16 * cc);
            v4u o; o.x = pg8::cvt_pk_bf16(bflo(hw.x) * bflo(gt[q].x), bfhi(hw.x) * bfhi(gt[q].x)); o.y = pg8::cvt_pk_bf16(bflo(hw.y) * bflo(gt[q].y), bfhi(hw.y) * bfhi(gt[q].y));
            o.z = pg8::cvt_pk_bf16(bflo(hw.z) * bflo(gt[q].z), bfhi(hw.z) * bfhi(gt[q].z)); o.w = pg8::cvt_pk_bf16(bflo(hw.w) * bflo(gt[q].w), bfhi(hw.w) * bfhi(gt[q].w));
            *(v4u*)(YM + ((size_t)b * T + t0 + tt) * D + DH + 128 * bp + 8 * cc) = o; }
        __syncthreads();
    }
    STAMPX(F, 34);
}
__device__ __forceinline__ void fix(Frame& F, int b, int j, int bp) {
    LAS float* CAR = (LAS float*)(F.lds + RING_OFF);
    int t_ = threadIdx.x; asm volatile("" : "+v"(t_));
    const int tid = t_, t0 = 256 * j;
    const float2* TOT = (const float2*)(F.ws + WS_RGSUB); const float* CIN = (const float*)(F.ws + WS_CIN);
    const unsigned* L0 = (const unsigned*)F.out; const unsigned* L1 = L0 + (size_t)M * DH;
    const bf16* ZRG = (const bf16*)(F.ws + WS_ZRG); bf16* YM = (bf16*)(F.ws + WS_XN);
    constexpr int NB = FIX_BATCH;
    v4u lf[NB][2], lb[NB][2], gt[NB];
    auto issue = [&](int hb) {
#pragma unroll
        for (int q = 0; q < NB; ++q) { const int p = tid + 512 * (NB * hb + q), tt = p >> 4, cc = p & 15; const size_t m = (size_t)b * T + t0 + tt;
            const v4u* pf = (const v4u*)(L0 + m * DH + 128 * bp + 8 * cc); const v4u* pb = (const v4u*)(L1 + m * DH + 128 * bp + 8 * cc);
            lf[q][0] = pf[0]; lf[q][1] = pf[1]; lb[q][0] = pb[0]; lb[q][1] = pb[1]; gt[q] = *(const v4u*)(ZRG + m * DH + 128 * bp + 8 * cc); } };
    issue(0);
    if (tid < 256) { const int dir = tid >> 7, c = tid & 127, ch = 128 * bp + c;
        float2 tt[4];
#pragma unroll
        for (int g = 0; g < 4; ++g) tt[g] = TOT[(size_t)((b * 256 + 4 * j + g) * 2 + dir) * DH + ch];
        float cv = CIN[(size_t)((b * 64 + j) * 2 + dir) * DH + ch];
#pragma unroll
        for (int q = 0; q < 4; ++q) { const int g = dir ? 3 - q : q; CAR[(dir * 4 + g) * 128 + c] = cv; cv = tt[g].x * cv + tt[g].y; }
    }
    __syncthreads();
#pragma unroll
    for (int hb = 0; hb < 8 / NB; ++hb) {
        if (hb > 0) issue(hb);
#pragma unroll
        for (int q = 0; q < NB; ++q) { const int p = tid + 512 * (NB * hb + q), tt = p >> 4, cc = p & 15, g = tt >> 6; const size_t m = (size_t)b * T + t0 + tt;
            const f32x4 cf0 = *(const LAS f32x4*)(CAR + (0 * 4 + g) * 128 + 8 * cc), cf1 = *(const LAS f32x4*)(CAR + (0 * 4 + g) * 128 + 8 * cc + 4);
            const f32x4 cb0 = *(const LAS f32x4*)(CAR + (1 * 4 + g) * 128 + 8 * cc), cb1 = *(const LAS f32x4*)(CAR + (1 * 4 + g) * 128 + 8 * cc + 4);
            const unsigned uf[8] = {lf[q][0].x, lf[q][0].y, lf[q][0].z, lf[q][0].w, lf[q][1].x, lf[q][1].y, lf[q][1].z, lf[q][1].w};
            const unsigned ub[8] = {lb[q][0].x, lb[q][0].y, lb[q][0].z, lb[q][0].w, lb[q][1].x, lb[q][1].y, lb[q][1].z, lb[q][1].w};
            const float cf[8] = {cf0[0], cf0[1], cf0[2], cf0[3], cf1[0], cf1[1], cf1[2], cf1[3]}, cb[8] = {cb0[0], cb0[1], cb0[2], cb0[3], cb1[0], cb1[1], cb1[2], cb1[3]};
            const float gg[8] = {bflo(gt[q].x), bfhi(gt[q].x), bflo(gt[q].y), bfhi(gt[q].y), bflo(gt[q].z), bfhi(gt[q].z), bflo(gt[q].w), bfhi(gt[q].w)};
            float o[8];
#pragma unroll
            for (int k = 0; k < 8; ++k) o[k] = ((bflo(uf[k]) + bfhi(uf[k]) * cf[k]) + (bflo(ub[k]) + bfhi(ub[k]) * cb[k])) * gg[k];
            v4u w; w.x = pg8::cvt_pk_bf16(o[0], o[1]); w.y = pg8::cvt_pk_bf16(o[2], o[3]); w.z = pg8::cvt_pk_bf16(o[4], o[5]); w.w = pg8::cvt_pk_bf16(o[6], o[7]);
            *(v4u*)(YM + m * D + DH + 128 * bp + 8 * cc) = w; }
    }
    __syncthreads();
}
__device__ __forceinline__ void pass2(Frame& F) {
    const float2* TOT = (const float2*)(F.ws + WS_RGTOT); float* CIN = (float*)(F.ws + WS_CIN);
    const int gt = (F.G - 1 - F.bid) * (NWAVES * 64) + F.tid;
    if (gt < 4 * 2 * 2 * DH) {
        const int part = gt & 3, chn = gt >> 2, ch = chn & (DH - 1), dir = (chn >> 9) & 1, b = chn >> 10, lane = F.tid & 63;
        float2 tt[16];
#pragma unroll
        for (int q = 0; q < 16; ++q) { const int s = 16 * part + q, jj = dir ? 63 - s : s; tt[q] = TOT[(size_t)((b * 64 + jj) * 2 + dir) * DH + ch]; }
        float A = 1.f, H = 0.f;
#pragma unroll
        for (int q = 0; q < 16; ++q) { H = tt[q].x * H + tt[q].y; A *= tt[q].x; }
        float c = 0.f;
#pragma unroll
        for (int p = 0; p < 3; ++p) { const float Ap = __shfl(A, (lane & ~3) + p), Hp = __shfl(H, (lane & ~3) + p); if (p < part) c = Ap * c + Hp; }
        float h = c;
#pragma unroll
        for (int q = 0; q < 16; ++q) { const int s = 16 * part + q, jj = dir ? 63 - s : s; CIN[(size_t)((b * 64 + jj) * 2 + dir) * DH + ch] = h; h = tt[q].x * h + tt[q].y; }
    }
}
}
#ifndef REP_A
#define REP_A 1
#endif
#ifndef REP_N
#define REP_N 1
#endif
#ifndef REP_IN
#define REP_IN 1
#endif
#ifndef REP_UP
#define REP_UP 1
#endif
#ifndef S1_START
#define S1_START 0
#endif
#ifndef S1_LIMIT
#define S1_LIMIT (512 * REP_H0 + 512 * REP_R0)
#endif
#ifndef REP_S1
#define REP_S1 1
#endif
#ifndef REP_H0
#define REP_H0 1
#endif
#ifndef REP_R0
#define REP_R0 1
#endif
#ifndef REP_H3
#define REP_H3 1
#endif
#ifndef REP_R3
#define REP_R3 1
#endif
#ifndef REP_S2
#define REP_S2 1
#endif
#ifndef REP_S3
#define REP_S3 1
#endif
#ifndef REP_BAR
#define REP_BAR 0
#endif
struct Args { const float* in[31]; float* out; unsigned char* ws; };
__global__ void __launch_bounds__(NWAVES * 64, 2) hymba_fwd(Args args) {
    extern __shared__ __attribute__((aligned(16))) unsigned char lds[];
    Frame F;
    F.lds = (LAS unsigned char*)lds;
    F.MISC = (volatile LAS unsigned*)(F.lds + MISC_OFF);
    F.tid = threadIdx.x; F.lane = F.tid & 63; F.wave = __builtin_amdgcn_readfirstlane(F.tid >> 6);
    F.G = gridDim.x; F.bid = blockIdx.x;
    F.ka = (const __attribute__((address_space(4))) unsigned long long*)__builtin_amdgcn_kernarg_segment_ptr();
    F.out = args.out; F.ws = args.ws;
    F.ctl = (gu32*)(F.ws + WS_CTL);
    for (int u = F.tid; u < (LDS_BYTES - LDSCTL_OFF) / 4; u += NWAVES * 64) ((LAS unsigned*)(F.lds + LDSCTL_OFF))[u] = 0u;
    __syncthreads();
    int n_stamp = 0;
    XcdBarrier bar = xcd_barrier_post((unsigned*)(F.ctl + CW_BAR), F.MISC + 8);
#define REFRESH() do { int t_ = threadIdx.x; asm volatile("" : "+v"(t_)); F.tid = t_; F.lane = t_ & 63; } while (0)
#ifndef STAMP_SCALE
#define STAMP_SCALE 0.05f
#endif
#ifdef STAMP_A
#define STAMP() do { if (blockIdx.x == 0 && threadIdx.x == 0) { ((unsigned long long*)(F.ws + WS_CTL + 768 * 1024))[n_stamp] = __builtin_amdgcn_s_memrealtime(); } ++n_stamp; } while (0)
#else
#define STAMP() do { } while (0)
#endif
#if defined(STAMP_A) && defined(STAMP_PB)
#define PB_STAMP(id) do { if (STAMP_PB == (id) && threadIdx.x == 0) ((unsigned long long*)(F.ws + WS_CTL + 768 * 1024))[64 + blockIdx.x] = __builtin_amdgcn_s_memrealtime(); } while (0)
#else
#define PB_STAMP(id) do { } while (0)
#endif
#define GRID_BAR() do { PB_STAMP(n_stamp); xcd_barrier(bar); REFRESH(); STAMP(); } while (0)
    STAMP();
    unsigned char* ws = F.ws;
    const float* MOD = (const float*)(ws + WS_MOD);
    bf16* XN = (bf16*)(ws + WS_XN); bf16* HB = (bf16*)(ws + WS_HB); bf16* XB = (bf16*)(ws + WS_XB);

    for (int rep = 0; rep < REP_A; ++rep) { p0a(F); __syncthreads(); } GRID_BAR();
    for (int rep = 0; rep < REP_BAR; ++rep) GRID_BAR();
    for (int rep = 0; rep < REP_N; ++rep) p0b(F); GRID_BAR();
    { pg8::Gemm g{XB, (const bf16*)(ws + WS_W13A), M, 2 * FF, D, W13_COPY}; pg8::StaticOrder S; S.init(M, 2 * FF, F.G, F.bid);
      pg8::EpiSwiGLU E{HB, FF, (const float*)(ws + WS_SSQ1), (const float*)(ws + WS_BIAS1), 2 * FF, T};
      for (int rep = 0; rep < REP_UP; ++rep) pg8::gemm_phase<pg8::EpiSwiGLU, pg8::StaticOrder, true, true>(F.lds + RING_OFF, g, S, E); GRID_BAR(); }
    { pg8::Gemm g{HB, (const bf16*)(ws + WS_W2A), M, D, FF, 0}; pg8::StaticOrder S; S.init(M, D, F.G, F.bid);
      pg8::EpiResid<false, 1, false, false> E{XB, XB, MOD + 2 * D, nullptr, nullptr, (float*)(ws + WS_SSQ2)};
      pg8::gemm_phase<pg8::EpiResid<false, 1, false, false>, pg8::StaticOrder, true, true>(F.lds + RING_OFF, g, S, E); GRID_BAR(); }
    { pg8::Gemm g{XB, (const bf16*)(ws + WS_WIN), M, NIN, D, WIN_COPY}; pg8::StaticOrder S; S.init(M, NIN, F.G, F.bid);
      pg8::EpiInProj E{(bf16*)(ws + WS_ZQ), (bf16*)(ws + WS_ZV), (bf16*)(ws + WS_ZG), (bf16*)(ws + WS_ZRX), (bf16*)(ws + WS_ZRG), (bf16*)(ws + WS_ZLF), (bf16*)(ws + WS_ZLB), (const float*)(ws + WS_LBF), (const float*)(ws + WS_LBB),
                       (const float*)(ws + WS_SSQ2), (const float*)(ws + WS_BIAS2), NIN, T};
      for (int rep = 0; rep < REP_IN; ++rep) pg8::gemm_phase<pg8::EpiInProj, pg8::StaticOrder, true, true>(F.lds + RING_OFF, g, S, E); GRID_BAR(); }
    {
        gu32* ctr = F.ctl + CW_QUEUE;
        for (;;) {
            if (F.tid == 0) F.MISC[16] = __hip_atomic_fetch_add(ctr, 1u, __ATOMIC_RELAXED, __HIP_MEMORY_SCOPE_AGENT);
            __syncthreads(); const int it = (int)F.MISC[16] + S1_START; __syncthreads();
            if (it >= S1_LIMIT) break;
            if (it < 512 * REP_H0) { const int i2 = it & 511; hg::pass0_direct(F, i2 >> 8, (i2 >> 6) & 3, (i2 >> 1) & 31, i2 & 1); }
            else { const int r = (it - 512 * REP_H0) & 511; rg::item<0>(F, r >> 8, (r >> 2) & 63, r & 3); }
        }
    }
    GRID_BAR();
    for (int rep = 0; rep < REP_S2; ++rep) { hg::pass2(F); rg::pass2(F); }
    GRID_BAR();
    {
        const int cls = (F.bid >> 3) & 7, idx = ((F.bid >> 6) << 3) | (F.bid & 7);
        { const int first = 2 * (cls * 32 + idx), n = cls < 2 ? 2 : 0;
#pragma unroll 1
          for (int q2 = 0; q2 < n; ++q2) { const int it = first + q2; rg::fix(F, it >> 8, (it >> 2) & 63, it & 3); } }
        for (int it = F.bid; it < 8 * hg::NSC; it += F.G) { const int b = it >> 7, h = (it >> 5) & 3, j = it & 31;
            hg::pass_pipe<1>(F, b, h, j, 1);
            { const int first = 128 + 2 * ((cls - 2) * 32 + idx), n = (cls >= 2 && cls < 5) ? 2 : 0;
#pragma unroll 1
              for (int q2 = 0; q2 < n; ++q2) { const int it2 = first + q2; rg::fix(F, it2 >> 8, (it2 >> 2) & 63, it2 & 3); } }
            hg::pass_pipe<2>(F, b, h, j, 0); }
        gu32* ctr = F.ctl + CW_QUEUE + 64;
        for (;;) {
            if (F.tid == 0) F.MISC[16] = __hip_atomic_fetch_add(ctr, 1u, __ATOMIC_RELAXED, __HIP_MEMORY_SCOPE_AGENT);
            __syncthreads(); const int it = 320 + (int)F.MISC[16]; __syncthreads();
            if (it >= 512) break;
            rg::fix(F, it >> 8, (it >> 2) & 63, it & 3);
        }
    }
    GRID_BAR();
    { pg8::Gemm g{XN, (const bf16*)(ws + WS_WOUT), M, D, D, 0}; pg8::StaticOrder S; S.init(M, D, F.G, F.bid);
      pg8::EpiResid<false, 2, false, false> E{XB, XB, MOD + 5 * D, nullptr, nullptr, (float*)(ws + WS_SSQ3)};
      pg8::gemm_phase<pg8::EpiResid<false, 2, false, false>, pg8::StaticOrder, true, true>(F.lds + RING_OFF, g, S, E); GRID_BAR(); }
    { pg8::Gemm g{XB, (const bf16*)(ws + WS_W13B), M, 2 * FF, D, W13_COPY}; pg8::StaticOrder S; S.init(M, 2 * FF, F.G, F.bid);
      pg8::EpiSwiGLU E{HB, FF, (const float*)(ws + WS_SSQ3), (const float*)(ws + WS_BIAS3), 2 * FF, T};
      pg8::gemm_phase<pg8::EpiSwiGLU, pg8::StaticOrder, true, true>(F.lds + RING_OFF, g, S, E); GRID_BAR(); }
    { pg8::Gemm g{HB, (const bf16*)(ws + WS_W2B), M, D, FF, 0}; pg8::StaticOrder S; S.init(M, D, F.G, F.bid);
      pg8::EpiFinal E{XB, F.out, MOD + 8 * D, FIN(30), (float*)(ws + WS_SSQ4), (unsigned*)(ws + WS_CTL) + CW_FIN};
      pg8::gemm_phase<pg8::EpiFinal, pg8::StaticOrder, true, true>(F.lds + RING_OFF, g, S, E); }
#ifdef STAMP_A
    GRID_BAR();
    if (blockIdx.x == 0 && threadIdx.x == 0) { asm volatile("s_waitcnt vmcnt(0)" ::: "memory"); const unsigned long long* tsp = (const unsigned long long*)(F.ws + WS_CTL + 768 * 1024);
#if STAMP_B == 999
        long long mx = 0; for (int q = 0; q < 256; ++q) { const long long d = (long long)(tsp[64 + q] - tsp[STAMP_A]); mx = d > mx ? d : mx; } F.out[0] = 0.0005f * (float)mx; }
#elif STAMP_B == 970
        F.out[0] = 0.01f * STAMP_SCALE * (float)(long long)((tsp[4] - tsp[3]) + (tsp[9] - tsp[8]) + (tsp[11] - tsp[10])); }
#elif STAMP_B == 996
        unsigned long long mx = 0; for (int q = 0; q < 256; ++q) { mx = tsp[64 + q] > mx ? tsp[64 + q] : mx; } F.out[0] = 0.0005f * (float)(long long)(tsp[6] - mx); }
#elif STAMP_B == 995
        int msk = 0; const long long d0 = (long long)(tsp[64] - tsp[STAMP_A]); for (int q = 0; q < 256; ++q) { const long long d = (long long)(tsp[64 + q] - tsp[STAMP_A]); if (5 * d > 6 * d0) msk |= 1 << (q & 7); } F.out[0] = 0.05f * (float)msk; }
#elif STAMP_B == 994
        long long mn = 1ll << 40; for (int q = 0; q < 256; ++q) { const long long d = (long long)(tsp[64 + q] - tsp[STAMP_A]); mn = d < mn ? d : mn; } F.out[0] = 0.0005f * (float)mn; }
#elif STAMP_B == 993
        long long mx = 0; for (int q = 0; q < 256; ++q) { if ((q & 7) == 6) continue; const long long d = (long long)(tsp[64 + q] - tsp[STAMP_A]); mx = d > mx ? d : mx; } F.out[0] = 0.0005f * (float)mx; }
#elif STAMP_B >= 980 && STAMP_B < 988
        long long mx = 0; for (int q = 0; q < 256; ++q) { if ((q & 7) != STAMP_B - 980) continue; const long long d = (long long)(tsp[64 + q] - tsp[STAMP_A]); mx = d > mx ? d : mx; } F.out[0] = 0.01f * STAMP_SCALE * (float)mx; }
#elif STAMP_B == 998
        long long mx = 0; int am = 0; for (int q = 0; q < 256; ++q) { const long long d = (long long)(tsp[64 + q] - tsp[STAMP_A]); if (d > mx) { mx = d; am = q; } } F.out[0] = 0.1f * (float)am; }
#elif STAMP_B == 997
        int cnt = 0; const long long d0 = (long long)(tsp[64] - tsp[STAMP_A]); for (int q = 0; q < 256; ++q) { const long long d = (long long)(tsp[64 + q] - tsp[STAMP_A]); if (5 * d > 6 * d0) ++cnt; } F.out[0] = 0.1f * (float)cnt; }
#else
        F.out[0] = 0.01f * STAMP_SCALE * (float)(long long)(tsp[STAMP_B] - tsp[STAMP_A]); }
#endif
#endif
}

extern "C" void kernel_launch(void* const* d_in, const int* in_sizes, int n_in, void* d_out, int out_size, void* d_ws, size_t ws_size, hipStream_t stream) {
    static int grid = 0;
    if (grid == 0) {
        if (n_in != 31 || in_sizes[0] != M * D || out_size != M * D || ws_size < WS_END) { fprintf(stderr, "kernel_launch: unexpected shapes (n_in %d, in0 %d, out %d, ws %zu)\n", n_in, n_in > 0 ? in_sizes[0] : -1, out_size, ws_size); grid = -1; return; }
        int dev = 0, cus = 0;
        if (hipGetDevice(&dev) != hipSuccess || hipDeviceGetAttribute(&cus, hipDeviceAttributeMultiprocessorCount, dev) != hipSuccess) { grid = -1; return; }
        if (hipFuncSetAttribute((const void*)hymba_fwd, hipFuncAttributeMaxDynamicSharedMemorySize, LDS_BYTES) != hipSuccess) { fprintf(stderr, "kernel_launch: hipFuncSetAttribute failed\n"); grid = -1; return; }
        (void)hipGetLastError();
        grid = cus;
    }
    if (grid < 0) return;
    if (hipMemsetAsync((char*)d_ws + WS_CTL, 0, CTL_ZERO_BYTES, stream) != hipSuccess) return;
    Args a{};
    for (int i = 0; i < 31; ++i) a.in[i] = (const float*)d_in[i];
    a.out = (float*)d_out; a.ws = (unsigned char*)d_ws;
    hipLaunchKernelGGL(hymba_fwd, dim3(grid), dim3(NWAVES * 64), LDS_BYTES, stream, a);
}
```

```cpp
#include <hip/hip_runtime.h>
#include <cstdio>
#include <cstdint>
namespace pg8 {
#define PG8_LAS __attribute__((address_space(3)))
typedef unsigned short bf16_t;
typedef short bf16x8 __attribute__((ext_vector_type(8)));
typedef float f32x4 __attribute__((ext_vector_type(4)));
typedef unsigned u32x4 __attribute__((ext_vector_type(4)));
constexpr int BM = 256, BK = 64, HALF = 128, HTB = HALF * BK * 2  , STAGE_BYTES = 8 * HTB, NXCD = 8, WGM = 8;

__host__ __device__ __forceinline__ int lds_byte(int r, int c) { const int st = (r >> 4) * 2 + (c >> 5), rr = r & 15, cc = c & 31, ob = rr * 64 + cc * 2; return st * 1024 + (ob ^ (((ob >> 9) & 1) << 5)); }
__host__ __device__ __forceinline__ void stage_rc(int b, int& R, int& C) { const int st = b / 1024, sb = b % 1024, swz = sb ^ (((sb >> 9) & 1) << 5); R = (st >> 1) * 16 + swz / 64; C = (st & 1) * 32 + (swz % 64) / 2; }
__host__ __device__ __forceinline__ int perm32(int rho) { const int n = rho >> 4, i = rho & 15; return 8 * (i >> 2) + 4 * n + (i & 3); }

struct Unit { int pm, pn; };
struct Gemm { const bf16_t* A; const bf16_t* Bt; int M, N, K; size_t bt_batch_bytes; };

struct StaticOrder {
    int nM, nN, nwg, G, c;
    __host__ __device__ void init(int M, int N, int G_, int c_) { nM = M / BM; nN = N / BM; nwg = nM * nN; G = G_; c = c_; }
    __host__ __device__ bool next(int i, Unit& u) const {
        const long L = (long)i * G + c; if (L >= nwg) return false;
        int wgid = (int)L; { const int q = nwg / NXCD, r = nwg % NXCD, xcd = wgid % NXCD, off = wgid / NXCD; wgid = (xcd < r ? xcd * (q + 1) : r * (q + 1) + (xcd - r) * q) + off; }
        const int nig = WGM * nN, gid = wgid / nig, fm = gid * WGM, gsz = (nM - fm) < WGM ? (nM - fm) : WGM;
        u.pm = fm + ((wgid % nig) % gsz); u.pn = (wgid % nig) / gsz; return true;
    }
    __device__ __forceinline__ void a_ready(const Unit&) const {}
    __device__ __forceinline__ void done(const Unit&) const {}
};
typedef __bf16 bf16v2_t __attribute__((ext_vector_type(2)));
__device__ __forceinline__ unsigned cvt_pk_bf16(float lo, float hi) { bf16v2_t v; v.x = (__bf16)lo; v.y = (__bf16)hi; return __builtin_bit_cast(unsigned, v); }
typedef float f32x2 __attribute__((ext_vector_type(2)));
__device__ __forceinline__ float sigmoid_f(float x) { return __builtin_amdgcn_rcpf(1.0f + __builtin_amdgcn_exp2f(-1.44269504f * x)); }
__device__ __forceinline__ float silu_f(float x) { return x * sigmoid_f(x); }
__device__ __forceinline__ float gelu_tanh_f(float x) { return x * sigmoid_f(1.5957691216f * (x + 0.044715f * x * x * x)); }

struct EpiSwiGLU {
    static constexpr bool PERM = true, AFTER_DRAIN = false, PRE = true;
    bf16_t* O; int ldc; const float* ssq; const float* bias; int bstride; int rows_per_batch;
    __device__ __forceinline__ float pre_load(const Unit& u, int tid) const { const float* p = tid < 256 ? ssq + u.pm * BM + tid : bias + (size_t)((u.pm * BM) / rows_per_batch) * bstride + u.pn * BM + tid - 256;
        float v; asm volatile("global_load_dword %0, %1, off" : "=v"(v) : "v"(p) : "memory"); return v; }
    __device__ __forceinline__ void pre_store(PG8_LAS float* p, float v, int tid) const { p[tid] = tid < 256 ? __builtin_amdgcn_rsqf(v * (1.0f / 1024.0f) + 1e-6f) : v; }
    __device__ __forceinline__ void operator()(const f32x4 (&acc)[2][2][4][2], const Unit& u, int wr, int wc, int fr, int fq, const PG8_LAS float* pre) const {
        const int row0 = u.pm * BM + wr * 64 + fr, col0 = u.pn * 128 + wc * 32 + 8 * fq;
        const PG8_LAS float* bp = pre + 256 + wc * 32 + 8 * fq;
        const f32x4 bg0 = *(const PG8_LAS f32x4*)bp, bg1 = *(const PG8_LAS f32x4*)(bp + 4), bu0 = *(const PG8_LAS f32x4*)(bp + HALF), bu1 = *(const PG8_LAS f32x4*)(bp + HALF + 4);
#pragma unroll
        for (int ai = 0; ai < 2; ++ai)
#pragma unroll
            for (int m = 0; m < 4; ++m) { bf16_t* rowp = O + (size_t)(row0 + ai * HALF + m * 16) * ldc + col0;
                const float rs = pre[wr * 64 + fr + ai * HALF + m * 16];
                const f32x4 g0 = acc[ai][0][m][0] * rs + bg0, g1 = acc[ai][0][m][1] * rs + bg1, u0 = acc[ai][1][m][0] * rs + bu0, u1 = acc[ai][1][m][1] * rs + bu1;
                f32x4 v0, v1;
#pragma unroll
                for (int j = 0; j < 4; ++j) { v0[j] = silu_f(g0[j]) * u0[j]; v1[j] = silu_f(g1[j]) * u1[j]; }
                u32x4 w; w.x = cvt_pk_bf16(v0[0], v0[1]); w.y = cvt_pk_bf16(v0[2], v0[3]); w.z = cvt_pk_bf16(v1[0], v1[1]); w.w = cvt_pk_bf16(v1[2], v1[3]);
                *(u32x4*)rowp = w; }
    }
};
template <bool HAS_XG, int SCALE2  , bool BASE_F32, bool OUT_F32> struct EpiResid {
    static constexpr bool PERM = true, AFTER_DRAIN = false, PRE = false;
    const void* base; void* out; const float* gate; bf16_t* xg; const float* gvn; float* ssq;
    static constexpr int gstride = 9216, rows_per_batch = 16384; static constexpr float scale = 0.5f * SCALE2;
    __device__ __forceinline__ void operator()(const f32x4 (&acc)[2][2][4][2], const Unit& u, int wr, int wc, int fr, int fq, const PG8_LAS float*) const {
        const int row0 = u.pm * BM + wr * 64 + fr, col0 = u.pn * BM + wc * 32 + 8 * fq, bidx = (u.pm * BM) / rows_per_batch;
        const float* gp = gate + (size_t)bidx * gstride + col0;
        f32x4 gv[2][2], gn[2][2];
#pragma unroll
        for (int bj = 0; bj < 2; ++bj)
#pragma unroll
            for (int n = 0; n < 2; ++n) { gv[bj][n] = *(const f32x4*)(gp + bj * HALF + n * 4) * scale; gn[bj][n] = HAS_XG ? *(const f32x4*)(gvn + (size_t)bidx * 1024 + col0 + bj * HALF + n * 4) : (f32x4){0.f, 0.f, 0.f, 0.f}; }
#pragma unroll
        for (int ai = 0; ai < 2; ++ai)
#pragma unroll
            for (int mp = 0; mp < 2; ++mp) {
            f32x4 bs[2][2][2];
#pragma unroll
            for (int mm = 0; mm < 2; ++mm)
#pragma unroll
                for (int bj = 0; bj < 2; ++bj) { const size_t off = (size_t)(row0 + ai * HALF + (2 * mp + mm) * 16) * 1024 + col0 + bj * HALF;
                    if (BASE_F32) { bs[mm][bj][0] = *(const f32x4*)((const float*)base + off); bs[mm][bj][1] = *(const f32x4*)((const float*)base + off + 4); }
                    else { const u32x4 w = *(const u32x4*)((const bf16_t*)base + off);
                        bs[mm][bj][0] = (f32x4){__builtin_bit_cast(float, w.x << 16), __builtin_bit_cast(float, w.x & 0xffff0000u), __builtin_bit_cast(float, w.y << 16), __builtin_bit_cast(float, w.y & 0xffff0000u)};
                        bs[mm][bj][1] = (f32x4){__builtin_bit_cast(float, w.z << 16), __builtin_bit_cast(float, w.z & 0xffff0000u), __builtin_bit_cast(float, w.w << 16), __builtin_bit_cast(float, w.w & 0xffff0000u)}; } }
#pragma unroll
            for (int mm = 0; mm < 2; ++mm) { const int m = 2 * mp + mm; float sq = 0.f;
#pragma unroll
                for (int bj = 0; bj < 2; ++bj) { const size_t off = (size_t)(row0 + ai * HALF + m * 16) * 1024 + col0 + bj * HALF;
                    const f32x4 o0 = bs[mm][bj][0] + gv[bj][0] * acc[ai][bj][m][0], o1 = bs[mm][bj][1] + gv[bj][1] * acc[ai][bj][m][1];
                    if (OUT_F32) { *(f32x4*)((float*)out + off) = o0; *(f32x4*)((float*)out + off + 4) = o1; }
                    else { u32x4 w; w.x = cvt_pk_bf16(o0[0], o0[1]); w.y = cvt_pk_bf16(o0[2], o0[3]); w.z = cvt_pk_bf16(o1[0], o1[1]); w.w = cvt_pk_bf16(o1[2], o1[3]); *(u32x4*)((bf16_t*)out + off) = w; }
                    sq += ((o0[0] * o0[0] + o0[1] * o0[1]) + (o0[2] * o0[2] + o0[3] * o0[3])) + ((o1[0] * o1[0] + o1[1] * o1[1]) + (o1[2] * o1[2] + o1[3] * o1[3]));
                    if (HAS_XG) { const f32x4 q0 = o0 * gn[bj][0], q1 = o1 * gn[bj][1]; u32x4 w; w.x = cvt_pk_bf16(q0[0], q0[1]); w.y = cvt_pk_bf16(q0[2], q0[3]); w.z = cvt_pk_bf16(q1[0], q1[1]); w.w = cvt_pk_bf16(q1[2], q1[3]); *(u32x4*)(xg + off) = w; } }
                sq += __shfl_xor(sq, 16); sq += __shfl_xor(sq, 32);
                if (fq == 0) atomicAdd(ssq + row0 + ai * HALF + m * 16, sq); }
            asm volatile("" ::: "memory"); }
    }
};
typedef __attribute__((address_space(1))) unsigned epi_gu32;
typedef __attribute__((address_space(1))) float epi_gf32;
struct EpiFinal {
    static constexpr bool PERM = true, AFTER_DRAIN = false, PRE = false;
    const bf16_t* base; float* out; const float* gate; const float* gain; float* ssq; unsigned* cnt;
    static constexpr int gstride = 9216, rows_per_batch = 16384;
    __device__ __forceinline__ void operator()(const f32x4 (&acc)[2][2][4][2], const Unit& u, int wr, int wc, int fr, int fq, const PG8_LAS float*) const {
        const int row0 = u.pm * BM + wr * 64 + fr, col0 = u.pn * BM + wc * 32 + 8 * fq, bidx = (u.pm * BM) / rows_per_batch;
        const float* gp = gate + (size_t)bidx * gstride + col0;
        f32x4 gv[2][2];
#pragma unroll
        for (int bj = 0; bj < 2; ++bj)
#pragma unroll
            for (int n = 0; n < 2; ++n) gv[bj][n] = *(const f32x4*)(gp + bj * HALF + n * 4) * 0.5f;
        f32x4 o[2][2][4][2]; float sq[2][4];
#pragma unroll
        for (int ai = 0; ai < 2; ++ai)
#pragma unroll
            for (int mp = 0; mp < 2; ++mp) {
            u32x4 bw[2][2];
#pragma unroll
            for (int mm = 0; mm < 2; ++mm)
#pragma unroll
                for (int bj = 0; bj < 2; ++bj) bw[mm][bj] = *(const u32x4*)(base + (size_t)(row0 + ai * HALF + (2 * mp + mm) * 16) * 1024 + col0 + bj * HALF);
#pragma unroll
            for (int mm = 0; mm < 2; ++mm) { const int m = 2 * mp + mm; float sqv = 0.f;
#pragma unroll
                for (int bj = 0; bj < 2; ++bj) { const u32x4 w = bw[mm][bj];
                    const f32x4 b0 = (f32x4){__builtin_bit_cast(float, w.x << 16), __builtin_bit_cast(float, w.x & 0xffff0000u), __builtin_bit_cast(float, w.y << 16), __builtin_bit_cast(float, w.y & 0xffff0000u)};
                    const f32x4 b1 = (f32x4){__builtin_bit_cast(float, w.z << 16), __builtin_bit_cast(float, w.z & 0xffff0000u), __builtin_bit_cast(float, w.w << 16), __builtin_bit_cast(float, w.w & 0xffff0000u)};
                    const f32x4 o0 = b0 + gv[bj][0] * acc[ai][bj][m][0], o1 = b1 + gv[bj][1] * acc[ai][bj][m][1];
                    o[ai][bj][m][0] = o0; o[ai][bj][m][1] = o1;
                    sqv += ((o0[0] * o0[0] + o0[1] * o0[1]) + (o0[2] * o0[2] + o0[3] * o0[3])) + ((o1[0] * o1[0] + o1[1] * o1[1]) + (o1[2] * o1[2] + o1[3] * o1[3])); }
                sq[ai][m] = sqv; }
            asm volatile("" ::: "memory"); }
#pragma unroll
        for (int ai = 0; ai < 2; ++ai)
#pragma unroll
            for (int m = 0; m < 4; ++m) sq[ai][m] += __shfl_xor(sq[ai][m], 16);
#pragma unroll
        for (int ai = 0; ai < 2; ++ai)
#pragma unroll
            for (int m = 0; m < 4; ++m) sq[ai][m] += __shfl_xor(sq[ai][m], 32);
        if (fq == 0) {
#pragma unroll
            for (int ai = 0; ai < 2; ++ai)
#pragma unroll
                for (int m = 0; m < 4; ++m) atomicAdd(ssq + row0 + ai * HALF + m * 16, sq[ai][m]); }
        asm volatile("s_waitcnt vmcnt(0)" ::: "memory");
        epi_gu32* c = (epi_gu32*)(cnt + u.pm * 16);
        if (fr == 0 && fq == 0) __hip_atomic_fetch_add(c, 1u, __ATOMIC_RELAXED, __HIP_MEMORY_SCOPE_AGENT);
        f32x4 gn[2][2];
#pragma unroll
        for (int bj = 0; bj < 2; ++bj)
#pragma unroll
            for (int n = 0; n < 2; ++n) gn[bj][n] = *(const f32x4*)(gain + col0 + bj * HALF + n * 4);
        for (unsigned spins = 0; (unsigned)__builtin_amdgcn_readfirstlane((int)__hip_atomic_load(c, __ATOMIC_RELAXED, __HIP_MEMORY_SCOPE_AGENT)) < 32u; ) { __builtin_amdgcn_s_sleep(1); if (++spins > (1u << 20)) break; }
        float rs[2][4];
#pragma unroll
        for (int ai = 0; ai < 2; ++ai)
#pragma unroll
            for (int m = 0; m < 4; ++m) rs[ai][m] = __hip_atomic_load((epi_gf32*)(ssq + row0 + ai * HALF + m * 16), __ATOMIC_RELAXED, __HIP_MEMORY_SCOPE_AGENT);
#pragma unroll
        for (int ai = 0; ai < 2; ++ai)
#pragma unroll
            for (int m = 0; m < 4; ++m) { const float r = __builtin_amdgcn_rsqf(rs[ai][m] * (1.0f / 1024.0f) + 1e-6f);
#pragma unroll
                for (int bj = 0; bj < 2; ++bj) { float* p = out + (size_t)(row0 + ai * HALF + m * 16) * 1024 + col0 + bj * HALF;
                    *(f32x4*)p = o[ai][bj][m][0] * r * gn[bj][0]; *(f32x4*)(p + 4) = o[ai][bj][m][1] * r * gn[bj][1]; } }
    }
};
struct EpiInProj {
    static constexpr bool PERM = true, AFTER_DRAIN = false, PRE = true;
    bf16_t *ZQ, *ZV, *ZG, *ZRX, *ZRG, *ZLF, *ZLB; const float *LBF, *LBB; const float* ssq; const float* bias; int bstride; int rows_per_batch;
    __device__ __forceinline__ float pre_load(const Unit& u, int tid) const { const float* p = tid < 256 ? ssq + u.pm * BM + tid : bias + (size_t)((u.pm * BM) / rows_per_batch) * bstride + u.pn * BM + tid - 256;
        float v; asm volatile("global_load_dword %0, %1, off" : "=v"(v) : "v"(p) : "memory"); return v; }
    __device__ __forceinline__ void pre_store(PG8_LAS float* p, float v, int tid) const { p[tid] = tid < 256 ? __builtin_amdgcn_rsqf(v * (1.0f / 1024.0f) + 1e-6f) : v; }
    __device__ __forceinline__ void operator()(const f32x4 (&acc)[2][2][4][2], const Unit& u, int wr, int wc, int fr, int fq, const PG8_LAS float* pre) const {
        const int row0 = u.pm * BM + wr * 64 + fr, seg = u.pn >> 1, cs0 = (u.pn & 1) * 256 + wc * 32 + 8 * fq;
        const PG8_LAS float* bp = pre + 256 + wc * 32 + 8 * fq;
        f32x4 bb[2][2];
#pragma unroll
        for (int bj = 0; bj < 2; ++bj) { bb[bj][0] = *(const PG8_LAS f32x4*)(bp + bj * HALF); bb[bj][1] = *(const PG8_LAS f32x4*)(bp + bj * HALF + 4); }
        float rs[2][4];
#pragma unroll
        for (int ai = 0; ai < 2; ++ai)
#pragma unroll
            for (int m = 0; m < 4; ++m) rs[ai][m] = pre[wr * 64 + fr + ai * HALF + m * 16];
        if (seg == 1 || seg == 2) {
            bf16_t* Z = seg == 1 ? ZLF : ZLB; const float* LB = seg == 1 ? LBF : LBB;
            f32x4 bbn[2][2];
#pragma unroll
            for (int bj = 0; bj < 2; ++bj) { bbn[bj][0] = bb[bj][0] * -1.44269504f; bbn[bj][1] = bb[bj][1] * -1.44269504f; }
#pragma unroll
            for (int bj = 0; bj < 2; ++bj) { const f32x4 l0 = *(const f32x4*)(LB + cs0 + bj * HALF), l1 = *(const f32x4*)(LB + cs0 + bj * HALF + 4); const f32x4 om0 = 1.0f - l0, om1 = 1.0f - l1;
#pragma unroll
                for (int ai = 0; ai < 2; ++ai)
#pragma unroll
                    for (int m = 0; m < 4; ++m) { bf16_t* rowp = Z + (size_t)(row0 + ai * HALF + m * 16) * 512 + cs0 + bj * HALF;
                        const float rsn = rs[ai][m] * -1.44269504f;
                        const f32x4 a0 = acc[ai][bj][m][0] * rsn + bbn[bj][0], a1 = acc[ai][bj][m][1] * rsn + bbn[bj][1]; f32x4 v0, v1;
#pragma unroll
                        for (int j = 0; j < 4; ++j) { v0[j] = __builtin_amdgcn_logf(l0[j] + om0[j] * __builtin_amdgcn_rcpf(1.0f + __builtin_amdgcn_exp2f(a0[j]))); v1[j] = __builtin_amdgcn_logf(l1[j] + om1[j] * __builtin_amdgcn_rcpf(1.0f + __builtin_amdgcn_exp2f(a1[j]))); }
                        u32x4 w; w.x = cvt_pk_bf16(v0[0], v0[1]); w.y = cvt_pk_bf16(v0[2], v0[3]); w.z = cvt_pk_bf16(v1[0], v1[1]); w.w = cvt_pk_bf16(v1[2], v1[3]); *(u32x4*)rowp = w; } }
        } else {
            bf16_t* Z = seg == 0 ? ZQ : seg == 3 ? ZV : seg == 4 ? ZG : seg == 5 ? ZRX : ZRG;
            const int act = (seg == 0 || seg == 4) ? 1 : (seg == 6 ? 2 : 0);
#pragma unroll
            for (int ai = 0; ai < 2; ++ai)
#pragma unroll
                for (int m = 0; m < 4; ++m) { bf16_t* rowp = Z + (size_t)(row0 + ai * HALF + m * 16) * 512 + cs0;
#pragma unroll
                    for (int bj = 0; bj < 2; ++bj) { f32x4 v0 = acc[ai][bj][m][0] * rs[ai][m] + bb[bj][0], v1 = acc[ai][bj][m][1] * rs[ai][m] + bb[bj][1];
                        if (act == 1) {
#pragma unroll
                            for (int j = 0; j < 4; ++j) { v0[j] = silu_f(v0[j]); v1[j] = silu_f(v1[j]); } }
                        else if (act == 2) {
#pragma unroll
                            for (int j = 0; j < 4; ++j) { v0[j] = gelu_tanh_f(v0[j]); v1[j] = gelu_tanh_f(v1[j]); } }
                        u32x4 w; w.x = cvt_pk_bf16(v0[0], v0[1]); w.y = cvt_pk_bf16(v0[2], v0[3]); w.z = cvt_pk_bf16(v1[0], v1[1]); w.w = cvt_pk_bf16(v1[2], v1[3]);
                        *(u32x4*)(rowp + bj * HALF) = w; } }
        }
    }
};
#ifdef GSTAMP_K
#define GSTAMP(k) do { if (g.K == GSTAMP_K && blockIdx.x == 0 && threadIdx.x == 0) ((unsigned long long*)((char*)g.A - GSTAMP_AOFF + 768 * 1024))[k] = __builtin_amdgcn_s_memrealtime(); } while (0)
#else
#define GSTAMP(k) do { } while (0)
#endif
template <class Epi, class Sched, bool ALIGN_EPI = false, bool SP2 = false>
__device__ __forceinline__ void gemm_phase(PG8_LAS unsigned char* lds, const Gemm g, const Sched& S, const Epi& E) {
    const int tid = threadIdx.x, wid = __builtin_amdgcn_readfirstlane(tid >> 6), lane = tid & 63, wr = wid >> 2, wc = wid & 3, fr = lane & 15, fq = lane >> 4;
    const int K = g.K, nt = K / BK;
    unsigned voffA[2], voffB[2];
#pragma unroll
    for (int i = 0; i < 2; ++i) { int R, C; stage_rc(tid * 16 + i * 8192, R, C); const int Rb = Epi::PERM ? ((R & ~31) + perm32(R & 31)) : R;
        voffA[i] = (unsigned)(R * K + C) * 2u; voffB[i] = (unsigned)(Rb * K + C) * 2u; }
    asm volatile("" : "+v"(voffA[0]), "+v"(voffA[1]), "+v"(voffB[0]), "+v"(voffB[1]));
    const size_t kstep = (size_t)(BK * 2);
    const size_t hstep = (size_t)HALF * K * 2;
    const size_t tstep = 2 * hstep;
    const unsigned ldsw = (unsigned)wid * 1024u;
    const int aoff = lds_byte(wr * 64 + fr, fq * 8), boff = lds_byte(wc * 32 + fr, fq * 8);
#define PG8_SA(b, h) (((b) * 2 + (h)) * HTB)
#define PG8_SB(b, h) ((4 + (b) * 2 + (h)) * HTB)
#define PG8_STAGE(bufoff, gbase, voff) do { _Pragma("unroll") for (int _i = 0; _i < 2; ++_i) \
        __builtin_amdgcn_global_load_lds((const unsigned*)((const char*)(gbase) + (voff)[_i]), (PG8_LAS unsigned*)(lds + (bufoff) + ldsw + _i * 8192), 16, 0, 0); } while (0)
#define PG8_LDA(dst, b, h) do { _Pragma("unroll") for (int m = 0; m < 4; ++m) _Pragma("unroll") for (int k = 0; k < 2; ++k) dst[m][k] = *(const PG8_LAS bf16x8*)(lds + PG8_SA(b, h) + aoff + m * 2048 + k * 1024); } while (0)
#define PG8_LDB(dst, b, h) do { _Pragma("unroll") for (int n = 0; n < 2; ++n) _Pragma("unroll") for (int k = 0; k < 2; ++k) dst[n][k] = *(const PG8_LAS bf16x8*)(lds + PG8_SB(b, h) + boff + n * 2048 + k * 1024); } while (0)
#define PG8_MMA(ai, bj, At, Bt) do { __builtin_amdgcn_s_setprio(1); _Pragma("unroll") for (int m = 0; m < 4; ++m) _Pragma("unroll") for (int n = 0; n < 2; ++n) _Pragma("unroll") for (int k = 0; k < 2; ++k) \
        acc[ai][bj][m][n] = __builtin_amdgcn_mfma_f32_16x16x32_bf16(Bt[n][k], At[m][k], acc[ai][bj][m][n], 0, 0, 0); __builtin_amdgcn_s_setprio(0); } while (0)
#define PG8_WAIT_V(n) asm volatile("s_waitcnt vmcnt(" #n ")" ::: "memory")
#define PG8_WAIT_L(n) asm volatile("s_waitcnt lgkmcnt(" #n ")" ::: "memory")
#define PG8_BAR __builtin_amdgcn_s_barrier()
#define PG8_SCHED __builtin_amdgcn_sched_barrier(0)
    Unit cur, nxt; int ui = 0; float pre_v = 0.f;
    if (!S.next(0, cur)) return;
    f32x4 acc[2][2][4][2];
#pragma unroll
    for (int a = 0; a < 2; ++a)
#pragma unroll
        for (int b = 0; b < 2; ++b)
#pragma unroll
            for (int m = 0; m < 4; ++m)
#pragma unroll
                for (int n = 0; n < 2; ++n) acc[a][b][m][n] = (f32x4){0.f, 0.f, 0.f, 0.f};
    bf16x8 At[4][2], B0[2][2], B1[2][2];
    const char* cA = (const char*)g.A + (size_t)cur.pm * tstep; const char* cB = (const char*)g.Bt + (size_t)cur.pn * tstep + (cur.pm >= 64 ? g.bt_batch_bytes : 0);
    S.a_ready(cur);
    if constexpr (SP2) {
        PG8_STAGE(PG8_SB(0, 0), cB, voffB); PG8_STAGE(PG8_SB(0, 1), cB + hstep, voffB); PG8_STAGE(PG8_SA(0, 0), cA, voffA); PG8_STAGE(PG8_SA(0, 1), cA + hstep, voffA);
        if (wr == 1) PG8_BAR;
        PG8_WAIT_V(2); PG8_BAR;
        PG8_STAGE(PG8_SB(1, 0), cB + kstep, voffB); PG8_STAGE(PG8_SA(1, 0), cA + kstep, voffA); PG8_STAGE(PG8_SB(1, 1), cB + hstep + kstep, voffB);
        PG8_WAIT_V(6); PG8_BAR;
    } else {
        PG8_STAGE(PG8_SB(0, 0), cB, voffB); PG8_STAGE(PG8_SA(0, 0), cA, voffA); PG8_STAGE(PG8_SB(0, 1), cB + hstep, voffB); PG8_STAGE(PG8_SA(0, 1), cA + hstep, voffA);
        if (wr == 1) PG8_BAR;
        PG8_WAIT_V(4); PG8_BAR;
        PG8_STAGE(PG8_SB(1, 0), cB + kstep, voffB); PG8_STAGE(PG8_SA(1, 0), cA + kstep, voffA); PG8_STAGE(PG8_SB(1, 1), cB + hstep + kstep, voffB);
        PG8_WAIT_V(6); PG8_BAR;
    }
    for (;;) {
        GSTAMP(22);
        const bool has_next = S.next(ui + 1, nxt);
        const char* nA = has_next ? (const char*)g.A + (size_t)nxt.pm * tstep : cA; const char* nB = has_next ? (const char*)g.Bt + (size_t)nxt.pn * tstep + (nxt.pm >= 64 ? g.bt_batch_bytes : 0) : cB;
        for (int t = 0; t < nt; t += 2) {
            const bool last = (t == nt - 2);
            const char* a1 = cA + (size_t)(t + 1) * kstep;
            const char* a2 = last ? nA : cA + (size_t)(t + 2) * kstep; const char* b2 = last ? nB : cB + (size_t)(t + 2) * kstep;
            const char* a3 = a2 + kstep; const char* b3 = b2 + kstep;
            if (last) { if constexpr (Epi::PRE) pre_v = E.pre_load(cur, tid); if (has_next) S.a_ready(nxt); }
            if constexpr (SP2) {
            PG8_LDB(B0, 0, 0); PG8_LDB(B1, 0, 1); PG8_SCHED; PG8_LDA(At, 0, 0); PG8_STAGE(PG8_SA(1, 1), a1 + hstep, voffA);
            PG8_WAIT_V(8); PG8_WAIT_L(0); PG8_BAR; PG8_MMA(0, 0, At, B0); PG8_MMA(0, 1, At, B1); PG8_BAR; PG8_SCHED;
            PG8_LDA(At, 0, 1); PG8_STAGE(PG8_SB(0, 0), b2, voffB); PG8_STAGE(PG8_SB(0, 1), b2 + hstep, voffB); PG8_STAGE(PG8_SA(0, 0), a2, voffA);
            PG8_WAIT_V(8); PG8_WAIT_L(0); PG8_BAR; PG8_MMA(1, 0, At, B0); PG8_MMA(1, 1, At, B1); PG8_BAR; PG8_SCHED;
            PG8_LDB(B0, 1, 0); PG8_LDB(B1, 1, 1); PG8_SCHED; PG8_LDA(At, 1, 0); PG8_STAGE(PG8_SA(0, 1), a2 + hstep, voffA);
            PG8_WAIT_V(8); PG8_WAIT_L(0); PG8_BAR; PG8_MMA(0, 0, At, B0); PG8_MMA(0, 1, At, B1); PG8_BAR; PG8_SCHED;
            PG8_LDA(At, 1, 1); PG8_STAGE(PG8_SB(1, 0), b3, voffB); PG8_STAGE(PG8_SB(1, 1), b3 + hstep, voffB); PG8_STAGE(PG8_SA(1, 0), a3, voffA);
            PG8_WAIT_V(8); PG8_WAIT_L(0); PG8_BAR; PG8_MMA(1, 0, At, B0); PG8_MMA(1, 1, At, B1); PG8_BAR; PG8_SCHED;
            } else {
            PG8_LDB(B0, 0, 0); PG8_SCHED; PG8_LDA(At, 0, 0); PG8_STAGE(PG8_SA(1, 1), a1 + hstep, voffA);
            PG8_WAIT_L(8); PG8_BAR; PG8_WAIT_L(0); PG8_MMA(0, 0, At, B0); PG8_BAR; PG8_SCHED;
            PG8_LDB(B1, 0, 1); PG8_STAGE(PG8_SB(0, 0), b2, voffB);
            PG8_BAR; PG8_WAIT_L(0); PG8_MMA(0, 1, At, B1); PG8_BAR;
            PG8_LDA(At, 0, 1); PG8_STAGE(PG8_SA(0, 0), a2, voffA);
            PG8_BAR; PG8_WAIT_L(0); PG8_MMA(1, 0, At, B0); PG8_BAR; PG8_SCHED;
            PG8_STAGE(PG8_SB(0, 1), b2 + hstep, voffB);
            PG8_WAIT_V(6); PG8_BAR; PG8_MMA(1, 1, At, B1); PG8_BAR;
            PG8_LDB(B0, 1, 0); PG8_SCHED; PG8_LDA(At, 1, 0); PG8_STAGE(PG8_SA(0, 1), a2 + hstep, voffA);
            PG8_WAIT_L(8); PG8_BAR; PG8_WAIT_L(0); PG8_MMA(0, 0, At, B0); PG8_BAR; PG8_SCHED;
            PG8_LDB(B1, 1, 1); PG8_STAGE(PG8_SB(1, 0), b3, voffB);
            PG8_BAR; PG8_WAIT_L(0); PG8_MMA(0, 1, At, B1); PG8_BAR;
            PG8_LDA(At, 1, 1); PG8_STAGE(PG8_SA(1, 0), a3, voffA);
            PG8_BAR; PG8_WAIT_L(0); PG8_MMA(1, 0, At, B0); PG8_BAR; PG8_SCHED;
            PG8_STAGE(PG8_SB(1, 1), b3 + hstep, voffB);
            PG8_WAIT_V(6); PG8_BAR; PG8_MMA(1, 1, At, B1); PG8_BAR;
            }
        }
        if constexpr (ALIGN_EPI) { if (wr == 0) PG8_BAR; }
        if constexpr (Epi::PRE) { asm volatile("s_waitcnt vmcnt(16)" : "+v"(pre_v) :: "memory"); E.pre_store((PG8_LAS float*)(lds + STAGE_BYTES), pre_v, tid); PG8_WAIT_L(0); PG8_BAR; }
        GSTAMP(20);
        if constexpr (!Epi::AFTER_DRAIN) { int t2 = threadIdx.x; asm volatile("" : "+v"(t2));
            E(acc, cur, wr, wc, t2 & 15, (t2 >> 4) & 3, (const PG8_LAS float*)(lds + STAGE_BYTES)); S.done(cur); }
        GSTAMP(21);
        if (!has_next) break;
#pragma unroll
        for (int a = 0; a < 2; ++a)
#pragma unroll
            for (int b = 0; b < 2; ++b)
#pragma unroll
                for (int m = 0; m < 4; ++m)
#pragma unroll
                    for (int n = 0; n < 2; ++n) acc[a][b][m][n] = (f32x4){0.f, 0.f, 0.f, 0.f};
        cur = nxt; cA = nA; cB = nB; ++ui;
        if constexpr (ALIGN_EPI) { if (wr == 1) PG8_BAR; }
    }
    PG8_WAIT_V(0);
    if constexpr (!ALIGN_EPI) { if (wr == 0) PG8_BAR; }
    PG8_BAR;
    if constexpr (Epi::AFTER_DRAIN) { E.fused(acc, cur, wr, wc, fr, fq, lds, wid, lane); S.done(cur); }
#undef PG8_SA
#undef PG8_SB
#undef PG8_STAGE
#undef PG8_LDA
#undef PG8_LDB
#undef PG8_MMA
#undef PG8_WAIT_V
#undef PG8_WAIT_L
#undef PG8_BAR
#undef PG8_SCHED
}
}
#define GAS __attribute__((address_space(1)))
#define LAS __attribute__((address_space(3)))
typedef unsigned short bf16;
typedef unsigned v4u __attribute__((ext_vector_type(4)));
typedef float f32x4 __attribute__((ext_vector_type(4)));
typedef short bf16x8 __attribute__((ext_vector_type(8)));
typedef GAS unsigned gu32;
typedef GAS unsigned long long gu64;
#define RLX_AGENT __ATOMIC_RELAXED, __HIP_MEMORY_SCOPE_AGENT
#define LDS_WAIT() asm volatile("s_waitcnt lgkmcnt(0)" ::: "memory")
#define VM_WAIT() asm volatile("s_waitcnt vmcnt(0)" ::: "memory")
__device__ __forceinline__ unsigned long long rt() { return __builtin_amdgcn_s_memrealtime(); }
__device__ __forceinline__ unsigned f2bf(float f) { unsigned u = __builtin_bit_cast(unsigned, f); return (u + 0x7fffu + ((u >> 16) & 1u)) >> 16; }
__device__ __forceinline__ unsigned pk2(float lo, float hi) { return pg8::cvt_pk_bf16(lo, hi); }

#define XB_TMO      128
#define XB_XCNT(j)  (256  + 64 * (j))
#define XB_XSUB(j)  (1280 + 64 * (j))
#define XB_XGEN(j)  (2304 + 64 * (j))
#define XB_TOP      3328
#define XB_TOPGEN   3392
#define XCD_BAR_WORDS 3456
#define XB_SPIN_CAP (1u << 23)

__device__ __forceinline__ unsigned xb_ld(unsigned* p)              { return __hip_atomic_load(p, __ATOMIC_RELAXED, __HIP_MEMORY_SCOPE_AGENT); }
__device__ __forceinline__ unsigned xb_add(unsigned* p, unsigned v) { return __hip_atomic_fetch_add(p, v, __ATOMIC_RELAXED, __HIP_MEMORY_SCOPE_AGENT); }
__device__ __forceinline__ unsigned xb_xcc_id() { return (unsigned)__builtin_amdgcn_s_getreg((3 << 11) | 20) & 0xFu; }
#define XB_SPIN(cond, bar) do { unsigned _sp = 0; while (cond) { __builtin_amdgcn_s_sleep(1); \
    if ((++_sp & 255u) == 0u) { if (xb_ld(&(bar)[XB_TMO])) break; if (_sp > XB_SPIN_CAP) { atomicAdd(&(bar)[XB_TMO], 1u); break; } } } } while (0)

struct XcdBarrier {
    unsigned* bar; unsigned x;
    volatile LAS unsigned* st;
};

__device__ __forceinline__ XcdBarrier xcd_barrier_post(unsigned* bar, volatile LAS unsigned* st) {
    XcdBarrier b; b.bar = bar; b.x = xb_xcc_id(); b.st = st;
    if (threadIdx.x == 0) (void)xb_add(&bar[XB_XCNT(b.x)], 1u);
    return b;
}
__device__ __forceinline__ void xcd_barrier_complete(unsigned* bar, unsigned x, unsigned& nloc, unsigned& nx) {
    const unsigned G = gridDim.x * gridDim.y * gridDim.z;
    unsigned sum, cnt, mine, sp = 0u;
    for (;;) {
        sum = 0u; cnt = 0u; mine = 0u;
#pragma unroll
        for (unsigned j = 0; j < 16; ++j) { const unsigned c = xb_ld(&bar[XB_XCNT(j)]); sum += c; cnt += (c > 0u) ? 1u : 0u; mine = (j == x) ? c : mine; }
        if (sum == G) break;
        __builtin_amdgcn_s_sleep(1);
        if ((++sp & 255u) == 0u) { if (xb_ld(&bar[XB_TMO])) break; if (sp > XB_SPIN_CAP) { atomicAdd(&bar[XB_TMO], 1u); break; } }
    }
    nloc = mine > 0u ? mine : 1u; nx = cnt > 0u ? cnt : 1u;
}

__device__ __forceinline__ void xcd_barrier(const XcdBarrier& b) {
    asm volatile("s_waitcnt vmcnt(0)" ::: "memory");
    __syncthreads();
    if (threadIdx.x == 0) {
        unsigned* bar = b.bar;
        __builtin_amdgcn_s_waitcnt(0);
        unsigned nloc = b.st[0], nx = b.st[1];
        if (nloc == 0u) { xcd_barrier_complete(bar, b.x, nloc, nx); b.st[0] = nloc; b.st[1] = nx; }
        const unsigned old = xb_add(&bar[XB_XSUB(b.x)], 1u);
        const unsigned gen = old / nloc;
        if (old + 1u == (gen + 1u) * nloc) {
            __builtin_amdgcn_fence(__ATOMIC_RELEASE, "agent");
            asm volatile("s_waitcnt vmcnt(0)" ::: "memory");
            const unsigned og = xb_add(&bar[XB_TOP], 1u);
            const unsigned tg = og / nx;
            if (og + 1u == (tg + 1u) * nx) xb_add(&bar[XB_TOPGEN], 1u);
            else XB_SPIN(xb_ld(&bar[XB_TOPGEN]) == tg, bar);
            __builtin_amdgcn_fence(__ATOMIC_ACQUIRE, "agent");
            xb_add(&bar[XB_XGEN(b.x)], 1u);
            asm volatile("s_waitcnt vmcnt(0)" ::: "memory");
        } else {
            XB_SPIN(xb_ld(&bar[XB_XGEN(b.x)]) == gen, bar);
            __builtin_amdgcn_fence(__ATOMIC_ACQUIRE, "agent");
            asm volatile("s_waitcnt vmcnt(0)" ::: "memory");
        }
    }
    __syncthreads();
}
constexpr int NWAVES = 8;
constexpr int BATCH = 2, T = 16384, D = 1024, FF = 2816, NIN = 3584, DH = 512, NMOD = 9 * D;
constexpr int M = BATCH * T;
constexpr float EPS = 1e-6f;
constexpr size_t MiB = 1u << 20;
constexpr size_t WS_CTL = 0, CTL_ZERO_BYTES = 128 * 1024;
constexpr size_t WS_MOD = 1 * MiB;
constexpr size_t WS_SSQ2 = 128 * 1024, WS_SSQ3 = 256 * 1024, WS_SSQ4 = 384 * 1024, WS_SSQ1 = 512 * 1024;
constexpr size_t WS_GV = WS_MOD + 80 * 1024;
constexpr size_t WS_BIAS1 = 640 * 1024, WS_BIAS2 = 688 * 1024, WS_BIAS3 = 720 * 1024;
constexpr size_t WS_LBF = WS_MOD + 128 * 1024, WS_LBB = WS_LBF + 4096, WS_RGCL = WS_LBB + 4096;
constexpr size_t WS_RGTOT = 2 * MiB;
constexpr size_t WS_DG = 3 * MiB;
constexpr size_t WS_W13B = 4 * MiB, WS_W2A = 26 * MiB, WS_W2B = 32 * MiB, WS_WOUT = 45 * MiB, WS_RGW = 47 * MiB;
constexpr size_t WS_W13A = 400 * MiB, WS_WIN = 464 * MiB;
constexpr size_t W13_COPY = (size_t)2 * 2816 * 1024 * 2, WIN_COPY = (size_t)3584 * 1024 * 2;
constexpr size_t WS_XN = 48 * MiB;
constexpr size_t WS_HB = 112 * MiB;
constexpr size_t WS_ZQ = 112 * MiB, WS_ZV = 144 * MiB, WS_ZG = 176 * MiB, WS_ZRX = 208 * MiB, WS_ZRG = 240 * MiB, WS_ZLF = 272 * MiB, WS_ZLB = 304 * MiB;
constexpr size_t WS_XB = 336 * MiB;
constexpr size_t WS_SG = 400 * MiB;
constexpr size_t WS_OB = 464 * MiB;
constexpr size_t WS_END = 500 * MiB;
static_assert(WS_HB + (size_t)M * FF * 2 <= WS_SG && WS_XB + (size_t)M * D * 2 <= WS_SG && WS_W13B + 2 * W13_COPY <= WS_W2A && WS_W13A + 2 * W13_COPY <= WS_SG + 32 * MiB && WS_WIN + 2 * WIN_COPY <= WS_OB + 32 * MiB && WS_W2A + (size_t)D * FF * 2 <= WS_W2B && WS_W2B + (size_t)D * FF * 2 <= WS_WOUT, "ws map");
constexpr int CW_BAR = 4096;
constexpr int CW_FIN = 20480;
constexpr int CW_QUEUE = 16384;
constexpr int RING_OFF = 0, RING_BYTES = 145408;
constexpr int LDSCTL_OFF = RING_BYTES, MISC_OFF = LDSCTL_OFF + 320;
constexpr int LDS_BYTES = 147456;
static_assert(MISC_OFF + 128 <= LDS_BYTES, "LDS map");

struct Frame {
    LAS unsigned char* lds;
    volatile LAS unsigned* MISC;
    gu32* ctl;
    int tid, lane, wave, G, bid;
    const __attribute__((address_space(4))) unsigned long long* ka;
    float* out; unsigned char* ws;
};
#ifdef STAMP_A
#define STAMPX(F, k) do { if (blockIdx.x == 0 && threadIdx.x == 0) ((unsigned long long*)((F).ws + WS_CTL + 768 * 1024))[k] = __builtin_amdgcn_s_memrealtime(); } while (0)
#else
#define STAMPX(F, k) do { } while (0)
#endif
#define FIN(k) ((const float*)(const __attribute__((address_space(1))) float*)F.ka[k])
__device__ __forceinline__ float wave_sum(float v) {
#pragma unroll
    for (int o = 1; o < 64; o <<= 1) v += __shfl_xor(v, o);
    return v;
}
__device__ __forceinline__ float bf2f(unsigned short b) { return __builtin_bit_cast(float, ((unsigned)b) << 16); }
__device__ __forceinline__ float bflo(unsigned w) { return __builtin_bit_cast(float, w << 16); }
__device__ __forceinline__ float bfhi(unsigned w) { return __builtin_bit_cast(float, w & 0xffff0000u); }
__device__ __forceinline__ float sigmoidf_(float x) { return __builtin_amdgcn_rcpf(1.0f + __builtin_amdgcn_exp2f(-1.44269504f * x)); }

__device__ __forceinline__ void p0_transpose_item(const float* W, int K, int N, bf16* WT, int k0, int n0, int drow0, LAS float* scr, int lane, float scale = 1.0f) {
    {
        const int r8 = lane >> 3, c4 = 4 * (lane & 7); f32x4 tv[8];
#pragma unroll
        for (int i = 0; i < 8; ++i) tv[i] = *(const f32x4*)(W + (size_t)(k0 + 8 * i + r8) * N + n0 + c4);
#pragma unroll
        for (int i = 0; i < 8; ++i) { LAS float* d = scr + (8 * i + r8) * 33 + c4; d[0] = tv[i][0] * scale; d[1] = tv[i][1] * scale; d[2] = tv[i][2] * scale; d[3] = tv[i][3] * scale; } }
    LDS_WAIT(); asm volatile("" ::: "memory");
    const int c = lane & 7;
#pragma unroll
    for (int j = 0; j < 4; ++j) { const int n = (lane >> 3) + 8 * j; const LAS float* s = scr + (8 * c) * 33 + n;
        v4u o; o.x = pk2(s[0 * 33], s[1 * 33]); o.y = pk2(s[2 * 33], s[3 * 33]); o.z = pk2(s[4 * 33], s[5 * 33]); o.w = pk2(s[6 * 33], s[7 * 33]);
        *(GAS v4u*)(WT + (size_t)(drow0 + n) * K + k0 + 8 * c) = o; }
    LDS_WAIT(); asm volatile("" ::: "memory");
}
__device__ __forceinline__ void p0_item_w13(const float* W, int mat, bf16* WT, int item, LAS float* scr, int lane) {
    const int nblk = FF / 32, kb = item / nblk, nb = item % nblk, n0 = 32 * nb;
    p0_transpose_item(W, D, FF, WT, 64 * kb, n0, 256 * (n0 / 128) + 128 * mat + (n0 % 128), scr, lane);
}
__device__ __forceinline__ void p0_item_plain(const float* W, int K, int N, bf16* WT, int item, LAS float* scr, int lane) {
    const int nblk = N / 32, kb = item / nblk, nb = item % nblk;
    p0_transpose_item(W, K, N, WT, 64 * kb, 32 * nb, 32 * nb, scr, lane);
}

__device__ __forceinline__ void p0a(Frame& F) {
    LAS float* L = (LAS float*)(F.lds + RING_OFF);
    const float* c = FIN(1); const float* w_ada = FIN(2); const float* b_ada = FIN(3);
    float* MOD = (float*)(F.ws + WS_MOD);
    for (int gi = F.bid; gi < NMOD / 64; gi += F.G) {
        for (int i = F.tid; i < 2 * D; i += NWAVES * 64) { const float v = c[i]; L[i] = v * sigmoidf_(v); }
        __syncthreads();
        const int n = 64 * gi + F.lane; float a0 = 0.f, a1 = 0.f; const float* wp = w_ada + (size_t)(128 * F.wave) * NMOD + n;
#pragma unroll 16
        for (int k = 0; k < 128; ++k) { const float wv = wp[(size_t)k * NMOD]; a0 += wv * L[128 * F.wave + k]; a1 += wv * L[D + 128 * F.wave + k]; }
        L[2 * D + (F.wave * 2 + 0) * 64 + F.lane] = a0; L[2 * D + (F.wave * 2 + 1) * 64 + F.lane] = a1;
        __syncthreads();
        if (F.wave < 2) { float s = b_ada[n];
#pragma unroll
            for (int w = 0; w < 8; ++w) s += L[2 * D + (w * 2 + F.wave) * 64 + F.lane];
            MOD[F.wave * NMOD + n] = s; }
        __syncthreads();
    }
    {
        f32x4* z0 = (f32x4*)(F.ws + 128 * 1024); f32x4* z1 = (f32x4*)(F.ws + 640 * 1024); const f32x4 zz = {0.f, 0.f, 0.f, 0.f};
        for (int i = F.bid * NWAVES * 64 + F.tid; i < (384 * 1024) / 16; i += F.G * NWAVES * 64) z0[i] = zz;
        for (int i = F.bid * NWAVES * 64 + F.tid; i < (128 * 1024) / 16; i += F.G * NWAVES * 64) z1[i] = zz;
    }
    if (F.bid == F.G - 1) {
        const float* lbf = FIN(10); const float* lbb = FIN(11); float* LBF = (float*)(F.ws + WS_LBF); float* LBB = (float*)(F.ws + WS_LBB); float* CL = (float*)(F.ws + WS_RGCL);
        for (int i = F.tid; i < DH; i += NWAVES * 64) {
            LBF[i] = sigmoidf_(lbf[DH + i] - lbf[i]); LBB[i] = sigmoidf_(lbb[DH + i] - lbb[i]);
            const float lf = FIN(19)[i], lb = FIN(24)[i];
            CL[i] = -8.0f * 1.44269504f * log1pf(expf(-lf)); CL[DH + i] = -8.0f * 1.44269504f * log1pf(expf(-lb));
        }
    }
    LAS float* scr = (LAS float*)(F.lds + RING_OFF + 16384 + F.wave * 12288);
    const int gw = F.bid * NWAVES + F.wave, NGW = F.G * NWAVES;
    constexpr int I_2 = (FF / 64) * (D / 32), I_OUT = (D / 64) * (D / 32), I_RG = 2;
    constexpr int NITEMS = 2 * I_2 + I_OUT + 32 * I_RG;
    for (int it = gw; it < NITEMS; it += NGW) {
        int r = it;
        if (r < I_2) { p0_item_plain(FIN(7), FF, D, (bf16*)(F.ws + WS_W2A), r, scr, F.lane); continue; } r -= I_2;
        if (r < I_2) { p0_item_plain(FIN(29), FF, D, (bf16*)(F.ws + WS_W2B), r, scr, F.lane); continue; } r -= I_2;
        if (r < I_OUT) { p0_item_plain(FIN(25), D, D, (bf16*)(F.ws + WS_WOUT), r, scr, F.lane); continue; } r -= I_OUT;
        { const int mb = r / I_RG, half = r % I_RG, mat = mb >> 3, blk = mb & 7;
          const float* src = (mat == 0 ? FIN(15) : mat == 1 ? FIN(17) : mat == 2 ? FIN(20) : FIN(22)) + (size_t)blk * 4096;
          p0_transpose_item(src, 64, 64, (bf16*)(F.ws + WS_RGW) + (size_t)mb * 4096, 0, 32 * half, 32 * half, scr, F.lane, -1.44269504f); }
    }
    const float* xin = FIN(0); bf16* XB = (bf16*)(F.ws + WS_XB); float* SSQ = (float*)(F.ws + WS_SSQ1);
    for (;;) {
        __syncthreads();
        if (F.tid == 0) F.MISC[16] = __hip_atomic_fetch_add(F.ctl + CW_QUEUE + 128, 1u, __ATOMIC_RELAXED, __HIP_MEMORY_SCOPE_AGENT);
        __syncthreads(); const int bt = (int)F.MISC[16];
        if (bt >= M / 32) break;
        const int mb = 32 * bt + 4 * F.wave;
        f32x4 v[4][4];
#pragma unroll
        for (int r = 0; r < 4; ++r) { const GAS f32x4* xr = (const GAS f32x4*)(xin + (size_t)(mb + r) * D) + F.lane;
#pragma unroll
            for (int j = 0; j < 4; ++j) v[r][j] = xr[64 * j]; }
#pragma unroll
        for (int r = 0; r < 4; ++r) { const int m = mb + r; float s = 0.f;
#pragma unroll
            for (int j = 0; j < 4; ++j) s += (v[r][j].x * v[r][j].x + v[r][j].y * v[r][j].y) + (v[r][j].z * v[r][j].z + v[r][j].w * v[r][j].w);
            s = wave_sum(s);
            if (F.lane == 0) SSQ[m] = s;
            GAS unsigned long long* o8 = (GAS unsigned long long*)(XB + (size_t)m * D) + F.lane;
#pragma unroll
            for (int j = 0; j < 4; ++j) o8[64 * j] = (unsigned long long)pk2(v[r][j].x, v[r][j].y) | ((unsigned long long)pk2(v[r][j].z, v[r][j].w) << 32); }
    }
}

__device__ __forceinline__ void p0_fold_item(const float* W, int N, bf16* WT, size_t copy_elems, int k0, int n0, int drow0, const float* gain, const float* sc, const float* sh, float* bias, int bstride, LAS float* scr, int lane) {
    const int r8 = lane >> 3, c4 = 4 * (lane & 7), c = lane & 7; f32x4 tv[8];
#pragma unroll
    for (int i = 0; i < 8; ++i) tv[i] = *(const f32x4*)(W + (size_t)(k0 + 8 * i + r8) * N + n0 + c4);
    const f32x4 ga = *(const f32x4*)(gain + k0 + 8 * c), gb = *(const f32x4*)(gain + k0 + 8 * c + 4);
    f32x4 sa[2], sb[2];
#pragma unroll
    for (int bb = 0; bb < 2; ++bb) { sa[bb] = *(const f32x4*)(sc + (size_t)bb * NMOD + k0 + 8 * c); sb[bb] = *(const f32x4*)(sc + (size_t)bb * NMOD + k0 + 8 * c + 4); }
    const float sh0 = sh[k0 + lane], sh1 = sh[(size_t)NMOD + k0 + lane];
    LAS float* shl = scr + 64 * 33;
#pragma unroll
    for (int i = 0; i < 8; ++i) { LAS float* d = scr + (8 * i + r8) * 33 + c4; d[0] = tv[i][0]; d[1] = tv[i][1]; d[2] = tv[i][2]; d[3] = tv[i][3]; }
    shl[lane] = sh0; shl[64 + lane] = sh1;
    LDS_WAIT(); asm volatile("" ::: "memory");
#pragma unroll
    for (int b = 0; b < 2; ++b) {
        const f32x4 va = ga * (1.0f + sa[b]), vb = gb * (1.0f + sb[b]);
        const float gv[8] = {va[0], va[1], va[2], va[3], vb[0], vb[1], vb[2], vb[3]};
#pragma unroll
        for (int j = 0; j < 4; ++j) { const int n = (lane >> 3) + 8 * j; const LAS float* s = scr + (8 * c) * 33 + n;
            v4u o; o.x = pk2(s[0 * 33] * gv[0], s[1 * 33] * gv[1]); o.y = pk2(s[2 * 33] * gv[2], s[3 * 33] * gv[3]); o.z = pk2(s[4 * 33] * gv[4], s[5 * 33] * gv[5]); o.w = pk2(s[6 * 33] * gv[6], s[7 * 33] * gv[7]);
            *(GAS v4u*)(WT + (size_t)b * copy_elems + (size_t)(drow0 + n) * D + k0 + 8 * c) = o; }
    }
    { const int n = lane & 31, b = lane >> 5; float a = 0.f;
#pragma unroll 16
      for (int kk = 0; kk < 64; ++kk) a += scr[kk * 33 + n] * shl[b * 64 + kk];
      atomicAdd(bias + (size_t)b * bstride + drow0 + n, a); }
    LDS_WAIT(); asm volatile("" ::: "memory");
}
__device__ __forceinline__ void p0b(Frame& F) {
    const float* MOD = (const float*)(F.ws + WS_MOD);
    const int gw = F.bid * NWAVES + F.wave, NGW = F.G * NWAVES;
    {
        LAS float* scr = (LAS float*)(F.lds + RING_OFF + F.wave * 12288);
        constexpr int I_13 = (D / 64) * (FF / 32), I_IN = (D / 64) * (NIN / 32);
        constexpr int NITEMS = 4 * I_13 + I_IN;
        for (int it = gw; it < NITEMS; it += NGW) {
            int r = it;
            if (r < 2 * I_13) { const int mat = r >= I_13; r -= mat * I_13; const int nblk = FF / 32, kb = r / nblk, nb = r % nblk, n0 = 32 * nb;
                p0_fold_item(mat ? FIN(6) : FIN(5), FF, (bf16*)(F.ws + WS_W13A), W13_COPY / 2, 64 * kb, n0, 256 * (n0 / 128) + 128 * mat + (n0 % 128), FIN(4), MOD + 1 * D, MOD + 0 * D, (float*)(F.ws + WS_BIAS1), 2 * FF, scr, F.lane); continue; }
            r -= 2 * I_13;
            if (r < 2 * I_13) { const int mat = r >= I_13; r -= mat * I_13; const int nblk = FF / 32, kb = r / nblk, nb = r % nblk, n0 = 32 * nb;
                p0_fold_item(mat ? FIN(28) : FIN(27), FF, (bf16*)(F.ws + WS_W13B), W13_COPY / 2, 64 * kb, n0, 256 * (n0 / 128) + 128 * mat + (n0 % 128), FIN(26), MOD + 7 * D, MOD + 6 * D, (float*)(F.ws + WS_BIAS3), 2 * FF, scr, F.lane); continue; }
            r -= 2 * I_13;
            { const int nblk = NIN / 32, kb = r / nblk, nb = r % nblk;
              p0_fold_item(FIN(9), NIN, (bf16*)(F.ws + WS_WIN), WIN_COPY / 2, 64 * kb, 32 * nb, 32 * nb, FIN(8), MOD + 4 * D, MOD + 3 * D, (float*)(F.ws + WS_BIAS2), NIN, scr, F.lane); }
        }
    }
}
__device__ __forceinline__ void final_norm_rows(Frame& F, const bf16* xb, float* out, const float* gain, const float* ssq) {
    const int gw = F.bid * NWAVES + F.wave, NGW = F.G * NWAVES;
    f32x4 g[4];
#pragma unroll
    for (int j = 0; j < 2; ++j) { g[2 * j] = *(const f32x4*)(gain + 512 * j + 8 * F.lane); g[2 * j + 1] = *(const f32x4*)(gain + 512 * j + 8 * F.lane + 4); }
    for (int m0 = gw; m0 < M; m0 += 4 * NGW) {
        v4u v[4][2]; float sq[4];
#pragma unroll
        for (int r = 0; r < 4; ++r) { const bf16* xr = xb + (size_t)(m0 + r * NGW) * D + 8 * F.lane; sq[r] = ssq[m0 + r * NGW]; v[r][0] = *(const v4u*)xr; v[r][1] = *(const v4u*)(xr + 512); }
#pragma unroll
        for (int r = 0; r < 4; ++r) { float* orow = out + (size_t)(m0 + r * NGW) * D + 8 * F.lane; const float rs = __builtin_amdgcn_rsqf(sq[r] * (1.f / D) + EPS);
#pragma unroll
            for (int j = 0; j < 2; ++j) { const v4u w = v[r][j];
                *(f32x4*)(orow + 512 * j) = (f32x4){bflo(w.x), bfhi(w.x), bflo(w.y), bfhi(w.y)} * rs * g[2 * j];
                *(f32x4*)(orow + 512 * j + 4) = (f32x4){bflo(w.z), bfhi(w.z), bflo(w.w), bfhi(w.w)} * rs * g[2 * j + 1]; } }
    }
}
__device__ __forceinline__ void hgrn2_naive(Frame& F, int ci) {
    const int dir = ci & 1, h = (ci >> 1) & 3, b = ci >> 3;
    LAS float* QS = (LAS float*)(F.lds + RING_OFF); LAS float* FS = QS + 2048; LAS float* KS = FS + 2048; LAS float* VS = KS + 2048; LAS float* PART = VS + 2048;
    const bf16* ZQ = (const bf16*)(F.ws + WS_ZQ); const bf16* ZV = (const bf16*)(F.ws + WS_ZV); const bf16* ZL = (const bf16*)(F.ws + (dir ? WS_ZLB : WS_ZLF));
    float* OF = (float*)(F.ws + WS_SG); bf16* OB = (bf16*)(F.ws + WS_OB);
    const int v = F.tid & 127, kq = F.tid >> 7;
    float S[32];
#pragma unroll
    for (int i = 0; i < 32; ++i) S[i] = 0.f;
    for (int tl = 0; tl < T / 16; ++tl) {
        { const int tt = F.tid >> 5, k4 = (F.tid & 31) * 4; const int p = 16 * tl + tt, t = dir ? (T - 1 - p) : p; const size_t off = (size_t)(b * T + t) * DH + h * 128 + k4;
          const uint2 qw = *(const uint2*)(ZQ + off); const uint2 vw = *(const uint2*)(ZV + off); const uint2 lw = *(const uint2*)(ZL + off); const f32x4 lg = {bflo(lw.x), bfhi(lw.x), bflo(lw.y), bfhi(lw.y)};
          LAS float* q = QS + tt * 128 + k4; q[0] = bflo(qw.x); q[1] = bfhi(qw.x); q[2] = bflo(qw.y); q[3] = bfhi(qw.y);
          LAS float* vv = VS + tt * 128 + k4; vv[0] = bflo(vw.x); vv[1] = bfhi(vw.x); vv[2] = bflo(vw.y); vv[3] = bfhi(vw.y);
#pragma unroll
          for (int j = 0; j < 4; ++j) { const float f = __builtin_amdgcn_exp2f(lg[j]); FS[tt * 128 + k4 + j] = f; KS[tt * 128 + k4 + j] = 1.0f - f; } }
        __syncthreads();
        for (int tt = 0; tt < 16; ++tt) { const float vv = VS[tt * 128 + v]; float a = 0.f; const LAS float* fp = FS + tt * 128 + 32 * kq; const LAS float* kp = KS + tt * 128 + 32 * kq; const LAS float* qp = QS + tt * 128 + 32 * kq;
#pragma unroll
            for (int kk = 0; kk < 32; ++kk) { S[kk] = fp[kk] * S[kk] + kp[kk] * vv; a += S[kk] * qp[kk]; }
            PART[(kq * 16 + tt) * 128 + v] = a; }
        __syncthreads();
        { const int tt = F.tid >> 5, v4 = (F.tid & 31) * 4; const int p = 16 * tl + tt, t = dir ? (T - 1 - p) : p; const size_t off = (size_t)(b * T + t) * DH + h * 128 + v4;
          f32x4 o = {0.f, 0.f, 0.f, 0.f};
#pragma unroll
          for (int q = 0; q < 4; ++q) o += *(const LAS f32x4*)(PART + (q * 16 + tt) * 128 + v4);
          if (dir == 0) *(f32x4*)(OF + off) = o; else { uint2 w; w.x = pk2(o[0], o[1]); w.y = pk2(o[2], o[3]); *(uint2*)(OB + off) = w; } }
    }
}
__device__ __forceinline__ void rglru_seg(Frame& F, int pass) {
    const int b = F.bid >> 7, blk = (F.bid >> 4) & 7, sg = F.bid & 15;
    LAS float* L = (LAS float*)(F.lds + RING_OFF);
    for (int i = F.tid; i < 4 * 4096; i += NWAVES * 64) { const int mat = i >> 12; const float* src = mat == 0 ? FIN(15) : mat == 1 ? FIN(17) : mat == 2 ? FIN(20) : FIN(22); L[i] = src[(size_t)blk * 4096 + (i & 4095)]; }
    __syncthreads();
    if (F.wave < 4) {
        const int seg = sg * 4 + F.wave, e = F.lane, ch = 64 * blk + e, t0 = seg * 256;
        const bf16* ZRX = (const bf16*)(F.ws + WS_ZRX); const bf16* ZRG = (const bf16*)(F.ws + WS_ZRG); bf16* YM = (bf16*)(F.ws + WS_XN);
        const float* CL = (const float*)(F.ws + WS_RGCL); float2* TOT = (float2*)(F.ws + WS_RGTOT);
        const float* cw = FIN(13); const float c0 = cw[ch], c1 = cw[DH + ch], c2 = cw[2 * DH + ch], c3 = cw[3 * DH + ch], cb = FIN(14)[ch];
        for (int dir = 0; dir < 2; ++dir) {
            const LAS float* wa = L + (2 * dir) * 4096 + e; const LAS float* wx = L + (2 * dir + 1) * 4096 + e;
            const float ba = (dir ? FIN(21) : FIN(16))[ch], bx = (dir ? FIN(23) : FIN(18))[ch], cl = CL[dir * DH + ch];
            float hs = 0.f, A = 1.f;
            if (pass == 1) {
                if (dir == 0) { for (int s = 0; s < seg; ++s) { const float2 tt = TOT[(size_t)((b * 64 + s) * 2 + 0) * DH + ch]; hs = tt.x * hs + tt.y; } }
                else { for (int s = 63; s > seg; --s) { const float2 tt = TOT[(size_t)((b * 64 + s) * 2 + 1) * DH + ch]; hs = tt.x * hs + tt.y; } }
            }
            for (int p = 0; p < 256; ++p) {
                const int t = dir ? (t0 + 255 - p) : (t0 + p); const size_t m = (size_t)b * T + t;
                const float x0 = t >= 2 ? bf2f(ZRX[(m - 2) * DH + ch]) : 0.f, x1 = t >= 1 ? bf2f(ZRX[(m - 1) * DH + ch]) : 0.f, x2 = bf2f(ZRX[m * DH + ch]), x3 = t + 1 < T ? bf2f(ZRX[(m + 1) * DH + ch]) : 0.f;
                const float xc = cb + c0 * x0 + c1 * x1 + c2 * x2 + c3 * x3;
                float rp = ba, ip = bx;
#pragma unroll 8
                for (int d = 0; d < 64; ++d) { const float xd = __shfl(xc, d); rp += xd * wa[d * 64]; ip += xd * wx[d * 64]; }
                const float r = sigmoidf_(rp), ii = sigmoidf_(ip), l2a = cl * r, a = __builtin_amdgcn_exp2f(l2a);
                const float u = sqrtf(fmaxf(1.0f - __builtin_amdgcn_exp2f(2.0f * l2a), 0.f)) * ii * xc;
                hs = a * hs + u; A *= a;
                if (pass == 1) { bf16* yp = YM + m * D + DH + ch;
                    if (dir == 0) *yp = (bf16)f2bf(hs); else *yp = (bf16)f2bf((bf2f(*yp) + hs) * bf2f(ZRG[m * DH + ch])); }
            }
            if (pass == 0) TOT[(size_t)((b * 64 + seg) * 2 + dir) * DH + ch] = make_float2(A, hs);
            asm volatile("s_waitcnt vmcnt(0)" ::: "memory");
        }
    }
    __syncthreads();
}
__device__ __forceinline__ void hgrn2_combine_rows(Frame& F) {
    const float* OF = (const float*)(F.ws + WS_SG); const bf16* OB = (const bf16*)(F.ws + WS_OB); const bf16* ZG = (const bf16*)(F.ws + WS_ZG); bf16* YM = (bf16*)(F.ws + WS_XN);
    const float* gn = FIN(12);
    const int gw = F.bid * NWAVES + F.wave, NGW = F.G * NWAVES;
    for (int m = gw; m < M; m += NGW) {
        const size_t off = (size_t)m * DH + 8 * F.lane;
        const f32x4 a0 = *(const f32x4*)(OF + off), a1 = *(const f32x4*)(OF + off + 4); const v4u bw = *(const v4u*)(OB + off), gwd = *(const v4u*)(ZG + off);
        float o[8] = {a0[0] + bflo(bw.x), a0[1] + bfhi(bw.x), a0[2] + bflo(bw.y), a0[3] + bfhi(bw.y), a1[0] + bflo(bw.z), a1[1] + bfhi(bw.z), a1[2] + bflo(bw.w), a1[3] + bfhi(bw.w)};
        float s = 0.f;
#pragma unroll
        for (int j = 0; j < 8; ++j) s += o[j] * o[j];
        s += __shfl_xor(s, 1); s += __shfl_xor(s, 2); s += __shfl_xor(s, 4); s += __shfl_xor(s, 8);
        const float rstd = rsqrtf(s * (1.f / 128.f) + EPS);
        const f32x4 g0 = *(const f32x4*)(gn + (8 * F.lane & 127)), g1 = *(const f32x4*)(gn + (8 * F.lane & 127) + 4);
        const float gg[8] = {bflo(gwd.x), bfhi(gwd.x), bflo(gwd.y), bfhi(gwd.y), bflo(gwd.z), bfhi(gwd.z), bflo(gwd.w), bfhi(gwd.w)};
        v4u w; w.x = pk2(o[0] * rstd * g0[0] * gg[0], o[1] * rstd * g0[1] * gg[1]); w.y = pk2(o[2] * rstd * g0[2] * gg[2], o[3] * rstd * g0[3] * gg[3]);
        w.z = pk2(o[4] * rstd * g1[0] * gg[4], o[5] * rstd * g1[1] * gg[5]); w.w = pk2(o[6] * rstd * g1[2] * gg[6], o[7] * rstd * g1[3] * gg[7]);
        *(v4u*)(YM + (size_t)m * D + 8 * F.lane) = w;
    }
}
namespace hg {
constexpr int QT = 0, KH = 8704, KT = 17408, VT = 27648, PB = 37888, ST = 40448, DEC = 75264, SEG = 75776, OT = 79872;
constexpr int RS = 272, TS = 80, OTS = 132;
typedef short bf16x8 __attribute__((ext_vector_type(8)));
typedef unsigned u32x2 __attribute__((ext_vector_type(2)));
typedef float f32x2 __attribute__((ext_vector_type(2)));
constexpr int NSC = 32, SCT = 512, NCH = 16;
constexpr size_t CARRY_OFF = 32 * MiB;
__device__ __forceinline__ int slot_of(int b, int h, int j, int dir) { return (((b * 4 + h) * NSC + j) * 2 + dir); }

template <int MODE>
__device__ __forceinline__ void pass(Frame& F, int b, int h, int j, int dir) {
    LAS unsigned char* L = F.lds + RING_OFF;
    const int tid = F.tid, lane = F.lane, w = F.wave, fr = lane & 15, fq = lane >> 4, cp = lane, ts = w;
    const bf16* ZQ = (const bf16*)(F.ws + WS_ZQ); const bf16* ZV = (const bf16*)(F.ws + WS_ZV); const bf16* ZL = (const bf16*)(F.ws + (dir ? WS_ZLB : WS_ZLF));
    float* SGp = (float*)(F.ws + WS_SG + (MODE != 0 ? CARRY_OFF : 0)) + (size_t)slot_of(b, h, j, dir) * 16384;
    const int colq = h * 128 + 2 * cp;
    auto mrow = [&](int c, int r) -> size_t { const int pos = 32 * c + r; return (size_t)b * T + (dir ? (SCT * j + SCT - 1 - pos) : (SCT * j + pos)); };
    STAMPX(F, 40);
    f32x4 s[8];
#pragma unroll
    for (int i = 0; i < 8; ++i) s[i] = (f32x4){0.f, 0.f, 0.f, 0.f};
    if (MODE != 0) {
#pragma unroll
        for (int i = 0; i < 8; ++i) { s[i] = *(const f32x4*)(SGp + (16 * w + fr) * 128 + 16 * i + 4 * fq);
            u32x2 pk; pk.x = pg8::cvt_pk_bf16(s[i][0], s[i][1]); pk.y = pg8::cvt_pk_bf16(s[i][2], s[i][3]);
            *(LAS u32x2*)(L + ST + (16 * w + fr) * RS + (16 * i + 4 * fq) * 2) = pk; }
    }
    float dsum0 = 0.f, dsum1 = 0.f;
    f32x4 g0 = {0.f, 0.f, 0.f, 0.f}, g1 = {0.f, 0.f, 0.f, 0.f};
    if (MODE == 2) { g0 = *(const f32x4*)(FIN(12) + 8 * (tid & 15)); g1 = *(const f32x4*)(FIN(12) + 8 * (tid & 15) + 4); }
    unsigned qA[4], vA[4], lA[4], qB[4], vB[4], lB[4];
    v4u obA = {0u, 0u, 0u, 0u}, gwA = {0u, 0u, 0u, 0u}, obB = {0u, 0u, 0u, 0u}, gwB = {0u, 0u, 0u, 0u};
    auto issue = [&](int c, unsigned (&q)[4], unsigned (&v)[4], unsigned (&l)[4]) {
#pragma unroll
        for (int r = 0; r < 4; ++r) { const size_t m = mrow(c, 4 * ts + r); q[r] = *(const unsigned*)(ZQ + m * DH + colq); v[r] = *(const unsigned*)(ZV + m * DH + colq); l[r] = *(const unsigned*)(ZL + m * DH + colq); } };
    auto issue_comb = [&](int c, v4u& ob, v4u& gw) { const size_t m = mrow(c, tid >> 4); ob = *(const v4u*)((const bf16*)(F.ws + WS_OB) + m * DH + h * 128 + 8 * (tid & 15)); gw = *(const v4u*)((const bf16*)(F.ws + WS_ZG) + m * DH + h * 128 + 8 * (tid & 15)); };
    issue(0, qA, vA, lA); issue(1, qB, vB, lB);
    if (MODE == 2) { issue_comb(0, obA, gwA); issue_comb(1, obB, gwB); }
    auto body = [&](int c, unsigned (&qX)[4], unsigned (&vX)[4], unsigned (&lX)[4], v4u& obX, v4u& gwX) {
        unsigned qc[4], vc[4]; float2 lc[4];
#pragma unroll
        for (int r = 0; r < 4; ++r) { qc[r] = qX[r]; vc[r] = vX[r]; lc[r] = make_float2(bflo(lX[r]), bfhi(lX[r])); }
        if (c < NCH - 2) issue(c + 2, qX, vX, lX);
        float cs0[4], cs1[4];
        cs0[0] = lc[0].x; cs1[0] = lc[0].y;
#pragma unroll
        for (int r = 1; r < 4; ++r) { cs0[r] = cs0[r - 1] + lc[r].x; cs1[r] = cs1[r - 1] + lc[r].y; }
        *(LAS f32x2*)(L + SEG + (ts * 128 + 2 * cp) * 4) = (f32x2){cs0[3], cs1[3]};
        __syncthreads();
        float pre0 = 0.f, pre1 = 0.f, tot0 = 0.f, tot1 = 0.f;
#pragma unroll
        for (int t2 = 0; t2 < 8; ++t2) { const f32x2 sv = *(const LAS f32x2*)(L + SEG + (t2 * 128 + 2 * cp) * 4); tot0 += sv.x; tot1 += sv.y; if (t2 < ts) { pre0 += sv.x; pre1 += sv.y; } }
        dsum0 += tot0; dsum1 += tot1;
        if (ts == 0) *(LAS f32x2*)(L + DEC + 2 * cp * 4) = (f32x2){__builtin_amdgcn_exp2f(tot0), __builtin_amdgcn_exp2f(tot1)};
        unsigned kt0[2], kt1[2];
        float kta[4], ktb[4];
#pragma unroll
        for (int r = 0; r < 4; ++r) {
            const float b0 = pre0 + cs0[r], b1 = pre1 + cs1[r];
            const float q0 = bflo(qc[r]), q1 = bfhi(qc[r]);
            const float k0 = 1.0f - __builtin_amdgcn_exp2f(lc[r].x), k1 = 1.0f - __builtin_amdgcn_exp2f(lc[r].y);
            const int row = 4 * ts + r;
            if (MODE != 0) {
                *(LAS unsigned*)(L + QT + row * RS + 4 * cp) = pg8::cvt_pk_bf16(q0 * __builtin_amdgcn_exp2f(b0), q1 * __builtin_amdgcn_exp2f(b1));
                *(LAS unsigned*)(L + KH + row * RS + 4 * cp) = pg8::cvt_pk_bf16(k0 * __builtin_amdgcn_exp2f(fminf(-b0, 126.f)), k1 * __builtin_amdgcn_exp2f(fminf(-b1, 126.f)));
            }
            kta[r] = k0 * __builtin_amdgcn_exp2f(tot0 - b0); ktb[r] = k1 * __builtin_amdgcn_exp2f(tot1 - b1);
        }
        kt0[0] = pg8::cvt_pk_bf16(kta[0], kta[1]); kt0[1] = pg8::cvt_pk_bf16(kta[2], kta[3]); kt1[0] = pg8::cvt_pk_bf16(ktb[0], ktb[1]); kt1[1] = pg8::cvt_pk_bf16(ktb[2], ktb[3]);
        *(LAS u32x2*)(L + KT + (2 * cp) * TS + 8 * ts) = (u32x2){kt0[0], kt0[1]};
        *(LAS u32x2*)(L + KT + (2 * cp + 1) * TS + 8 * ts) = (u32x2){kt1[0], kt1[1]};
        {
            const unsigned a0 = (vc[0] & 0xffffu) | (vc[1] << 16), a1 = (vc[2] & 0xffffu) | (vc[3] << 16);
            const unsigned c0 = (vc[0] >> 16) | (vc[1] & 0xffff0000u), c1 = (vc[2] >> 16) | (vc[3] & 0xffff0000u);
            *(LAS u32x2*)(L + VT + (2 * cp) * TS + 8 * ts) = (u32x2){a0, a1};
            *(LAS u32x2*)(L + VT + (2 * cp + 1) * TS + 8 * ts) = (u32x2){c0, c1};
        }
        __syncthreads();
        f32x4 o[2] = {(f32x4){0.f, 0.f, 0.f, 0.f}, (f32x4){0.f, 0.f, 0.f, 0.f}};
        if (MODE != 0) {
            f32x4 p = (f32x4){0.f, 0.f, 0.f, 0.f}; const int pmt = (w >> 1) & 1, pnt = w & 1;
#pragma unroll
            for (int ks = 0; ks < 4; ++ks) {
                const bf16x8 a0 = *(const LAS bf16x8*)(L + QT + (fr) * RS + (32 * ks + 8 * fq) * 2), a1 = *(const LAS bf16x8*)(L + QT + (16 + fr) * RS + (32 * ks + 8 * fq) * 2);
                const bf16x8 bs = *(const LAS bf16x8*)(L + ST + (16 * w + fr) * RS + (32 * ks + 8 * fq) * 2);
                o[0] = __builtin_amdgcn_mfma_f32_16x16x32_bf16(a0, bs, o[0], 0, 0, 0);
                o[1] = __builtin_amdgcn_mfma_f32_16x16x32_bf16(a1, bs, o[1], 0, 0, 0);
                if (w < 4) { const bf16x8 bk = *(const LAS bf16x8*)(L + KH + (16 * pnt + fr) * RS + (32 * ks + 8 * fq) * 2);
                    p = __builtin_amdgcn_mfma_f32_16x16x32_bf16(pmt ? a1 : a0, bk, p, 0, 0, 0); }
            }
            if (w < 4) {
#pragma unroll
                for (int rg = 0; rg < 4; ++rg) { const int t = 16 * pmt + 4 * fq + rg, sc = 16 * pnt + fr; const float pv = (sc <= t) ? p[rg] : 0.f;
                    *(LAS unsigned short*)(L + PB + t * TS + sc * 2) = (unsigned short)(pg8::cvt_pk_bf16(pv, 0.f) & 0xffffu); }
            }
            __syncthreads();
        }
        const bf16x8 bv = *(const LAS bf16x8*)(L + VT + (16 * w + fr) * TS + 16 * fq);
        if (MODE != 0) {
#pragma unroll
            for (int mt = 0; mt < 2; ++mt) { const bf16x8 ap = *(const LAS bf16x8*)(L + PB + (16 * mt + fr) * TS + 16 * fq);
                o[mt] = __builtin_amdgcn_mfma_f32_16x16x32_bf16(ap, bv, o[mt], 0, 0, 0);
#pragma unroll
                for (int rg = 0; rg < 4; ++rg) *(LAS float*)(L + OT + ((16 * mt + 4 * fq + rg) * OTS + 16 * w + fr) * 4) = o[mt][rg]; }
        }
#pragma unroll
        for (int i = 0; i < 8; ++i) {
            const f32x4 d4 = *(const LAS f32x4*)(L + DEC + (16 * i + 4 * fq) * 4);
            const bf16x8 ak = *(const LAS bf16x8*)(L + KT + (16 * i + fr) * TS + 16 * fq);
            s[i] = s[i] * d4;
            s[i] = __builtin_amdgcn_mfma_f32_16x16x32_bf16(ak, bv, s[i], 0, 0, 0);
            if (MODE != 0) { u32x2 pk; pk.x = pg8::cvt_pk_bf16(s[i][0], s[i][1]); pk.y = pg8::cvt_pk_bf16(s[i][2], s[i][3]);
                *(LAS u32x2*)(L + ST + (16 * w + fr) * RS + (16 * i + 4 * fq) * 2) = pk; }
        }
        __syncthreads();
        if (MODE != 0) {
            const int t = tid >> 4, vg = tid & 15; const size_t m = mrow(c, t);
            const f32x4 o0 = *(const LAS f32x4*)(L + OT + (t * OTS + 8 * vg) * 4), o1 = *(const LAS f32x4*)(L + OT + (t * OTS + 8 * vg + 4) * 4);
            if (MODE == 1) {
                v4u wv; wv.x = pg8::cvt_pk_bf16(o0[0], o0[1]); wv.y = pg8::cvt_pk_bf16(o0[2], o0[3]); wv.z = pg8::cvt_pk_bf16(o1[0], o1[1]); wv.w = pg8::cvt_pk_bf16(o1[2], o1[3]);
                *(v4u*)((bf16*)(F.ws + WS_OB) + m * DH + h * 128 + 8 * vg) = wv;
            } else {
                const v4u bw = obX, gwd = gwX;
                float ov[8] = {o0[0] + bflo(bw.x), o0[1] + bfhi(bw.x), o0[2] + bflo(bw.y), o0[3] + bfhi(bw.y), o1[0] + bflo(bw.z), o1[1] + bfhi(bw.z), o1[2] + bflo(bw.w), o1[3] + bfhi(bw.w)};
                float ss = 0.f;
#pragma unroll
                for (int q = 0; q < 8; ++q) ss += ov[q] * ov[q];
                ss += __builtin_bit_cast(float, __builtin_amdgcn_update_dpp(0, __builtin_bit_cast(int, ss), 0xB1, 0xF, 0xF, true));
                ss += __builtin_bit_cast(float, __builtin_amdgcn_update_dpp(0, __builtin_bit_cast(int, ss), 0x4E, 0xF, 0xF, true));
                ss += __builtin_bit_cast(float, __builtin_amdgcn_update_dpp(0, __builtin_bit_cast(int, ss), 0x141, 0xF, 0xF, true));
                ss += __builtin_bit_cast(float, __builtin_amdgcn_update_dpp(0, __builtin_bit_cast(int, ss), 0x140, 0xF, 0xF, true));
                const float rstd = __builtin_amdgcn_rsqf(ss * (1.f / 128.f) + EPS);
                const float gg[8] = {bflo(gwd.x), bfhi(gwd.x), bflo(gwd.y), bfhi(gwd.y), bflo(gwd.z), bfhi(gwd.z), bflo(gwd.w), bfhi(gwd.w)};
                v4u wv; wv.x = pg8::cvt_pk_bf16(ov[0] * rstd * g0[0] * gg[0], ov[1] * rstd * g0[1] * gg[1]); wv.y = pg8::cvt_pk_bf16(ov[2] * rstd * g0[2] * gg[2], ov[3] * rstd * g0[3] * gg[3]);
                wv.z = pg8::cvt_pk_bf16(ov[4] * rstd * g1[0] * gg[4], ov[5] * rstd * g1[1] * gg[5]); wv.w = pg8::cvt_pk_bf16(ov[6] * rstd * g1[2] * gg[6], ov[7] * rstd * g1[3] * gg[7]);
                *(v4u*)((bf16*)(F.ws + WS_XN) + m * D + h * 128 + 8 * vg) = wv;
            }
            if (MODE == 2 && c < NCH - 2) issue_comb(c + 2, obX, gwX);
        }
    };
    STAMPX(F, 41);
    for (int c = 0; c < NCH; c += 2) { body(c, qA, vA, lA, obA, gwA); if (c == 6) STAMPX(F, 43); body(c + 1, qB, vB, lB, obB, gwB); if (c == 6) STAMPX(F, 44); }
    STAMPX(F, 42);
    if (MODE == 0) {
#pragma unroll
        for (int i = 0; i < 8; ++i) *(f32x4*)(SGp + (16 * w + fr) * 128 + 16 * i + 4 * fq) = s[i];
        if (ts == 0) *(float2*)((float*)(F.ws + WS_DG) + (size_t)slot_of(b, h, j, dir) * 128 + 2 * cp) = make_float2(__builtin_amdgcn_exp2f(dsum0), __builtin_amdgcn_exp2f(dsum1));
    }
    asm volatile("s_waitcnt vmcnt(0)" ::: "memory");
    __syncthreads();
}

template <int MODE>
__device__ __forceinline__ void pass_pipe(Frame& F, int b, int h, int j, int dir) {
    constexpr int SETB = 38400, oQT = 0, oKH = 8704, oKT = 17408, oVT = 27648, oDEC = 37888;
    constexpr int pPB = 76800, pST = 79360, pSEG = 114176, pOT = 122368;
    LAS unsigned char* L = F.lds + RING_OFF;
    int t_ = threadIdx.x; asm volatile("" : "+v"(t_));
    const int tid = t_, lane = t_ & 63, w = F.wave, fr = lane & 15, fq = lane >> 4, cp = lane, ts = w;
    const bf16* ZQ = (const bf16*)(F.ws + WS_ZQ); const bf16* ZV = (const bf16*)(F.ws + WS_ZV); const bf16* ZL = (const bf16*)(F.ws + (dir ? WS_ZLB : WS_ZLF));
    const bf16* SGp = (const bf16*)(F.ws + WS_SG + CARRY_OFF) + (size_t)slot_of(b, h, j, dir) * 16384;
    const int colq = h * 128 + 2 * cp;
    auto mrow = [&](int c, int r) -> size_t { const int pos = 32 * c + r; return (size_t)b * T + (dir ? (SCT * j + SCT - 1 - pos) : (SCT * j + pos)); };
    f32x4 s[8];
#pragma unroll
    for (int i = 0; i < 8; ++i) { const u32x2 pk = *(const u32x2*)(SGp + (16 * w + fr) * 128 + 16 * i + 4 * fq);
        s[i] = (f32x4){bflo(pk.x), bfhi(pk.x), bflo(pk.y), bfhi(pk.y)};
        *(LAS u32x2*)(L + pST + (16 * w + fr) * RS + (16 * i + 4 * fq) * 2) = pk; }
    f32x4 g0 = {0.f, 0.f, 0.f, 0.f}, g1 = {0.f, 0.f, 0.f, 0.f};
    if (MODE == 2) { g0 = *(const f32x4*)(FIN(12) + 8 * (tid & 15)); g1 = *(const f32x4*)(FIN(12) + 8 * (tid & 15) + 4); }
    unsigned qA[4], vA[4], lA[4], qB[4], vB[4], lB[4];
    v4u obA = {0u, 0u, 0u, 0u}, gwA = {0u, 0u, 0u, 0u}, obB = {0u, 0u, 0u, 0u}, gwB = {0u, 0u, 0u, 0u};
    auto issue = [&](int c, unsigned (&q)[4], unsigned (&v)[4], unsigned (&l)[4]) {
#pragma unroll
        for (int r = 0; r < 4; ++r) { const size_t m = mrow(c, 4 * ts + r); q[r] = *(const unsigned*)(ZQ + m * DH + colq); v[r] = *(const unsigned*)(ZV + m * DH + colq); l[r] = *(const unsigned*)(ZL + m * DH + colq); } };
    auto issue_comb = [&](int c, v4u& ob, v4u& gw) { const size_t m = mrow(c, tid >> 4); ob = *(const v4u*)((const bf16*)(F.ws + WS_OB) + m * DH + h * 128 + 8 * (tid & 15)); gw = *(const v4u*)((const bf16*)(F.ws + WS_ZG) + m * DH + h * 128 + 8 * (tid & 15)); };
    auto seg_write = [&](const unsigned (&l)[4], int sb) { float t0 = 0.f, t1 = 0.f;
#pragma unroll
        for (int r = 0; r < 4; ++r) { t0 += bflo(l[r]); t1 += bfhi(l[r]); }
        *(LAS f32x2*)(L + pSEG + sb * 4096 + (ts * 128 + 2 * cp) * 4) = (f32x2){t0, t1}; };
    auto prep = [&](const unsigned (&q)[4], const unsigned (&v)[4], const unsigned (&l)[4], int so, int sb) {
        float2 lc[4]; float cs0[4], cs1[4];
#pragma unroll
        for (int r = 0; r < 4; ++r) lc[r] = make_float2(bflo(l[r]), bfhi(l[r]));
        cs0[0] = lc[0].x; cs1[0] = lc[0].y;
#pragma unroll
        for (int r = 1; r < 4; ++r) { cs0[r] = cs0[r - 1] + lc[r].x; cs1[r] = cs1[r - 1] + lc[r].y; }
        float pre0 = 0.f, pre1 = 0.f, tot0 = 0.f, tot1 = 0.f;
#pragma unroll
        for (int t2 = 0; t2 < 8; ++t2) { const f32x2 sv = *(const LAS f32x2*)(L + pSEG + sb * 4096 + (t2 * 128 + 2 * cp) * 4); tot0 += sv.x; tot1 += sv.y; if (t2 < ts) { pre0 += sv.x; pre1 += sv.y; } }
        if (ts == 0) *(LAS f32x2*)(L + so + oDEC + 2 * cp * 4) = (f32x2){__builtin_amdgcn_exp2f(tot0), __builtin_amdgcn_exp2f(tot1)};
        float kta[4], ktb[4];
#pragma unroll
        for (int r = 0; r < 4; ++r) {
            const float b0 = pre0 + cs0[r], b1 = pre1 + cs1[r];
            const float q0 = bflo(q[r]), q1 = bfhi(q[r]);
            const float k0 = 1.0f - __builtin_amdgcn_exp2f(lc[r].x), k1 = 1.0f - __builtin_amdgcn_exp2f(lc[r].y);
            const int row = 4 * ts + r;
            *(LAS unsigned*)(L + so + oQT + row * RS + 4 * cp) = pg8::cvt_pk_bf16(q0 * __builtin_amdgcn_exp2f(b0), q1 * __builtin_amdgcn_exp2f(b1));
            *(LAS unsigned*)(L + so + oKH + row * RS + 4 * cp) = pg8::cvt_pk_bf16(k0 * __builtin_amdgcn_exp2f(fminf(-b0, 126.f)), k1 * __builtin_amdgcn_exp2f(fminf(-b1, 126.f)));
            kta[r] = k0 * __builtin_amdgcn_exp2f(tot0 - b0); ktb[r] = k1 * __builtin_amdgcn_exp2f(tot1 - b1);
        }
        *(LAS u32x2*)(L + so + oKT + (2 * cp) * TS + 8 * ts) = (u32x2){pg8::cvt_pk_bf16(kta[0], kta[1]), pg8::cvt_pk_bf16(kta[2], kta[3])};
        *(LAS u32x2*)(L + so + oKT + (2 * cp + 1) * TS + 8 * ts) = (u32x2){pg8::cvt_pk_bf16(ktb[0], ktb[1]), pg8::cvt_pk_bf16(ktb[2], ktb[3])};
        *(LAS u32x2*)(L + so + oVT + (2 * cp) * TS + 8 * ts) = (u32x2){(v[0] & 0xffffu) | (v[1] << 16), (v[2] & 0xffffu) | (v[3] << 16)};
        *(LAS u32x2*)(L + so + oVT + (2 * cp + 1) * TS + 8 * ts) = (u32x2){(v[0] >> 16) | (v[1] & 0xffff0000u), (v[2] >> 16) | (v[3] & 0xffff0000u)};
    };
    auto stage1 = [&](int so, f32x4 (&o)[2]) {
        f32x4 p = (f32x4){0.f, 0.f, 0.f, 0.f}; const int pmt = (w >> 1) & 1, pnt = w & 1;
#pragma unroll
        for (int ks = 0; ks < 4; ++ks) {
            const bf16x8 a0 = *(const LAS bf16x8*)(L + so + oQT + (fr) * RS + (32 * ks + 8 * fq) * 2), a1 = *(const LAS bf16x8*)(L + so + oQT + (16 + fr) * RS + (32 * ks + 8 * fq) * 2);
            const bf16x8 bs = *(const LAS bf16x8*)(L + pST + (16 * w + fr) * RS + (32 * ks + 8 * fq) * 2);
            o[0] = __builtin_amdgcn_mfma_f32_16x16x32_bf16(bs, a0, o[0], 0, 0, 0);
            o[1] = __builtin_amdgcn_mfma_f32_16x16x32_bf16(bs, a1, o[1], 0, 0, 0);
            if (w < 4) { const bf16x8 bk = *(const LAS bf16x8*)(L + so + oKH + (16 * pnt + fr) * RS + (32 * ks + 8 * fq) * 2);
                p = __builtin_amdgcn_mfma_f32_16x16x32_bf16(pmt ? a1 : a0, bk, p, 0, 0, 0); }
        }
        if (w < 4) {
#pragma unroll
            for (int rg = 0; rg < 4; ++rg) { const int t = 16 * pmt + 4 * fq + rg, sc = 16 * pnt + fr; const float pv = (sc <= t) ? p[rg] : 0.f;
                *(LAS unsigned short*)(L + pPB + t * TS + sc * 2) = (unsigned short)(pg8::cvt_pk_bf16(pv, 0.f) & 0xffffu); }
        }
    };
    auto stage2 = [&](int so, f32x4 (&o)[2]) {
        const bf16x8 bv = *(const LAS bf16x8*)(L + so + oVT + (16 * w + fr) * TS + 16 * fq);
#pragma unroll
        for (int mt = 0; mt < 2; ++mt) { const bf16x8 ap = *(const LAS bf16x8*)(L + pPB + (16 * mt + fr) * TS + 16 * fq);
            o[mt] = __builtin_amdgcn_mfma_f32_16x16x32_bf16(bv, ap, o[mt], 0, 0, 0);
            *(LAS f32x4*)(L + pOT + ((16 * mt + fr) * OTS + 16 * w + 4 * fq) * 4) = o[mt]; }
#pragma unroll
        for (int i = 0; i < 8; ++i) {
            const f32x4 d4 = *(const LAS f32x4*)(L + so + oDEC + (16 * i + 4 * fq) * 4);
            const bf16x8 ak = *(const LAS bf16x8*)(L + so + oKT + (16 * i + fr) * TS + 16 * fq);
            s[i] = s[i] * d4;
            s[i] = __builtin_amdgcn_mfma_f32_16x16x32_bf16(ak, bv, s[i], 0, 0, 0);
            u32x2 pk; pk.x = pg8::cvt_pk_bf16(s[i][0], s[i][1]); pk.y = pg8::cvt_pk_bf16(s[i][2], s[i][3]);
            *(LAS u32x2*)(L + pST + (16 * w + fr) * RS + (16 * i + 4 * fq) * 2) = pk;
        }
    };
    auto combine = [&](int c, const v4u& obX, const v4u& gwX) {
        const int t = tid >> 4, vg = tid & 15; const size_t m = mrow(c, t);
        const f32x4 o0 = *(const LAS f32x4*)(L + pOT + (t * OTS + 8 * vg) * 4), o1 = *(const LAS f32x4*)(L + pOT + (t * OTS + 8 * vg + 4) * 4);
        if (MODE == 1) {
            v4u wv; wv.x = pg8::cvt_pk_bf16(o0[0], o0[1]); wv.y = pg8::cvt_pk_bf16(o0[2], o0[3]); wv.z = pg8::cvt_pk_bf16(o1[0], o1[1]); wv.w = pg8::cvt_pk_bf16(o1[2], o1[3]);
            *(v4u*)((bf16*)(F.ws + WS_OB) + m * DH + h * 128 + 8 * vg) = wv;
        } else {
            const v4u bw = obX, gwd = gwX;
            float ov[8] = {o0[0] + bflo(bw.x), o0[1] + bfhi(bw.x), o0[2] + bflo(bw.y), o0[3] + bfhi(bw.y), o1[0] + bflo(bw.z), o1[1] + bfhi(bw.z), o1[2] + bflo(bw.w), o1[3] + bfhi(bw.w)};
            float ss = 0.f;
#pragma unroll
            for (int q = 0; q < 8; ++q) ss += ov[q] * ov[q];
            ss += __builtin_bit_cast(float, __builtin_amdgcn_update_dpp(0, __builtin_bit_cast(int, ss), 0xB1, 0xF, 0xF, true));
            ss += __builtin_bit_cast(float, __builtin_amdgcn_update_dpp(0, __builtin_bit_cast(int, ss), 0x4E, 0xF, 0xF, true));
            ss += __builtin_bit_cast(float, __builtin_amdgcn_update_dpp(0, __builtin_bit_cast(int, ss), 0x141, 0xF, 0xF, true));
            ss += __builtin_bit_cast(float, __builtin_amdgcn_update_dpp(0, __builtin_bit_cast(int, ss), 0x140, 0xF, 0xF, true));
            const float rstd = __builtin_amdgcn_rsqf(ss * (1.f / 128.f) + EPS);
            const float gg[8] = {bflo(gwd.x), bfhi(gwd.x), bflo(gwd.y), bfhi(gwd.y), bflo(gwd.z), bfhi(gwd.z), bflo(gwd.w), bfhi(gwd.w)};
            v4u wv; wv.x = pg8::cvt_pk_bf16(ov[0] * rstd * g0[0] * gg[0], ov[1] * rstd * g0[1] * gg[1]); wv.y = pg8::cvt_pk_bf16(ov[2] * rstd * g0[2] * gg[2], ov[3] * rstd * g0[3] * gg[3]);
            wv.z = pg8::cvt_pk_bf16(ov[4] * rstd * g1[0] * gg[4], ov[5] * rstd * g1[1] * gg[5]); wv.w = pg8::cvt_pk_bf16(ov[6] * rstd * g1[2] * gg[6], ov[7] * rstd * g1[3] * gg[7]);
            *(v4u*)((bf16*)(F.ws + WS_XN) + m * D + h * 128 + 8 * vg) = wv;
        }
    };
    issue(0, qA, vA, lA); issue(1, qB, vB, lB);
    if (MODE == 2) { issue_comb(0, obA, gwA); issue_comb(1, obB, gwB); }
    seg_write(lA, 0); seg_write(lB, 1);
    __syncthreads();
    prep(qA, vA, lA, 0, 0); issue(2, qA, vA, lA);
    __syncthreads();
    auto step = [&](int c, int so, int sn, unsigned (&qX)[4], unsigned (&vX)[4], unsigned (&lX)[4], unsigned (&qY)[4], unsigned (&vY)[4], unsigned (&lY)[4], v4u& obP, v4u& gwP) {
        f32x4 o[2] = {(f32x4){0.f, 0.f, 0.f, 0.f}, (f32x4){0.f, 0.f, 0.f, 0.f}};
        stage1(so, o);
        if (c > 0) { combine(c - 1, obP, gwP); if (MODE == 2 && c + 1 < NCH) issue_comb(c + 1, obP, gwP); }
        if (c + 2 < NCH) seg_write(lX, c & 1);
        __syncthreads();
        stage2(so, o);
        if (c + 1 < NCH) { prep(qY, vY, lY, sn, (c + 1) & 1); if (c + 3 < NCH) issue(c + 3, qY, vY, lY); }
        __syncthreads();
    };
    for (int c = 0; c < NCH; c += 2) {
        step(c, 0, SETB, qA, vA, lA, qB, vB, lB, obB, gwB);
        step(c + 1, SETB, 0, qB, vB, lB, qA, vA, lA, obA, gwA);
    }
    combine(NCH - 1, obB, gwB);
    asm volatile("s_waitcnt vmcnt(0)" ::: "memory");
    __syncthreads();
}

__device__ __forceinline__ void pass0_direct(Frame& F, int b, int h, int j, int dir) {
    constexpr int KT2 = 0, VT2 = 34816, SEG2 = 69632;
    LAS unsigned char* L = F.lds + RING_OFF;
    const int lane = F.lane, w = F.wave, fr = lane & 15, fq = lane >> 4, cp = lane, ts = w;
    const bf16* ZV = (const bf16*)(F.ws + WS_ZV); const bf16* ZL = (const bf16*)(F.ws + (dir ? WS_ZLB : WS_ZLF));
    const int colq = h * 128 + 2 * cp;
    auto mrow = [&](int pos) -> size_t { return (size_t)b * T + (dir ? (SCT * j + SCT - 1 - pos) : (SCT * j + pos)); };
    f32x4 s[8];
#pragma unroll
    for (int i = 0; i < 8; ++i) s[i] = (f32x4){0.f, 0.f, 0.f, 0.f};
    float c0 = 0.f, c1 = 0.f;
    unsigned ln[16], vn[16];
#pragma unroll
    for (int r = 0; r < 16; ++r) { const size_t m = mrow(SCT - 128 + 16 * ts + r); ln[r] = *(const unsigned*)(ZL + m * DH + colq); vn[r] = *(const unsigned*)(ZV + m * DH + colq); }
    for (int blk = SCT / 128 - 1; blk >= 0; --blk) {
        float l0[16], l1[16]; unsigned vc[16];
#pragma unroll
        for (int r = 0; r < 16; ++r) { l0[r] = bflo(ln[r]); l1[r] = bfhi(ln[r]); vc[r] = vn[r]; }
        if (blk > 0) {
#pragma unroll
            for (int r = 0; r < 16; ++r) { const size_t m = mrow(128 * (blk - 1) + 16 * ts + r); ln[r] = *(const unsigned*)(ZL + m * DH + colq); vn[r] = *(const unsigned*)(ZV + m * DH + colq); }
        }
        float t0 = 0.f, t1 = 0.f;
#pragma unroll
        for (int r = 0; r < 16; ++r) { t0 += l0[r]; t1 += l1[r]; }
        *(LAS f32x2*)(L + SEG2 + (ts * 128 + 2 * cp) * 4) = (f32x2){t0, t1};
        __syncthreads();
        float a0 = c0, a1 = c1, tt0 = 0.f, tt1 = 0.f;
#pragma unroll
        for (int t2 = 0; t2 < 8; ++t2) { const f32x2 sv = *(const LAS f32x2*)(L + SEG2 + (t2 * 128 + 2 * cp) * 4); tt0 += sv.x; tt1 += sv.y; if (t2 > ts) { a0 += sv.x; a1 += sv.y; } }
        c0 += tt0; c1 += tt1;
        float k0v[16], k1v[16];
        float e0 = __builtin_amdgcn_exp2f(a0), e1 = __builtin_amdgcn_exp2f(a1);
#pragma unroll
        for (int r = 15; r >= 0; --r) {
            const float f0 = __builtin_amdgcn_exp2f(l0[r]), f1 = __builtin_amdgcn_exp2f(l1[r]);
            const float n0 = e0 * f0, n1 = e1 * f1;
            k0v[r] = e0 - n0; k1v[r] = e1 - n1; e0 = n0; e1 = n1; }
        v4u w0, w1;
#pragma unroll
        for (int hh = 0; hh < 2; ++hh) {
            w0.x = pg8::cvt_pk_bf16(k0v[8 * hh + 0], k0v[8 * hh + 1]); w0.y = pg8::cvt_pk_bf16(k0v[8 * hh + 2], k0v[8 * hh + 3]); w0.z = pg8::cvt_pk_bf16(k0v[8 * hh + 4], k0v[8 * hh + 5]); w0.w = pg8::cvt_pk_bf16(k0v[8 * hh + 6], k0v[8 * hh + 7]);
            w1.x = pg8::cvt_pk_bf16(k1v[8 * hh + 0], k1v[8 * hh + 1]); w1.y = pg8::cvt_pk_bf16(k1v[8 * hh + 2], k1v[8 * hh + 3]); w1.z = pg8::cvt_pk_bf16(k1v[8 * hh + 4], k1v[8 * hh + 5]); w1.w = pg8::cvt_pk_bf16(k1v[8 * hh + 6], k1v[8 * hh + 7]);
            *(LAS v4u*)(L + KT2 + (2 * cp) * RS + (16 * ts + 8 * hh) * 2) = w0; *(LAS v4u*)(L + KT2 + (2 * cp + 1) * RS + (16 * ts + 8 * hh) * 2) = w1;
            v4u x0, x1;
            x0.x = (vc[8 * hh + 0] & 0xffffu) | (vc[8 * hh + 1] << 16); x0.y = (vc[8 * hh + 2] & 0xffffu) | (vc[8 * hh + 3] << 16); x0.z = (vc[8 * hh + 4] & 0xffffu) | (vc[8 * hh + 5] << 16); x0.w = (vc[8 * hh + 6] & 0xffffu) | (vc[8 * hh + 7] << 16);
            x1.x = (vc[8 * hh + 0] >> 16) | (vc[8 * hh + 1] & 0xffff0000u); x1.y = (vc[8 * hh + 2] >> 16) | (vc[8 * hh + 3] & 0xffff0000u); x1.z = (vc[8 * hh + 4] >> 16) | (vc[8 * hh + 5] & 0xffff0000u); x1.w = (vc[8 * hh + 6] >> 16) | (vc[8 * hh + 7] & 0xffff0000u);
            *(LAS v4u*)(L + VT2 + (2 * cp) * RS + (16 * ts + 8 * hh) * 2) = x0; *(LAS v4u*)(L + VT2 + (2 * cp + 1) * RS + (16 * ts + 8 * hh) * 2) = x1;
        }
        __syncthreads();
#pragma unroll
        for (int ks = 0; ks < 4; ++ks) {
            const bf16x8 bv = *(const LAS bf16x8*)(L + VT2 + (16 * w + fr) * RS + (32 * ks + 8 * fq) * 2);
#pragma unroll
            for (int i = 0; i < 8; ++i) { const bf16x8 ak = *(const LAS bf16x8*)(L + KT2 + (16 * i + fr) * RS + (32 * ks + 8 * fq) * 2);
                s[i] = __builtin_amdgcn_mfma_f32_16x16x32_bf16(ak, bv, s[i], 0, 0, 0); }
        }
        __syncthreads();
    }
    bf16* SGp = (bf16*)(F.ws + WS_SG) + (size_t)slot_of(b, h, j, dir) * 16384;
#pragma unroll
    for (int i = 0; i < 8; ++i) *(u32x2*)(SGp + (16 * w + fr) * 128 + 16 * i + 4 * fq) = (u32x2){pg8::cvt_pk_bf16(s[i][0], s[i][1]), pg8::cvt_pk_bf16(s[i][2], s[i][3])};
    if (ts == 0) *(float2*)((float*)(F.ws + WS_DG) + (size_t)slot_of(b, h, j, dir) * 128 + 2 * cp) = make_float2(__builtin_amdgcn_exp2f(c0), __builtin_amdgcn_exp2f(c1));
    asm volatile("s_waitcnt vmcnt(0)" ::: "memory");
    __syncthreads();
}
__device__ __forceinline__ void pass2(Frame& F) {
    const unsigned* SU = (const unsigned*)(F.ws + WS_SG); unsigned* SC = (unsigned*)(F.ws + WS_SG + CARRY_OFF); const float* DG = (const float*)(F.ws + WS_DG);
    const int gt = F.bid * (NWAVES * 64) + F.tid, NT = F.G * NWAVES * 64;
    for (int i = gt; i < 16 * 8192; i += NT) {
        const int chain = i >> 13, e2 = i & 8191, dir = chain & 1, bh = chain >> 1, k0 = (2 * e2) & 127;
        f32x2 carry = (f32x2){0.f, 0.f};
        for (int st0 = 0; st0 < NSC; st0 += 16) {
            unsigned u[16]; f32x2 d[16];
#pragma unroll
            for (int q = 0; q < 16; ++q) { const int jj = dir ? NSC - 1 - (st0 + q) : (st0 + q); const size_t sl = (size_t)((bh * NSC + jj) * 2 + dir);
                u[q] = SU[sl * 8192 + e2]; d[q] = *(const f32x2*)(DG + sl * 128 + k0); }
#pragma unroll
            for (int q = 0; q < 16; ++q) { const int jj = dir ? NSC - 1 - (st0 + q) : (st0 + q); const size_t sl = (size_t)((bh * NSC + jj) * 2 + dir);
                SC[sl * 8192 + e2] = pg8::cvt_pk_bf16(carry.x, carry.y); carry = d[q] * carry + (f32x2){bflo(u[q]), bfhi(u[q])}; }
        }
    }
}
}
namespace rg {
#ifndef FIX_BATCH
#define FIX_BATCH 8
#endif
typedef short bf16x8 __attribute__((ext_vector_type(8)));
constexpr int XCS = 144, XCB = 256 * XCS + 256;
constexpr int OUTT = 2 * XCB, OTS = 272;
constexpr size_t WS_CIN = WS_DG + 512 * 1024;
constexpr size_t WS_RGSUB = 496 * MiB;

template <int DIR>
__device__ __forceinline__ void group_prefix(float Ag, float Hg, float& EA, float& EH, float& TA, float& TH, int lane) {
    const int g = lane >> 4; EA = 1.f; EH = 0.f;
#pragma unroll
    for (int rnd = 1; rnd < 4; ++rnd) {
        const float ca = Ag * EA, chh = Ag * EH + Hg;
        const float na = DIR == 0 ? __shfl_up(ca, 16) : __shfl_down(ca, 16), nh = DIR == 0 ? __shfl_up(chh, 16) : __shfl_down(chh, 16);
        const bool take = DIR == 0 ? (g == rnd) : (g == 3 - rnd);
        EA = take ? na : EA; EH = take ? nh : EH;
    }
    const int last = DIR == 0 ? 48 + (lane & 15) : (lane & 15);
    TA = __shfl(Ag * EA, last); TH = __shfl(Ag * EH + Hg, last);
}
template <int PASS>
__device__ __forceinline__ void item(Frame& F, int b, int j, int bp) {
    LAS unsigned char* L = F.lds + RING_OFF;
    const int tid = F.tid, lane = F.lane, w = F.wave, fr = lane & 15, fq = lane >> 4;
    const bf16* ZRX = (const bf16*)(F.ws + WS_ZRX);
    const int t0 = 256 * j;
    STAMPX(F, 30);
    const int blk = 2 * bp + (w >> 2), nt = w & 3, e = 16 * nt + fr, ch = 64 * blk + e, ss = 4 * j + fq;
    const bf16* RGW = (const bf16*)(F.ws + WS_RGW);
    const float* CL = (const float*)(F.ws + WS_RGCL);
    float2* TOT = (float2*)(F.ws + WS_RGSUB); float2* TSEG = (float2*)(F.ws + WS_RGTOT); const float* CIN = (const float*)(F.ws + WS_CIN);
    bf16x8 wa_[2][2], wx_[2][2]; float ba_[2], bx_[2], cl_[2]; float2 mine_[2] = {make_float2(1.f, 0.f), make_float2(1.f, 0.f)}; float cseg_[2] = {0.f, 0.f};
#pragma unroll
    for (int dir = 0; dir < 2; ++dir) {
#pragma unroll
        for (int ks = 0; ks < 2; ++ks) { wa_[dir][ks] = *(const bf16x8*)(RGW + (size_t)(((2 * dir) * 8 + blk) * 64 + e) * 64 + 32 * ks + 8 * fq); wx_[dir][ks] = *(const bf16x8*)(RGW + (size_t)(((2 * dir + 1) * 8 + blk) * 64 + e) * 64 + 32 * ks + 8 * fq); }
        ba_[dir] = (dir ? FIN(21) : FIN(16))[ch] * -1.44269504f; bx_[dir] = (dir ? FIN(23) : FIN(18))[ch] * -1.44269504f; cl_[dir] = CL[dir * DH + ch];
        if (PASS == 1) { mine_[dir] = TOT[(size_t)((b * 256 + ss) * 2 + dir) * DH + ch]; cseg_[dir] = CIN[(size_t)((b * 64 + j) * 2 + dir) * DH + ch]; }
    }
    v4u gt[8];
    if (PASS == 1) { const bf16* ZRG = (const bf16*)(F.ws + WS_ZRG);
#pragma unroll
        for (int q = 0; q < 8; ++q) { const int c16 = tid + 512 * q, tt = c16 >> 4, cc = c16 & 15; gt[q] = *(const v4u*)(ZRG + ((size_t)b * T + t0 + tt) * DH + 128 * bp + 8 * cc); } }
    {
        const int cp = lane, tg = w, cg = 128 * bp + 2 * cp;
        const float* cw = FIN(13); const float* cbp = FIN(14);
        const int tb = t0 + 32 * tg;
        unsigned x[35];
#pragma unroll
        for (int q = 0; q < 35; ++q) { const int t = tb + q - 2, tc = t < 0 ? 0 : (t >= T ? T - 1 : t); x[q] = *(const unsigned*)(ZRX + ((size_t)b * T + tc) * DH + cg); }
#pragma unroll
        for (int q = 0; q < 35; ++q) { const int t = tb + q - 2; x[q] = (t >= 0 && t < T) ? x[q] : 0u; }
        const float w00 = cw[cg], w01 = cw[cg + 1], w10 = cw[DH + cg], w11 = cw[DH + cg + 1], w20 = cw[2 * DH + cg], w21 = cw[2 * DH + cg + 1], w30 = cw[3 * DH + cg], w31 = cw[3 * DH + cg + 1], cb0 = cbp[cg], cb1 = cbp[cg + 1];
        LAS unsigned char* dst = L + (cp >> 5) * XCB + (32 * tg) * XCS + 64 * (tg >> 1) + 4 * (cp & 31);
#pragma unroll
        for (int q = 0; q < 32; ++q) {
            const float y0 = cb0 + w00 * bflo(x[q]) + w10 * bflo(x[q + 1]) + w20 * bflo(x[q + 2]) + w30 * bflo(x[q + 3]);
            const float y1 = cb1 + w01 * bfhi(x[q]) + w11 * bfhi(x[q + 1]) + w21 * bfhi(x[q + 2]) + w31 * bfhi(x[q + 3]);
            *(LAS unsigned*)(dst + q * XCS) = pg8::cvt_pk_bf16(y0, y1);
        }
    }
    __syncthreads();
    STAMPX(F, 31);
    const LAS unsigned char* XA = L + (w >> 2) * XCB + (64 * (fr >> 2) + (fr & 3)) * XCS + 64 * (fr >> 2) + 16 * fq;
    bf16x8 idf[2];
#pragma unroll
    for (int ks = 0; ks < 2; ++ks)
#pragma unroll
        for (int q = 0; q < 8; ++q) idf[ks][q] = (32 * ks + 8 * fq + q == e) ? (short)0x3F80 : (short)0;
#pragma unroll
    for (int dir = 0; dir < 2; ++dir) {
        const bf16x8 wa[2] = {wa_[dir][0], wa_[dir][1]}, wx[2] = {wx_[dir][0], wx_[dir][1]}; const float ba = ba_[dir], bx = bx_[dir], cl = cl_[dir];
        float carry = 0.f, atot = 1.f;
        if (PASS == 1) {
            const float2 mine = mine_[dir]; const float cseg = cseg_[dir];
            float EA, EH, TA, TH;
            if (dir == 0) group_prefix<0>(mine.x, mine.y, EA, EH, TA, TH, lane); else group_prefix<1>(mine.x, mine.y, EA, EH, TA, TH, lane);
            carry = EA * cseg + EH;
        }
        LAS unsigned char* const ot = L + OUTT + (64 * fq) * OTS + 64 * fq + 128 * (w >> 2) + 2 * e;
        const __amdgpu_buffer_rsrc_t locr = __builtin_amdgcn_make_buffer_rsrc((void*)((unsigned*)F.out + (size_t)dir * ((size_t)M * DH)), (short)0, (int)(M * DH * 4), 0x00020000);
        const unsigned locv = (unsigned)((((size_t)b * T + t0 + 64 * fq) * DH + ch) * 4);
#pragma unroll 2
        for (int mi = 0; mi < 16; ++mi) {
            const int mt = dir ? 15 - mi : mi;
            const bf16x8 a0 = *(const LAS bf16x8*)(XA + (4 * mt) * XCS), a1 = *(const LAS bf16x8*)(XA + (4 * mt) * XCS + 64);
            f32x4 cr = {ba, ba, ba, ba}, ci = {bx, bx, bx, bx}, cx = {0.f, 0.f, 0.f, 0.f};
            cr = __builtin_amdgcn_mfma_f32_16x16x32_bf16(a0, wa[0], cr, 0, 0, 0); cr = __builtin_amdgcn_mfma_f32_16x16x32_bf16(a1, wa[1], cr, 0, 0, 0);
            ci = __builtin_amdgcn_mfma_f32_16x16x32_bf16(a0, wx[0], ci, 0, 0, 0); ci = __builtin_amdgcn_mfma_f32_16x16x32_bf16(a1, wx[1], ci, 0, 0, 0);
            cx = __builtin_amdgcn_mfma_f32_16x16x32_bf16(a0, idf[0], cx, 0, 0, 0); cx = __builtin_amdgcn_mfma_f32_16x16x32_bf16(a1, idf[1], cx, 0, 0, 0);
            float hv[4];
#pragma unroll
            for (int q = 0; q < 4; ++q) {
                const int r = dir ? 3 - q : q;
                const float rr = __builtin_amdgcn_rcpf(1.0f + __builtin_amdgcn_exp2f(cr[r])), ii = __builtin_amdgcn_rcpf(1.0f + __builtin_amdgcn_exp2f(ci[r])), l2a = cl * rr;
                const float av = __builtin_amdgcn_exp2f(l2a), uv = __builtin_amdgcn_sqrtf(__builtin_fmaf(-av, av, 1.0f)) * ii * cx[r];
                carry = av * carry + uv; atot *= av; hv[r] = carry;
                if (PASS == 0) __builtin_amdgcn_raw_buffer_store_b32(pg8::cvt_pk_bf16(carry, atot), locr, locv + (unsigned)(r * DH * 4), (unsigned)(mt * 4 * DH * 4), 0);
            }
            if (PASS == 1) {
#pragma unroll
                for (int r = 0; r < 4; ++r) { LAS unsigned short* p = (LAS unsigned short*)(ot + (4 * mt + r) * OTS);
                    const float hsum = dir == 0 ? hv[r] : hv[r] + bf2f(*p);
                    *p = (unsigned short)(pg8::cvt_pk_bf16(hsum, 0.f) & 0xffffu); }
            }
        }
        if (PASS == 0) {
            TOT[(size_t)((b * 256 + ss) * 2 + dir) * DH + ch] = make_float2(atot, carry);
            float EA, EH, TA, TH;
            if (dir == 0) group_prefix<0>(atot, carry, EA, EH, TA, TH, lane); else group_prefix<1>(atot, carry, EA, EH, TA, TH, lane);
            if (fq == 0) TSEG[(size_t)((b * 64 + j) * 2 + dir) * DH + ch] = make_float2(TA, TH);
        }
    }
    STAMPX(F, 32);
    __syncthreads();
    STAMPX(F, 33);
    if (PASS == 1) {
        bf16* YM = (bf16*)(F.ws + WS_XN);
#pragma unroll
        for (int q = 0; q < 8; ++q) { const int c16 = tid + 512 * q, tt = c16 >> 4, cc = c16 & 15;
            const v4u hw = *(const LAS v4u*)(L + OUTT + tt * OTS + 64 * (tt >> 6) + 16 * cc);
            v4u o; o.x = pg8::cvt_pk_bf16(bflo(hw.x) * bflo(gt[q].x), bfhi(hw.x) * bfhi(gt[q].x)); o.y = pg8::cvt_pk_bf16(bflo(hw.y) * bflo(gt[q].y), bfhi(hw.y) * bfhi(gt[q].y));
            o.z = pg8::cvt_pk_bf16(bflo(hw.z) * bflo(gt[q].z), bfhi(hw.z) * bfhi(gt[q].z)); o.w = pg8::cvt_pk_bf16(bflo(hw.w) * bflo(gt[q].w), bfhi(hw.w) * bfhi(gt[q].w));
            *(v4u*)(YM + ((size_t)b * T + t0 + tt) * D + DH + 128 * bp + 8 * cc) = o; }
        __syncthreads();
    }
    STAMPX(F, 34);
}
__device__ __forceinline__ void fix(Frame& F, int b, int j, int bp) {
    LAS float* CAR = (LAS float*)(F.lds + RING_OFF);
    int t_ = threadIdx.x; asm volatile("" : "+v"(t_));
    const int tid = t_, t0 = 256 * j;
    const float2* TOT = (const float2*)(F.ws + WS_RGSUB); const float* CIN = (const float*)(F.ws + WS_CIN);
    const unsigned* L0 = (const unsigned*)F.out; const unsigned* L1 = L0 + (size_t)M * DH;
    const bf16* ZRG = (const bf16*)(F.ws + WS_ZRG); bf16* YM = (bf16*)(F.ws + WS_XN);
    constexpr int NB = FIX_BATCH;
    v4u lf[NB][2], lb[NB][2], gt[NB];
    auto issue = [&](int hb) {
#pragma unroll
        for (int q = 0; q < NB; ++q) { const int p = tid + 512 * (NB * hb + q), tt = p >> 4, cc = p & 15; const size_t m = (size_t)b * T + t0 + tt;
            const v4u* pf = (const v4u*)(L0 + m * DH + 128 * bp + 8 * cc); const v4u* pb = (const v4u*)(L1 + m * DH + 128 * bp + 8 * cc);
            lf[q][0] = pf[0]; lf[q][1] = pf[1]; lb[q][0] = pb[0]; lb[q][1] = pb[1]; gt[q] = *(const v4u*)(ZRG + m * DH + 128 * bp + 8 * cc); } };
    issue(0);
    if (tid < 256) { const int dir = tid >> 7, c = tid & 127, ch = 128 * bp + c;
        float2 tt[4];
#pragma unroll
        for (int g = 0; g < 4; ++g) tt[g] = TOT[(size_t)((b * 256 + 4 * j + g) * 2 + dir) * DH + ch];
        float cv = CIN[(size_t)((b * 64 + j) * 2 + dir) * DH + ch];
#pragma unroll
        for (int q = 0; q < 4; ++q) { const int g = dir ? 3 - q : q; CAR[(dir * 4 + g) * 128 + c] = cv; cv = tt[g].x * cv + tt[g].y; }
    }
    __syncthreads();
#pragma unroll
    for (int hb = 0; hb < 8 / NB; ++hb) {
        if (hb > 0) issue(hb);
#pragma unroll
        for (int q = 0; q < NB; ++q) { const int p = tid + 512 * (NB * hb + q), tt = p >> 4, cc = p & 15, g = tt >> 6; const size_t m = (size_t)b * T + t0 + tt;
            const f32x4 cf0 = *(const LAS f32x4*)(CAR + (0 * 4 + g) * 128 + 8 * cc), cf1 = *(const LAS f32x4*)(CAR + (0 * 4 + g) * 128 + 8 * cc + 4);
            const f32x4 cb0 = *(const LAS f32x4*)(CAR + (1 * 4 + g) * 128 + 8 * cc), cb1 = *(const LAS f32x4*)(CAR + (1 * 4 + g) * 128 + 8 * cc + 4);
            const unsigned uf[8] = {lf[q][0].x, lf[q][0].y, lf[q][0].z, lf[q][0].w, lf[q][1].x, lf[q][1].y, lf[q][1].z, lf[q][1].w};
            const unsigned ub[8] = {lb[q][0].x, lb[q][0].y, lb[q][0].z, lb[q][0].w, lb[q][1].x, lb[q][1].y, lb[q][1].z, lb[q][1].w};
            const float cf[8] = {cf0[0], cf0[1], cf0[2], cf0[3], cf1[0], cf1[1], cf1[2], cf1[3]}, cb[8] = {cb0[0], cb0[1], cb0[2], cb0[3], cb1[0], cb1[1], cb1[2], cb1[3]};
            const float gg[8] = {bflo(gt[q].x), bfhi(gt[q].x), bflo(gt[q].y), bfhi(gt[q].y), bflo(gt[q].z), bfhi(gt[q].z), bflo(gt[q].w), bfhi(gt[q].w)};
            float o[8];
#pragma unroll
            for (int k = 0; k < 8; ++k) o[k] = ((bflo(uf[k]) + bfhi(uf[k]) * cf[k]) + (bflo(ub[k]) + bfhi(ub[k]) * cb[k])) * gg[k];
            v4u w; w.x = pg8::cvt_pk_bf16(o[0], o[1]); w.y = pg8::cvt_pk_bf16(o[2], o[3]); w.z = pg8::cvt_pk_bf16(o[4], o[5]); w.w = pg8::cvt_pk_bf16(o[6], o[7]);
            *(v4u*)(YM + m * D + DH + 128 * bp + 8 * cc) = w; }
    }
    __syncthreads();
}
__device__ __forceinline__ void pass2(Frame& F) {
    const float2* TOT = (const float2*)(F.ws + WS_RGTOT); float* CIN = (float*)(F.ws + WS_CIN);
    const int gt = (F.G - 1 - F.bid) * (NWAVES * 64) + F.tid;
    if (gt < 4 * 2 * 2 * DH) {
        const int part = gt & 3, chn = gt >> 2, ch = chn & (DH - 1), dir = (chn >> 9) & 1, b = chn >> 10, lane = F.tid & 63;
        float2 tt[16];
#pragma unroll
        for (int q = 0; q < 16; ++q) { const int s = 16 * part + q, jj = dir ? 63 - s : s; tt[q] = TOT[(size_t)((b * 64 + jj) * 2 + dir) * DH + ch]; }
        float A = 1.f, H = 0.f;
#pragma unroll
        for (int q = 0; q < 16; ++q) { H = tt[q].x * H + tt[q].y; A *= tt[q].x; }
        float c = 0.f;
#pragma unroll
        for (int p = 0; p < 3; ++p) { const float Ap = __shfl(A, (lane & ~3) + p), Hp = __shfl(H, (lane & ~3) + p); if (p < part) c = Ap * c + Hp; }
        float h = c;
#pragma unroll
        for (int q = 0; q < 16; ++q) { const int s = 16 * part + q, jj = dir ? 63 - s : s; CIN[(size_t)((b * 64 + jj) * 2 + dir) * DH + ch] = h; h = tt[q].x * h + tt[q].y; }
    }
}
}
#ifndef REP_A
#define REP_A 1
#endif
#ifndef REP_N
#define REP_N 1
#endif
#ifndef REP_IN
#define REP_IN 1
#endif
#ifndef REP_UP
#define REP_UP 1
#endif
#ifndef S1_START
#define S1_START 0
#endif
#ifndef S1_LIMIT
#define S1_LIMIT (512 * REP_H0 + 512 * REP_R0)
#endif
#ifndef REP_S1
#define REP_S1 1
#endif
#ifndef REP_H0
#define REP_H0 1
#endif
#ifndef REP_R0
#define REP_R0 1
#endif
#ifndef REP_H3
#define REP_H3 1
#endif
#ifndef REP_R3
#define REP_R3 1
#endif
#ifndef REP_S2
#define REP_S2 1
#endif
#ifndef REP_S3
#define REP_S3 1
#endif
#ifndef REP_BAR
#define REP_BAR 0
#endif
struct Args { const float* in[31]; float* out; unsigned char* ws; };
__global__ void __launch_bounds__(NWAVES * 64, 2) hymba_fwd(Args args) {
    extern __shared__ __attribute__((aligned(16))) unsigned char lds[];
    Frame F;
    F.lds = (LAS unsigned char*)lds;
    F.MISC = (volatile LAS unsigned*)(F.lds + MISC_OFF);
    F.tid = threadIdx.x; F.lane = F.tid & 63; F.wave = __builtin_amdgcn_readfirstlane(F.tid >> 6);
    F.G = gridDim.x; F.bid = blockIdx.x;
    F.ka = (const __attribute__((address_space(4))) unsigned long long*)__builtin_amdgcn_kernarg_segment_ptr();
    F.out = args.out; F.ws = args.ws;
    F.ctl = (gu32*)(F.ws + WS_CTL);
    for (int u = F.tid; u < (LDS_BYTES - LDSCTL_OFF) / 4; u += NWAVES * 64) ((LAS unsigned*)(F.lds + LDSCTL_OFF))[u] = 0u;
    __syncthreads();
    int n_stamp = 0;
    XcdBarrier bar = xcd_barrier_post((unsigned*)(F.ctl + CW_BAR), F.MISC + 8);
#define REFRESH() do { int t_ = threadIdx.x; asm volatile("" : "+v"(t_)); F.tid = t_; F.lane = t_ & 63; } while (0)
#ifndef STAMP_SCALE
#define STAMP_SCALE 0.05f
#endif
#ifdef STAMP_A
#define STAMP() do { if (blockIdx.x == 0 && threadIdx.x == 0) { ((unsigned long long*)(F.ws + WS_CTL + 768 * 1024))[n_stamp] = __builtin_amdgcn_s_memrealtime(); } ++n_stamp; } while (0)
#else
#define STAMP() do { } while (0)
#endif
#if defined(STAMP_A) && defined(STAMP_PB)
#define PB_STAMP(id) do { if (STAMP_PB == (id) && threadIdx.x == 0) ((unsigned long long*)(F.ws + WS_CTL + 768 * 1024))[64 + blockIdx.x] = __builtin_amdgcn_s_memrealtime(); } while (0)
#else
#define PB_STAMP(id) do { } while (0)
#endif
#define GRID_BAR() do { PB_STAMP(n_stamp); xcd_barrier(bar); REFRESH(); STAMP(); } while (0)
    STAMP();
    unsigned char* ws = F.ws;
    const float* MOD = (const float*)(ws + WS_MOD);
    bf16* XN = (bf16*)(ws + WS_XN); bf16* HB = (bf16*)(ws + WS_HB); bf16* XB = (bf16*)(ws + WS_XB);

    for (int rep = 0; rep < REP_A; ++rep) { p0a(F); __syncthreads(); } GRID_BAR();
    for (int rep = 0; rep < REP_BAR; ++rep) GRID_BAR();
    for (int rep = 0; rep < REP_N; ++rep) p0b(F); GRID_BAR();
    { pg8::Gemm g{XB, (const bf16*)(ws + WS_W13A), M, 2 * FF, D, W13_COPY}; pg8::StaticOrder S; S.init(M, 2 * FF, F.G, F.bid);
      pg8::EpiSwiGLU E{HB, FF, (const float*)(ws + WS_SSQ1), (const float*)(ws + WS_BIAS1), 2 * FF, T};
      for (int rep = 0; rep < REP_UP; ++rep) pg8::gemm_phase<pg8::EpiSwiGLU, pg8::StaticOrder, true, true>(F.lds + RING_OFF, g, S, E); GRID_BAR(); }
    { pg8::Gemm g{HB, (const bf16*)(ws + WS_W2A), M, D, FF, 0}; pg8::StaticOrder S; S.init(M, D, F.G, F.bid);
      pg8::EpiResid<false, 1, false, false> E{XB, XB, MOD + 2 * D, nullptr, nullptr, (float*)(ws + WS_SSQ2)};
      pg8::gemm_phase<pg8::EpiResid<false, 1, false, false>, pg8::StaticOrder, true, true>(F.lds + RING_OFF, g, S, E); GRID_BAR(); }
    { pg8::Gemm g{XB, (const bf16*)(ws + WS_WIN), M, NIN, D, WIN_COPY}; pg8::StaticOrder S; S.init(M, NIN, F.G, F.bid);
      pg8::EpiInProj E{(bf16*)(ws + WS_ZQ), (bf16*)(ws + WS_ZV), (bf16*)(ws + WS_ZG), (bf16*)(ws + WS_ZRX), (bf16*)(ws + WS_ZRG), (bf16*)(ws + WS_ZLF), (bf16*)(ws + WS_ZLB), (const float*)(ws + WS_LBF), (const float*)(ws + WS_LBB),
                       (const float*)(ws + WS_SSQ2), (const float*)(ws + WS_BIAS2), NIN, T};
      for (int rep = 0; rep < REP_IN; ++rep) pg8::gemm_phase<pg8::EpiInProj, pg8::StaticOrder, true, true>(F.lds + RING_OFF, g, S, E); GRID_BAR(); }
    {
        gu32* ctr = F.ctl + CW_QUEUE;
        for (;;) {
            if (F.tid == 0) F.MISC[16] = __hip_atomic_fetch_add(ctr, 1u, __ATOMIC_RELAXED, __HIP_MEMORY_SCOPE_AGENT);
            __syncthreads(); const int it = (int)F.MISC[16] + S1_START; __syncthreads();
            if (it >= S1_LIMIT) break;
            if (it < 512 * REP_H0) { const int i2 = it & 511; hg::pass0_direct(F, i2 >> 8, (i2 >> 6) & 3, (i2 >> 1) & 31, i2 & 1); }
            else { const int r = (it - 512 * REP_H0) & 511; rg::item<0>(F, r >> 8, (r >> 2) & 63, r & 3); }
        }
    }
    GRID_BAR();
    for (int rep = 0; rep < REP_S2; ++rep) { hg::pass2(F); rg::pass2(F); }
    GRID_BAR();
    {
        const int cls = (F.bid >> 3) & 7, idx = ((F.bid >> 6) << 3) | (F.bid & 7);
        { const int first = 2 * (cls * 32 + idx), n = cls < 2 ? 2 : 0;
#pragma unroll 1
          for (int q2 = 0; q2 < n; ++q2) { const int it = first + q2; rg::fix(F, it >> 8, (it >> 2) & 63, it & 3); } }
        for (int it = F.bid; it < 8 * hg::NSC; it += F.G) { const int b = it >> 7, h = (it >> 5) & 3, j = it & 31;
            hg::pass_pipe<1>(F, b, h, j, 1);
            { const int first = 128 + 2 * ((cls - 2) * 32 + idx), n = (cls >= 2 && cls < 5) ? 2 : 0;
#pragma unroll 1
              for (int q2 = 0; q2 < n; ++q2) { const int it2 = first + q2; rg::fix(F, it2 >> 8, (it2 >> 2) & 63, it2 & 3); } }
            hg::pass_pipe<2>(F, b, h, j, 0); }
        gu32* ctr = F.ctl + CW_QUEUE + 64;
        for (;;) {
            if (F.tid == 0) F.MISC[16] = __hip_atomic_fetch_add(ctr, 1u, __ATOMIC_RELAXED, __HIP_MEMORY_SCOPE_AGENT);
            __syncthreads(); const int it = 320 + (int)F.MISC[16]; __syncthreads();
            if (it >= 512) break;
            rg::fix(F, it >> 8, (it >> 2) & 63, it & 3);
        }
    }
    GRID_BAR();
    { pg8::Gemm g{XN, (const bf16*)(ws + WS_WOUT), M, D, D, 0}; pg8::StaticOrder S; S.init(M, D, F.G, F.bid);
      pg8::EpiResid<false, 2, false, false> E{XB, XB, MOD + 5 * D, nullptr, nullptr, (float*)(ws + WS_SSQ3)};
      pg8::gemm_phase<pg8::EpiResid<false, 2, false, false>, pg8::StaticOrder, true, true>(F.lds + RING_OFF, g, S, E); GRID_BAR(); }
    { pg8::Gemm g{XB, (const bf16*)(ws + WS_W13B), M, 2 * FF, D, W13_COPY}; pg8::StaticOrder S; S.init(M, 2 * FF, F.G, F.bid);
      pg8::EpiSwiGLU E{HB, FF, (const float*)(ws + WS_SSQ3), (const float*)(ws + WS_BIAS3), 2 * FF, T};
      pg8::gemm_phase<pg8::EpiSwiGLU, pg8::StaticOrder, true, true>(F.lds + RING_OFF, g, S, E); GRID_BAR(); }
    { pg8::Gemm g{HB, (const bf16*)(ws + WS_W2B), M, D, FF, 0}; pg8::StaticOrder S; S.init(M, D, F.G, F.bid);
      pg8::EpiFinal E{XB, F.out, MOD + 8 * D, FIN(30), (float*)(ws + WS_SSQ4), (unsigned*)(ws + WS_CTL) + CW_FIN};
      pg8::gemm_phase<pg8::EpiFinal, pg8::StaticOrder, true, true>(F.lds + RING_OFF, g, S, E); }
#ifdef STAMP_A
    GRID_BAR();
    if (blockIdx.x == 0 && threadIdx.x == 0) { asm volatile("s_waitcnt vmcnt(0)" ::: "memory"); const unsigned long long* tsp = (const unsigned long long*)(F.ws + WS_CTL + 768 * 1024);
#if STAMP_B == 999
        long long mx = 0; for (int q = 0; q < 256; ++q) { const long long d = (long long)(tsp[64 + q] - tsp[STAMP_A]); mx = d > mx ? d : mx; } F.out[0] = 0.0005f * (float)mx; }
#elif STAMP_B == 970
        F.out[0] = 0.01f * STAMP_SCALE * (float)(long long)((tsp[4] - tsp[3]) + (tsp[9] - tsp[8]) + (tsp[11] - tsp[10])); }
#elif STAMP_B == 996
        unsigned long long mx = 0; for (int q = 0; q < 256; ++q) { mx = tsp[64 + q] > mx ? tsp[64 + q] : mx; } F.out[0] = 0.0005f * (float)(long long)(tsp[6] - mx); }
#elif STAMP_B == 995
        int msk = 0; const long long d0 = (long long)(tsp[64] - tsp[STAMP_A]); for (int q = 0; q < 256; ++q) { const long long d = (long long)(tsp[64 + q] - tsp[STAMP_A]); if (5 * d > 6 * d0) msk |= 1 << (q & 7); } F.out[0] = 0.05f * (float)msk; }
#elif STAMP_B == 994
        long long mn = 1ll << 40; for (int q = 0; q < 256; ++q) { const long long d = (long long)(tsp[64 + q] - tsp[STAMP_A]); mn = d < mn ? d : mn; } F.out[0] = 0.0005f * (float)mn; }
#elif STAMP_B == 993
        long long mx = 0; for (int q = 0; q < 256; ++q) { if ((q & 7) == 6) continue; const long long d = (long long)(tsp[64 + q] - tsp[STAMP_A]); mx = d > mx ? d : mx; } F.out[0] = 0.0005f * (float)mx; }
#elif STAMP_B >= 980 && STAMP_B < 988
        long long mx = 0; for (int q = 0; q < 256; ++q) { if ((q & 7) != STAMP_B - 980) continue; const long long d = (long long)(tsp[64 + q] - tsp[STAMP_A]); mx = d > mx ? d : mx; } F.out[0] = 0.01f * STAMP_SCALE * (float)mx; }
#elif STAMP_B == 998
        long long mx = 0; int am = 0; for (int q = 0; q < 256; ++q) { const long long d = (long long)(tsp[64 + q] - tsp[STAMP_A]); if (d > mx) { mx = d; am = q; } } F.out[0] = 0.1f * (float)am; }
#elif STAMP_B == 997
        int cnt = 0; const long long d0 = (long long)(tsp[64] - tsp[STAMP_A]); for (int q = 0; q < 256; ++q) { const long long d = (long long)(tsp[64 + q] - tsp[STAMP_A]); if (5 * d > 6 * d0) ++cnt; } F.out[0] = 0.1f * (float)cnt; }
#else
        F.out[0] = 0.01f * STAMP_SCALE * (float)(long long)(tsp[STAMP_B] - tsp[STAMP_A]); }
#endif
#endif
}

extern "C" void kernel_launch(void* const* d_in, const int* in_sizes, int n_in, void* d_out, int out_size, void* d_ws, size_t ws_size, hipStream_t stream) {
    static int grid = 0;
    if (grid == 0) {
        if (n_in != 31 || in_sizes[0] != M * D || out_size != M * D || ws_size < WS_END) { fprintf(stderr, "kernel_launch: unexpected shapes (n_in %d, in0 %d, out %d, ws %zu)\n", n_in, n_in > 0 ? in_sizes[0] : -1, out_size, ws_size); grid = -1; return; }
        int dev = 0, cus = 0;
        if (hipGetDevice(&dev) != hipSuccess || hipDeviceGetAttribute(&cus, hipDeviceAttributeMultiprocessorCount, dev) != hipSuccess) { grid = -1; return; }
        if (hipFuncSetAttribute((const void*)hymba_fwd, hipFuncAttributeMaxDynamicSharedMemorySize, LDS_BYTES) != hipSuccess) { fprintf(stderr, "kernel_launch: hipFuncSetAttribute failed\n"); grid = -1; return; }
        (void)hipGetLastError();
        grid = cus;
    }
    if (grid < 0) return;
    if (hipMemsetAsync((char*)d_ws + WS_CTL, 0, CTL_ZERO_BYTES, stream) != hipSuccess) return;
    Args a{};
    for (int i = 0; i < 31; ++i) a.in[i] = (const float*)d_in[i];
    a.out = (float*)d_out; a.ws = (unsigned char*)d_ws;
    hipLaunchKernelGGL(hymba_fwd, dim3(grid), dim3(NWAVES * 64), LDS_BYTES, stream, a);
}
```
